# Optimizing an MI355X kernel written in HIP

```python
import jax, jax.numpy as jnp
from jax import lax
import numpy as np

D_MODEL = 1024
BATCH = 8
SEQ = 2048
DEPTH = 1
DEC_BATCH = 128
DEC_SEQ = 8
PAST_LEN = 16384
PAGE_SIZE = 128

MIX_WIDTH = D_MODEL
CONV_WIDTH = MIX_WIDTH // 2
RWKV_WIDTH = MIX_WIDTH - CONV_WIDTH
HEAD_SIZE = 64
N_HEADS = RWKV_WIDTH // HEAD_SIZE
CONV_K = 3
D_DECAY_LORA = 64
D_AAA_LORA = 64
D_GATE_LORA = 128
D_FF = 4 * D_MODEL
RWKV_COLS = 3 * RWKV_WIDTH + D_DECAY_LORA + D_AAA_LORA + D_GATE_LORA
IN_COLS = 3 * CONV_WIDTH + RWKV_COLS
RMS_EPS = 1e-6
GN_EPS = 64e-5
NORM_EPS = 1e-12

kernel_name = "hymba_shortconv_rwkv7_step"


def _rmsnorm(x, g):
    xf = x.astype(jnp.float32)
    y = xf * lax.rsqrt(jnp.mean(xf * xf, axis=-1, keepdims=True) + RMS_EPS) * g.astype(jnp.float32)
    return y.astype(x.dtype)


def _short_conv(u, buf, conv_w):
    t_len = u.shape[1]
    full = jnp.concatenate([buf.astype(u.dtype), u], axis=1)
    out = sum(full[:, j:j + t_len] * conv_w[j] for j in range(CONV_K))
    return out, full[:, -(CONV_K - 1):]


def _wkv_scan(s0, r, decay, k, v, kk, a):
    def step(s, inp):
        r_t, w_t, k_t, v_t, kk_t, a_t = inp
        s_kk = jnp.einsum('bhvk,bhk->bhv', s, kk_t)
        s = (s * w_t[:, :, None, :]
             - s_kk[..., None] * (kk_t * a_t)[:, :, None, :]
             + v_t[..., None] * k_t[:, :, None, :])
        y_t = jnp.einsum('bhvk,bhk->bhv', s, r_t)
        return s, y_t
    xs = tuple(jnp.swapaxes(t, 0, 1) for t in (r, decay, k, v, kk, a))
    s_final, ys = lax.scan(step, s0, xs)
    return jnp.swapaxes(ys, 0, 1), s_final


def _layer(x, conv_buf, shift_buf, wkv_state, norm1_g, w_in, conv_w, mu, w0, w2, a0, a2, g2,
           k_k, k_a, r_k, lnx_g, lnx_b, w_out, norm2_g, w_ff1, w_ff2):
    bsz, t_len, _ = x.shape
    f32 = jnp.float32
    h = _rmsnorm(x, norm1_g)
    proj = h @ w_in
    c_b, c_c, c_x, p_rw = jnp.split(proj, [CONV_WIDTH, 2 * CONV_WIDTH, 3 * CONV_WIDTH], axis=-1)

    conv_out, new_conv = _short_conv(c_c * c_x, conv_buf, conv_w)
    y_conv = c_b * conv_out

    prev = jnp.concatenate([shift_buf[:, None, :].astype(p_rw.dtype), p_rw[:, :-1]], axis=1)
    xm = (p_rw + (prev - p_rw) * mu).astype(f32)
    new_shift = p_rw[:, -1]
    r, k, v, pw, pa, pg = jnp.split(
        xm, [RWKV_WIDTH, 2 * RWKV_WIDTH, 3 * RWKV_WIDTH, 3 * RWKV_WIDTH + D_DECAY_LORA,
             3 * RWKV_WIDTH + D_DECAY_LORA + D_AAA_LORA], axis=-1)
    w = -jax.nn.softplus(-(w0.astype(f32) + jnp.tanh(pw) @ w2.astype(f32))) - 0.5
    decay = jnp.exp(-jnp.exp(w))
    a = jax.nn.sigmoid(a0.astype(f32) + pa @ a2.astype(f32))
    g = jax.nn.sigmoid(pg) @ g2.astype(f32)

    def heads(t):
        return t.reshape(bsz, t_len, N_HEADS, HEAD_SIZE)
    r, k, v, decay, a = heads(r), heads(k), heads(v), heads(decay), heads(a)
    kk = k * k_k.astype(f32).reshape(N_HEADS, HEAD_SIZE)
    kk = kk / jnp.maximum(jnp.sqrt(jnp.sum(kk * kk, axis=-1, keepdims=True)), NORM_EPS)
    k = k * (1.0 + (a - 1.0) * k_a.astype(f32).reshape(N_HEADS, HEAD_SIZE))
    y, new_wkv = _wkv_scan(wkv_state.astype(f32), r, decay, k, v, kk, a)
    mean = jnp.mean(y, axis=-1, keepdims=True)
    var = jnp.mean(jnp.square(y - mean), axis=-1, keepdims=True)
    y = ((y - mean) * lax.rsqrt(var + GN_EPS)).reshape(bsz, t_len, RWKV_WIDTH)
    y = y * lnx_g.astype(f32) + lnx_b.astype(f32)
    bonus = jnp.sum(r * k * r_k.astype(f32), axis=-1, keepdims=True) * v
    y_rwkv = ((y + bonus.reshape(bsz, t_len, RWKV_WIDTH)) * g).astype(x.dtype)

    x = x + jnp.concatenate([y_conv, y_rwkv], axis=-1) @ w_out
    h2 = _rmsnorm(x, norm2_g)
    x = x + jnp.square(jax.nn.relu(h2 @ w_ff1)) @ w_ff2
    return x, new_conv, new_shift, new_wkv.astype(x.dtype)


def setup_inputs(seed: int = 0) -> dict:
    key = jax.random.key(seed)
    ks = jax.random.split(key, 32)
    f32 = jnp.float32
    nrm = lambda k, shape, s: jax.random.normal(k, shape, f32) * s
    return {
        "x_prompt": nrm(ks[0], (BATCH, SEQ, D_MODEL), 1.0),
        "x_sample": nrm(ks[1], (DEC_BATCH, DEC_SEQ, D_MODEL), 1.0),
        "state_conv": nrm(ks[2], (DEPTH, DEC_BATCH, CONV_K - 1, CONV_WIDTH), 1.0),
        "state_shift": nrm(ks[3], (DEPTH, DEC_BATCH, RWKV_COLS), 1.0),
        "state_wkv": nrm(ks[4], (DEPTH, DEC_BATCH, N_HEADS, HEAD_SIZE, HEAD_SIZE), 0.1),
        "norm1_g": 1.0 + nrm(ks[5], (DEPTH, D_MODEL), 0.02),
        "w_in": nrm(ks[6], (DEPTH, D_MODEL, IN_COLS), D_MODEL ** -0.5),
        "conv_w": nrm(ks[7], (DEPTH, CONV_K, CONV_WIDTH), CONV_K ** -0.5),
        "mu": jax.random.uniform(ks[8], (DEPTH, RWKV_COLS), f32, 0.0, 1.0),
        "w0": jax.random.uniform(ks[9], (DEPTH, RWKV_WIDTH), f32, -4.0, 0.0),
        "w2": nrm(ks[10], (DEPTH, D_DECAY_LORA, RWKV_WIDTH), 0.1 * D_DECAY_LORA ** -0.5),
        "a0": nrm(ks[11], (DEPTH, RWKV_WIDTH), 0.1),
        "a2": nrm(ks[12], (DEPTH, D_AAA_LORA, RWKV_WIDTH), 0.1 * D_AAA_LORA ** -0.5),
        "g2": nrm(ks[13], (DEPTH, D_GATE_LORA, RWKV_WIDTH), D_GATE_LORA ** -0.5),
        "k_k": 0.85 + nrm(ks[14], (DEPTH, RWKV_WIDTH), 0.02),
        "k_a": 1.0 + nrm(ks[15], (DEPTH, RWKV_WIDTH), 0.02),
        "r_k": nrm(ks[16], (DEPTH, N_HEADS, HEAD_SIZE), 0.1),
        "lnx_g": 1.0 + nrm(ks[17], (DEPTH, RWKV_WIDTH), 0.02),
        "lnx_b": nrm(ks[18], (DEPTH, RWKV_WIDTH), 0.02),
        "w_out": nrm(ks[19], (DEPTH, MIX_WIDTH, D_MODEL), MIX_WIDTH ** -0.5),
        "norm2_g": 1.0 + nrm(ks[20], (DEPTH, D_MODEL), 0.02),
        "w_ff1": nrm(ks[21], (DEPTH, D_MODEL, D_FF), D_MODEL ** -0.5),
        "w_ff2": nrm(ks[22], (DEPTH, D_FF, D_MODEL), D_FF ** -0.5),
        "normf_g": 1.0 + nrm(ks[23], (D_MODEL,), 0.02),
    }


def reference(x_prompt, x_sample, state_conv, state_shift, state_wkv, norm1_g, w_in, conv_w, mu,
              w0, w2, a0, a2, g2, k_k, k_a, r_k, lnx_g, lnx_b, w_out, norm2_g, w_ff1, w_ff2,
              normf_g):
    dt = x_prompt.dtype
    bp = x_prompt.shape[0]
    hp, hs = x_prompt, x_sample
    conv_p, shift_p, wkv_p, conv_s, shift_s, wkv_s = [], [], [], [], [], []
    for layer in range(DEPTH):
        weights = (norm1_g[layer], w_in[layer], conv_w[layer], mu[layer], w0[layer], w2[layer],
                   a0[layer], a2[layer], g2[layer], k_k[layer], k_a[layer], r_k[layer],
                   lnx_g[layer], lnx_b[layer], w_out[layer], norm2_g[layer], w_ff1[layer],
                   w_ff2[layer])
        hp, c_p, s_p, m_p = _layer(
            hp, jnp.zeros((bp, CONV_K - 1, CONV_WIDTH), dt), jnp.zeros((bp, RWKV_COLS), dt),
            jnp.zeros((bp, N_HEADS, HEAD_SIZE, HEAD_SIZE), dt), *weights)
        hs, c_s, s_s, m_s = _layer(hs, state_conv[layer], state_shift[layer], state_wkv[layer],
                                   *weights)
        conv_p.append(c_p); shift_p.append(s_p); wkv_p.append(m_p)
        conv_s.append(c_s); shift_s.append(s_s); wkv_s.append(m_s)
    y_prompt = _rmsnorm(hp, normf_g)
    y_sample = _rmsnorm(hs, normf_g)
    return (y_prompt, y_sample, jnp.stack(conv_p), jnp.stack(shift_p), jnp.stack(wkv_p),
            jnp.stack(conv_s), jnp.stack(shift_s), jnp.stack(wkv_s))
```

```cpp
#include <hip/hip_runtime.h>
#include <hip/hip_cooperative_groups.h>
#include <cstdio>
#include <cstdint>
namespace cg = cooperative_groups;
namespace pg8 {
#define PG8_LAS __attribute__((address_space(3)))
typedef unsigned short bf16_t;
typedef short bf16x8 __attribute__((ext_vector_type(8)));
typedef float f32x4 __attribute__((ext_vector_type(4)));
typedef unsigned u32x4 __attribute__((ext_vector_type(4)));
constexpr int BM = 256, BK = 64, HALF = 128, HTB = HALF * BK * 2  , STAGE_BYTES = 8 * HTB, NXCD = 8, WGM = 8;

__host__ __device__ __forceinline__ int lds_byte(int r, int c) { const int st = (r >> 4) * 2 + (c >> 5), rr = r & 15, cc = c & 31, ob = rr * 64 + cc * 2; return st * 1024 + (ob ^ (((ob >> 9) & 1) << 5)); }
__host__ __device__ __forceinline__ void stage_rc(int b, int& R, int& C) { const int st = b / 1024, sb = b % 1024, swz = sb ^ (((sb >> 9) & 1) << 5); R = (st >> 1) * 16 + swz / 64; C = (st & 1) * 32 + (swz % 64) / 2; }
__host__ __device__ __forceinline__ int perm32(int rho) { const int n = rho >> 4, i = rho & 15; return 8 * (i >> 2) + 4 * n + (i & 3); }

struct Unit { int pm, pn, ko; };
struct Gemm { const bf16_t* A; const bf16_t* Bt; int M, N, K, ld; };

struct StaticOrder {
    int nM, nN, nwg, G, c;
    __host__ __device__ void init(int M, int N, int G_, int c_) { nM = M / BM; nN = N / BM; nwg = nM * nN; G = G_; c = c_; }
    __host__ __device__ bool next(int i, Unit& u) const {
        const long L = (long)i * G + c; if (L >= nwg) return false;
        int wgid = (int)L; { const int q = nwg / NXCD, r = nwg % NXCD, xcd = wgid % NXCD, off = wgid / NXCD; wgid = (xcd < r ? xcd * (q + 1) : r * (q + 1) + (xcd - r) * q) + off; }
        const int nig = WGM * nN, gid = wgid / nig, fm = gid * WGM, gsz = (nM - fm) < WGM ? (nM - fm) : WGM;
        u.pm = fm + ((wgid % nig) % gsz); u.pn = (wgid % nig) / gsz; u.ko = 0; return true;
    }
    __device__ __forceinline__ void a_ready(const Unit&) const {}
    __device__ __forceinline__ void done(const Unit&) const {}
};

__device__ __forceinline__ unsigned cvt_pk_bf16(float lo, float hi) { unsigned r; asm volatile("v_cvt_pk_bf16_f32 %0, %1, %2" : "=v"(r) : "v"(lo), "v"(hi)); return r; }
#define PG8_GAS __attribute__((address_space(1)))
template <int ACT  > struct EpiStore {
    static constexpr bool PERM = true, AFTER_DRAIN = false;
    bf16_t* O; int ldc;
    __device__ __forceinline__ void operator()(const f32x4 (&acc)[2][2][4][2], const Unit& u, int wr, int wc, int fr, int fq) const {
        const int row0 = u.pm * BM + wr * 64 + fr, col0 = u.pn * BM + wc * 32 + 8 * fq;
#pragma unroll
        for (int ai = 0; ai < 2; ++ai)
#pragma unroll
            for (int m = 0; m < 4; ++m) { bf16_t* rowp = O + (size_t)(row0 + ai * HALF + m * 16) * ldc + col0;
#pragma unroll
                for (int bj = 0; bj < 2; ++bj) { f32x4 v0 = acc[ai][bj][m][0], v1 = acc[ai][bj][m][1];
                    if (ACT == 1) { v0 = __builtin_elementwise_max(v0, (f32x4){0.f, 0.f, 0.f, 0.f}); v1 = __builtin_elementwise_max(v1, (f32x4){0.f, 0.f, 0.f, 0.f}); v0 = v0 * v0; v1 = v1 * v1; }
                    u32x4 w; w.x = cvt_pk_bf16(v0[0], v0[1]); w.y = cvt_pk_bf16(v0[2], v0[3]); w.z = cvt_pk_bf16(v1[0], v1[1]); w.w = cvt_pk_bf16(v1[2], v1[3]);
                    *(PG8_GAS u32x4*)(rowp + bj * HALF) = w; } }
    }
};
template <int MODE> struct EpiRes {
    static constexpr bool PERM = true, AFTER_DRAIN = false;
    const float* xp; const float* xs; float* out; bf16_t* XG; const float* gam; const float* ss_in; float* ssq;
    __device__ __forceinline__ void operator()(const f32x4 (&acc)[2][2][4][2], const Unit& u, int wr, int wc, int fr, int fq) const {
        const int row0 = u.pm * BM + wr * 64 + fr, col0 = u.pn * BM + wc * 32 + 8 * fq;
        f32x4 gv[2][2];
        if (MODE == 0) {
#pragma unroll
            for (int bj = 0; bj < 2; ++bj)
#pragma unroll
                for (int n = 0; n < 2; ++n) gv[bj][n] = *(const PG8_GAS f32x4*)(gam + col0 + bj * HALF + 4 * n);
        }
#pragma unroll
        for (int ai = 0; ai < 2; ++ai)
#pragma unroll
            for (int m = 0; m < 4; ++m) {
                const int row = row0 + ai * HALF + m * 16;
                const float* xin; float sc = 1.f;
                if (MODE == 0) { xin = (row < 16384) ? xp + (size_t)row * 1024 : xs + (size_t)(row - 16384) * 1024; }
                else { xin = out + (size_t)row * 1024;
                    const PG8_GAS f32x4* sp = (const PG8_GAS f32x4*)(ss_in + (size_t)row * 16);
                    const f32x4 s0 = sp[0], s1 = sp[1], s2 = sp[2], s3 = sp[3];
                    const f32x4 st = (s0 + s1) + (s2 + s3);
                    const float tot = (st[0] + st[1]) + (st[2] + st[3]);
                    sc = 1.0f / (tot * (1.0f / 1024.0f) + 1e-6f); }
                float* op = out + (size_t)row * 1024 + col0;
                float ss = 0.f;
#pragma unroll
                for (int bj = 0; bj < 2; ++bj) {
                    const f32x4 a0 = *(const PG8_GAS f32x4*)(xin + col0 + bj * HALF), a1 = *(const PG8_GAS f32x4*)(xin + col0 + bj * HALF + 4);
                    const f32x4 v0 = a0 + acc[ai][bj][m][0] * sc, v1 = a1 + acc[ai][bj][m][1] * sc;
                    *(PG8_GAS f32x4*)(op + bj * HALF) = v0; *(PG8_GAS f32x4*)(op + bj * HALF + 4) = v1;
                    ss += (v0[0] * v0[0] + v0[1] * v0[1]) + (v0[2] * v0[2] + v0[3] * v0[3]);
                    ss += (v1[0] * v1[0] + v1[1] * v1[1]) + (v1[2] * v1[2] + v1[3] * v1[3]);
                    if (MODE == 0) { const f32x4 g0 = v0 * gv[bj][0], g1 = v1 * gv[bj][1];
                        u32x4 w; w.x = cvt_pk_bf16(g0[0], g0[1]); w.y = cvt_pk_bf16(g0[2], g0[3]); w.z = cvt_pk_bf16(g1[0], g1[1]); w.w = cvt_pk_bf16(g1[2], g1[3]);
                        *(PG8_GAS u32x4*)(XG + (size_t)row * 1024 + col0 + bj * HALF) = w; }
                }
                ss += __shfl_xor(ss, 16); ss += __shfl_xor(ss, 32);
                if (fq == 0) ssq[(size_t)row * 16 + u.pn * 4 + wc] = ss;
            }
    }
};
struct SplitOrder {
    int G, c;
    __device__ bool next(int i, Unit& u) const { const int L = i * G + c; if (L >= 128) return false; const int tile = L >> 3, kc = L & 7; u.pm = 64 + (tile >> 2); u.pn = tile & 3; u.ko = kc * 512; return true; }
    __device__ __forceinline__ void a_ready(const Unit&) const {}
    __device__ __forceinline__ void done(const Unit&) const {}
};
struct EpiPart {
    static constexpr bool PERM = true, AFTER_DRAIN = false;
    float* P;
    __device__ __forceinline__ void operator()(const f32x4 (&acc)[2][2][4][2], const Unit& u, int wr, int wc, int fr, int fq) const {
        const int row0 = (u.pm - 64) * BM + wr * 64 + fr, col0 = u.pn * BM + wc * 32 + 8 * fq;
        float* base = P + (size_t)(u.ko >> 9) * (1024 * 1024);
#pragma unroll
        for (int ai = 0; ai < 2; ++ai)
#pragma unroll
            for (int m = 0; m < 4; ++m) { float* rowp = base + (size_t)(row0 + ai * HALF + m * 16) * 1024 + col0;
#pragma unroll
                for (int bj = 0; bj < 2; ++bj) { *(PG8_GAS f32x4*)(rowp + bj * HALF) = acc[ai][bj][m][0]; *(PG8_GAS f32x4*)(rowp + bj * HALF + 4) = acc[ai][bj][m][1]; } }
    }
};
struct OutOrder {
    int G, c; unsigned* cnt;
    __device__ bool next(int i, Unit& u) const { const int t = i * G + c; if (t >= 272) return false; if (t < 16) { u.pm = 64 + (t >> 2); u.pn = t & 3; } else { const int p = t - 16; u.pm = p >> 2; u.pn = p & 3; } u.ko = 0; return true; }
    __device__ __forceinline__ void a_ready(const Unit&) const {}
    __device__ __forceinline__ void done(const Unit& u) const {
        if (u.pm >= 64) {
            asm volatile("s_waitcnt vmcnt(0)" ::: "memory");
            __builtin_amdgcn_fence(__ATOMIC_RELEASE, "agent");
            if ((threadIdx.x & 63) == 0) __hip_atomic_fetch_add(cnt, 1u, __ATOMIC_RELAXED, __HIP_MEMORY_SCOPE_AGENT);
        }
    }
};
struct SampleFF1Order {
    int G, c; const unsigned* cnt; unsigned need;
    __device__ bool next(int i, Unit& u) const { const int t = c - 16; if (i != 0 || t < 0 || t >= 64) return false; u.pm = 64 + (t >> 4); u.pn = t & 15; u.ko = 0; return true; }
    __device__ __forceinline__ void a_ready(const Unit&) const {
        if (threadIdx.x < 64) {
            unsigned polls = 0;
            while ((unsigned)__builtin_amdgcn_readfirstlane(__hip_atomic_load(cnt, __ATOMIC_RELAXED, __HIP_MEMORY_SCOPE_AGENT)) < need) { if (++polls > (1u << 22)) break; __builtin_amdgcn_s_sleep(2); }
            __builtin_amdgcn_fence(__ATOMIC_ACQUIRE, "agent");
            asm volatile("s_waitcnt vmcnt(0)" ::: "memory");
        }
        asm volatile("" ::: "memory"); __builtin_amdgcn_s_barrier(); asm volatile("" ::: "memory");
    }
    __device__ __forceinline__ void done(const Unit&) const {}
};
struct EpiResNorm {
    static constexpr bool PERM = true, AFTER_DRAIN = true;
    float* out; const float* ss_in; const float* gam; float* xbuf; unsigned* cnt;
    __device__ __forceinline__ void fused(f32x4 (&acc)[2][2][4][2], const Unit& u, int wr, int wc, int fr, int fq, PG8_LAS unsigned char* lds, int wid, int lane) const {
        PG8_LAS float* P = (PG8_LAS float*)lds;
        PG8_LAS float* S = (PG8_LAS float*)(lds + 4096);
        const int row0 = u.pm * BM + wr * 64 + fr, col0 = u.pn * BM + wc * 32 + 8 * fq;
#pragma unroll
        for (int ai = 0; ai < 2; ++ai)
#pragma unroll
            for (int m = 0; m < 4; ++m) {
                const int row = row0 + ai * HALF + m * 16;
                const PG8_GAS f32x4* sp = (const PG8_GAS f32x4*)(ss_in + (size_t)row * 16);
                const f32x4 s0 = sp[0], s1 = sp[1], s2 = sp[2], s3 = sp[3];
                const f32x4 st = (s0 + s1) + (s2 + s3);
                const float sc = 1.0f / (((st[0] + st[1]) + (st[2] + st[3])) * (1.0f / 1024.0f) + 1e-6f);
                const float* xin = out + (size_t)row * 1024 + col0;
                float ss = 0.f;
#pragma unroll
                for (int bj = 0; bj < 2; ++bj) {
                    const f32x4 a0 = *(const PG8_GAS f32x4*)(xin + bj * HALF), a1 = *(const PG8_GAS f32x4*)(xin + bj * HALF + 4);
                    const f32x4 v0 = a0 + acc[ai][bj][m][0] * sc, v1 = a1 + acc[ai][bj][m][1] * sc;
                    acc[ai][bj][m][0] = v0; acc[ai][bj][m][1] = v1;
                    ss += (v0[0] * v0[0] + v0[1] * v0[1]) + (v0[2] * v0[2] + v0[3] * v0[3]);
                    ss += (v1[0] * v1[0] + v1[1] * v1[1]) + (v1[2] * v1[2] + v1[3] * v1[3]);
                }
                ss += __shfl_xor(ss, 16); ss += __shfl_xor(ss, 32);
                if (fq == 0) P[(ai * HALF + wr * 64 + m * 16 + fr) * 4 + wc] = ss;
            }
        asm volatile("s_waitcnt lgkmcnt(0)" ::: "memory"); __builtin_amdgcn_s_barrier(); asm volatile("" ::: "memory");
        const int rowl = wid * 32 + (lane & 31);
        if (lane < 32) {
            const float t = (P[rowl * 4 + 0] + P[rowl * 4 + 1]) + (P[rowl * 4 + 2] + P[rowl * 4 + 3]);
            __hip_atomic_store(xbuf + ((size_t)(u.pm * BM + rowl) * 4 + u.pn), t, __ATOMIC_RELAXED, __HIP_MEMORY_SCOPE_AGENT);
        }
        asm volatile("s_waitcnt vmcnt(0)" ::: "memory");
        if (lane == 0) __hip_atomic_fetch_add(cnt + 64 * u.pm, 1u, __ATOMIC_RELAXED, __HIP_MEMORY_SCOPE_AGENT);
        if (wid == 0) {
            unsigned polls = 0;
            while ((unsigned)__builtin_amdgcn_readfirstlane(__hip_atomic_load(cnt + 64 * u.pm, __ATOMIC_RELAXED, __HIP_MEMORY_SCOPE_AGENT)) < 32u) { if (++polls > (1u << 22)) break; __builtin_amdgcn_s_sleep(2); }
            __builtin_amdgcn_fence(__ATOMIC_ACQUIRE, "agent");
        }
        asm volatile("s_waitcnt vmcnt(0) lgkmcnt(0)" ::: "memory"); __builtin_amdgcn_s_barrier(); asm volatile("" ::: "memory");
        if (lane < 32) {
            const float* slot = xbuf + (size_t)(u.pm * BM + rowl) * 4; float tot = 0.f;
#pragma unroll
            for (int t = 0; t < 4; ++t) tot += __hip_atomic_load(slot + t, __ATOMIC_RELAXED, __HIP_MEMORY_SCOPE_AGENT);
            S[rowl] = 1.0f / sqrtf(tot * (1.0f / 1024.0f) + 1e-6f);
        }
        asm volatile("s_waitcnt lgkmcnt(0)" ::: "memory"); __builtin_amdgcn_s_barrier(); asm volatile("" ::: "memory");
        f32x4 gv[2][2];
#pragma unroll
        for (int bj = 0; bj < 2; ++bj)
#pragma unroll
            for (int n = 0; n < 2; ++n) gv[bj][n] = *(const PG8_GAS f32x4*)(gam + col0 + bj * HALF + 4 * n);
#pragma unroll
        for (int ai = 0; ai < 2; ++ai)
#pragma unroll
            for (int m = 0; m < 4; ++m) {
                const int rl = ai * HALF + wr * 64 + m * 16 + fr; const float rs = S[rl];
                float* op = out + (size_t)(u.pm * BM + rl) * 1024 + col0;
#pragma unroll
                for (int bj = 0; bj < 2; ++bj) { *(PG8_GAS f32x4*)(op + bj * HALF) = acc[ai][bj][m][0] * rs * gv[bj][0]; *(PG8_GAS f32x4*)(op + bj * HALF + 4) = acc[ai][bj][m][1] * rs * gv[bj][1]; }
            }
    }
};
template <class Epi, class Sched, bool ALIGN_EPI = false, bool SP2 = false>
__device__ __forceinline__ void gemm_phase(PG8_LAS unsigned char* lds, const Gemm g, const Sched& S, const Epi& E) {
    const int tid = threadIdx.x, wid = __builtin_amdgcn_readfirstlane(tid >> 6), lane = tid & 63, wr = wid >> 2, wc = wid & 3, fr = lane & 15, fq = lane >> 4;
    const int K = g.K, nt = K / BK, LD = g.ld ? g.ld : g.K;
    unsigned voffA[2], voffB[2];
#pragma unroll
    for (int i = 0; i < 2; ++i) { int R, C; stage_rc(tid * 16 + i * 8192, R, C); const int Rb = Epi::PERM ? ((R & ~31) + perm32(R & 31)) : R;
        voffA[i] = (unsigned)(R * LD + C) * 2u; voffB[i] = (unsigned)(Rb * LD + C) * 2u; }
    const size_t kstep = (size_t)(BK * 2);
    const size_t hstep = (size_t)HALF * LD * 2;
    const size_t tstep = 2 * hstep;
    const unsigned ldsw = (unsigned)wid * 1024u;
    const int aoff = lds_byte(wr * 64 + fr, fq * 8), boff = lds_byte(wc * 32 + fr, fq * 8);
#define PG8_SA(b, h) (((b) * 2 + (h)) * HTB)
#define PG8_SB(b, h) ((4 + (b) * 2 + (h)) * HTB)
#define PG8_STAGE(bufoff, gbase, voff) do { _Pragma("unroll") for (int _i = 0; _i < 2; ++_i) \
        __builtin_amdgcn_global_load_lds((const unsigned*)((const char*)(gbase) + (voff)[_i]), (PG8_LAS unsigned*)(lds + (bufoff) + ldsw + _i * 8192), 16, 0, 0); } while (0)
#define PG8_LDA(dst, b, h) do { _Pragma("unroll") for (int m = 0; m < 4; ++m) _Pragma("unroll") for (int k = 0; k < 2; ++k) dst[m][k] = *(const PG8_LAS bf16x8*)(lds + PG8_SA(b, h) + aoff + m * 2048 + k * 1024); } while (0)
#define PG8_LDB(dst, b, h) do { _Pragma("unroll") for (int n = 0; n < 2; ++n) _Pragma("unroll") for (int k = 0; k < 2; ++k) dst[n][k] = *(const PG8_LAS bf16x8*)(lds + PG8_SB(b, h) + boff + n * 2048 + k * 1024); } while (0)
#define PG8_MMA(ai, bj, At, Bt) do { __builtin_amdgcn_s_setprio(1); _Pragma("unroll") for (int m = 0; m < 4; ++m) _Pragma("unroll") for (int n = 0; n < 2; ++n) _Pragma("unroll") for (int k = 0; k < 2; ++k) \
        acc[ai][bj][m][n] = __builtin_amdgcn_mfma_f32_16x16x32_bf16(Bt[n][k], At[m][k], acc[ai][bj][m][n], 0, 0, 0); __builtin_amdgcn_s_setprio(0); } while (0)
#define PG8_WAIT_V(n) asm volatile("s_waitcnt vmcnt(" #n ")" ::: "memory")
#define PG8_WAIT_L(n) asm volatile("s_waitcnt lgkmcnt(" #n ")" ::: "memory")
#define PG8_BAR __builtin_amdgcn_s_barrier()
#define PG8_SCHED __builtin_amdgcn_sched_barrier(0)
    Unit cur, nxt; int ui = 0;
    if (!S.next(0, cur)) return;
    f32x4 acc[2][2][4][2];
#pragma unroll
    for (int a = 0; a < 2; ++a)
#pragma unroll
        for (int b = 0; b < 2; ++b)
#pragma unroll
            for (int m = 0; m < 4; ++m)
#pragma unroll
                for (int n = 0; n < 2; ++n) acc[a][b][m][n] = (f32x4){0.f, 0.f, 0.f, 0.f};
    bf16x8 At[4][2], B0[2][2], B1[2][2];
    const char* cA = (const char*)g.A + (size_t)cur.pm * tstep + (size_t)cur.ko * 2; const char* cB = (const char*)g.Bt + (size_t)cur.pn * tstep + (size_t)cur.ko * 2;
    S.a_ready(cur);
    if constexpr (SP2) {
        PG8_STAGE(PG8_SB(0, 0), cB, voffB); PG8_STAGE(PG8_SB(0, 1), cB + hstep, voffB); PG8_STAGE(PG8_SA(0, 0), cA, voffA); PG8_STAGE(PG8_SA(0, 1), cA + hstep, voffA);
        if (wr == 1) PG8_BAR;
        PG8_WAIT_V(2); PG8_BAR;
        PG8_STAGE(PG8_SB(1, 0), cB + kstep, voffB); PG8_STAGE(PG8_SA(1, 0), cA + kstep, voffA); PG8_STAGE(PG8_SB(1, 1), cB + hstep + kstep, voffB);
        PG8_WAIT_V(6); PG8_BAR;
    } else {
        PG8_STAGE(PG8_SB(0, 0), cB, voffB); PG8_STAGE(PG8_SA(0, 0), cA, voffA); PG8_STAGE(PG8_SB(0, 1), cB + hstep, voffB); PG8_STAGE(PG8_SA(0, 1), cA + hstep, voffA);
        if (wr == 1) PG8_BAR;
        PG8_WAIT_V(4); PG8_BAR;
        PG8_STAGE(PG8_SB(1, 0), cB + kstep, voffB); PG8_STAGE(PG8_SA(1, 0), cA + kstep, voffA); PG8_STAGE(PG8_SB(1, 1), cB + hstep + kstep, voffB);
        PG8_WAIT_V(6); PG8_BAR;
    }
    for (;;) {
        const bool has_next = S.next(ui + 1, nxt);
        const char* nA = has_next ? (const char*)g.A + (size_t)nxt.pm * tstep + (size_t)nxt.ko * 2 : cA; const char* nB = has_next ? (const char*)g.Bt + (size_t)nxt.pn * tstep + (size_t)nxt.ko * 2 : cB;
        for (int t = 0; t < nt; t += 2) {
            const bool last = (t == nt - 2);
            const char* a1 = cA + (size_t)(t + 1) * kstep;
            const char* a2 = last ? nA : cA + (size_t)(t + 2) * kstep; const char* b2 = last ? nB : cB + (size_t)(t + 2) * kstep;
            const char* a3 = a2 + kstep; const char* b3 = b2 + kstep;
            if (last && has_next) S.a_ready(nxt);
            if constexpr (SP2) {
            PG8_LDB(B0, 0, 0); PG8_LDB(B1, 0, 1); PG8_SCHED; PG8_LDA(At, 0, 0); PG8_STAGE(PG8_SA(1, 1), a1 + hstep, voffA);
            PG8_WAIT_V(8); PG8_WAIT_L(0); PG8_BAR; PG8_MMA(0, 0, At, B0); PG8_MMA(0, 1, At, B1); PG8_BAR; PG8_SCHED;
            PG8_LDA(At, 0, 1); PG8_STAGE(PG8_SB(0, 0), b2, voffB); PG8_STAGE(PG8_SB(0, 1), b2 + hstep, voffB); PG8_STAGE(PG8_SA(0, 0), a2, voffA);
            PG8_WAIT_V(8); PG8_WAIT_L(0); PG8_BAR; PG8_MMA(1, 0, At, B0); PG8_MMA(1, 1, At, B1); PG8_BAR; PG8_SCHED;
            PG8_LDB(B0, 1, 0); PG8_LDB(B1, 1, 1); PG8_SCHED; PG8_LDA(At, 1, 0); PG8_STAGE(PG8_SA(0, 1), a2 + hstep, voffA);
            PG8_WAIT_V(8); PG8_WAIT_L(0); PG8_BAR; PG8_MMA(0, 0, At, B0); PG8_MMA(0, 1, At, B1); PG8_BAR; PG8_SCHED;
            PG8_LDA(At, 1, 1); PG8_STAGE(PG8_SB(1, 0), b3, voffB); PG8_STAGE(PG8_SB(1, 1), b3 + hstep, voffB); PG8_STAGE(PG8_SA(1, 0), a3, voffA);
            PG8_WAIT_V(8); PG8_WAIT_L(0); PG8_BAR; PG8_MMA(1, 0, At, B0); PG8_MMA(1, 1, At, B1); PG8_BAR; PG8_SCHED;
            } else {
            PG8_LDB(B0, 0, 0); PG8_SCHED; PG8_LDA(At, 0, 0); PG8_STAGE(PG8_SA(1, 1), a1 + hstep, voffA);
            PG8_WAIT_L(8); PG8_BAR; PG8_WAIT_L(0); PG8_MMA(0, 0, At, B0); PG8_BAR; PG8_SCHED;
            PG8_LDB(B1, 0, 1); PG8_STAGE(PG8_SB(0, 0), b2, voffB);
            PG8_BAR; PG8_WAIT_L(0); PG8_MMA(0, 1, At, B1); PG8_BAR;
            PG8_LDA(At, 0, 1); PG8_STAGE(PG8_SA(0, 0), a2, voffA);
            PG8_BAR; PG8_WAIT_L(0); PG8_MMA(1, 0, At, B0); PG8_BAR; PG8_SCHED;
            PG8_STAGE(PG8_SB(0, 1), b2 + hstep, voffB);
            PG8_WAIT_V(6); PG8_BAR; PG8_MMA(1, 1, At, B1); PG8_BAR;
            PG8_LDB(B0, 1, 0); PG8_SCHED; PG8_LDA(At, 1, 0); PG8_STAGE(PG8_SA(0, 1), a2 + hstep, voffA);
            PG8_WAIT_L(8); PG8_BAR; PG8_WAIT_L(0); PG8_MMA(0, 0, At, B0); PG8_BAR; PG8_SCHED;
            PG8_LDB(B1, 1, 1); PG8_STAGE(PG8_SB(1, 0), b3, voffB);
            PG8_BAR; PG8_WAIT_L(0); PG8_MMA(0, 1, At, B1); PG8_BAR;
            PG8_LDA(At, 1, 1); PG8_STAGE(PG8_SA(1, 0), a3, voffA);
            PG8_BAR; PG8_WAIT_L(0); PG8_MMA(1, 0, At, B0); PG8_BAR; PG8_SCHED;
            PG8_STAGE(PG8_SB(1, 1), b3 + hstep, voffB);
            PG8_WAIT_V(6); PG8_BAR; PG8_MMA(1, 1, At, B1); PG8_BAR;
            }
        }
        if constexpr (ALIGN_EPI) { if (wr == 0) PG8_BAR; }
        if constexpr (!Epi::AFTER_DRAIN) { E(acc, cur, wr, wc, fr, fq); S.done(cur); }
        if (!has_next) break;
#pragma unroll
        for (int a = 0; a < 2; ++a)
#pragma unroll
            for (int b = 0; b < 2; ++b)
#pragma unroll
                for (int m = 0; m < 4; ++m)
#pragma unroll
                    for (int n = 0; n < 2; ++n) acc[a][b][m][n] = (f32x4){0.f, 0.f, 0.f, 0.f};
        cur = nxt; cA = nA; cB = nB; ++ui;
        if constexpr (ALIGN_EPI) { if (wr == 1) PG8_BAR; }
    }
    PG8_WAIT_V(0);
    if constexpr (!ALIGN_EPI) { if (wr == 0) PG8_BAR; }
    PG8_BAR;
    if constexpr (Epi::AFTER_DRAIN) { E.fused(acc, cur, wr, wc, fr, fq, lds, wid, lane); S.done(cur); }
#undef PG8_SA
#undef PG8_SB
#undef PG8_STAGE
#undef PG8_LDA
#undef PG8_LDB
#undef PG8_MMA
#undef PG8_WAIT_V
#undef PG8_WAIT_L
#undef PG8_BAR
#undef PG8_SCHED
}
}
constexpr int DM = 1024, TP = 16384, TS = 1024, TT = TP + TS, SEQ = 2048, DSEQ = 8, DBATCH = 128;
constexpr int IC = 3328, RWC = 1792, PRW = 1536, FFD = 4096;
constexpr size_t MiB = 1u << 20;
constexpr size_t WS_WIN = 0, WS_WOUT = 7 * MiB, WS_WFF1 = 9 * MiB, WS_WFF2 = 17 * MiB, WS_W2T = 25 * MiB, WS_A2T = WS_W2T + 65536, WS_G2T = WS_A2T + 65536;
constexpr size_t WS_SS1 = 26 * MiB, WS_SS2 = 28 * MiB, WS_XN = 30 * MiB, WS_XG = 64 * MiB, WS_PROJ = 98 * MiB, WS_H = 98 * MiB, WS_END = 234 * MiB;
constexpr size_t O_Y = 0, O_CONVP = (size_t)TT * 1024, O_SHIFTP = O_CONVP + 8192, O_WKVP = O_SHIFTP + 14336, O_CONVS = O_WKVP + 262144, O_SHIFTS = O_CONVS + 131072, O_WKVS = O_SHIFTS + 229376;
constexpr size_t OS_YRAW = 0, OS_G = (size_t)TT * 512, OS_V = OS_G + (size_t)TT * 256;
constexpr size_t WS_WD = 30 * MiB, WS_KK = 64 * MiB, WS_BB = 81 * MiB, WS_KM = 209 * MiB, WS_RR = 226 * MiB, WS_RK = 27 * MiB + 262144;
constexpr int LDS_BYTES = 147456;
constexpr size_t WS_BAR = 29 * MiB + 524288, BAR_ZERO_BYTES = 131072;
constexpr size_t WS_PART = 30 * MiB;
constexpr size_t WS_XSTAT = 29 * MiB + 131072;
constexpr int LDS_BARST = 131072 + 64;

#define GAS __attribute__((address_space(1)))
#define LAS __attribute__((address_space(3)))
typedef unsigned short bf16;
typedef unsigned u32x4 __attribute__((ext_vector_type(4)));
typedef unsigned u32x2 __attribute__((ext_vector_type(2)));
typedef float f32x4 __attribute__((ext_vector_type(4)));
typedef short bf16x8 __attribute__((ext_vector_type(8)));
#define LDS_WAIT() asm volatile("s_waitcnt lgkmcnt(0)" ::: "memory")

__device__ __forceinline__ unsigned pk2(float lo, float hi) { return pg8::cvt_pk_bf16(lo, hi); }
__device__ __forceinline__ bf16 f2bf_sw(float f) { const unsigned u = __builtin_bit_cast(unsigned, f); return (bf16)((u + 0x7fffu + ((u >> 16) & 1u)) >> 16); }
__device__ __forceinline__ float bflo(unsigned u) { return __builtin_bit_cast(float, u << 16); }
__device__ __forceinline__ float bfhi(unsigned u) { return __builtin_bit_cast(float, u & 0xffff0000u); }
__device__ __forceinline__ u32x4 gld16(const void* p) { return *(const GAS u32x4*)p; }
__device__ __forceinline__ f32x4 gldf4(const float* p) { return *(const GAS f32x4*)p; }
__device__ __forceinline__ void unpack8(const u32x4 u, float (&o)[8]) { o[0] = bflo(u.x); o[1] = bfhi(u.x); o[2] = bflo(u.y); o[3] = bfhi(u.y); o[4] = bflo(u.z); o[5] = bfhi(u.z); o[6] = bflo(u.w); o[7] = bfhi(u.w); }
__device__ __forceinline__ u32x4 pack8(const float (&v)[8]) { u32x4 w; w.x = pk2(v[0], v[1]); w.y = pk2(v[2], v[3]); w.z = pk2(v[4], v[5]); w.w = pk2(v[6], v[7]); return w; }
__device__ __forceinline__ float wave_sum(float v) {
#pragma unroll
    for (int o = 1; o < 64; o <<= 1) v += __shfl_xor(v, o);
    return v;
}
template <int CTRL> __device__ __forceinline__ float dppf(float x) { return __builtin_bit_cast(float, __builtin_amdgcn_update_dpp(0, __builtin_bit_cast(int, x), CTRL, 0xF, 0xF, true)); }
__device__ __forceinline__ float row16_sum(float x) {
    x += dppf<0xB1>(x); x += dppf<0x4E>(x); x += dppf<0x124>(x); x += dppf<0x128>(x); return x;
}
__device__ __forceinline__ float sigmoidf_(float x) { return __builtin_amdgcn_rcpf(1.0f + __expf(-x)); }
__device__ __forceinline__ float tanhf_(float x) { const float e = __expf(2.0f * x); return 1.0f - 2.0f * __builtin_amdgcn_rcpf(e + 1.0f); }

struct Args { const float* in[24]; float* out; unsigned char* ws; int ph_lo, ph_hi, li, pad; };

__device__ __forceinline__ void p0_transpose_item(const float* W, int K, int N, bf16* WT, LAS float* scr, int item, int lane) {
    const int nblk = N / 32, kb = item / nblk, nb = item % nblk, k0 = 64 * kb, n0 = 32 * nb;
#pragma unroll 8
    for (int i = 0; i < 32; ++i) { const int kk = 2 * i + (lane >> 5); scr[kk * 33 + (lane & 31)] = W[(size_t)(k0 + kk) * N + n0 + (lane & 31)]; }
    LDS_WAIT(); asm volatile("" ::: "memory");
    const int c = lane & 7;
#pragma unroll
    for (int j = 0; j < 4; ++j) { const int n = (lane >> 3) + 8 * j; const LAS float* s = scr + (8 * c) * 33 + n;
        u32x4 o; o.x = pk2(s[0 * 33], s[1 * 33]); o.y = pk2(s[2 * 33], s[3 * 33]); o.z = pk2(s[4 * 33], s[5 * 33]); o.w = pk2(s[6 * 33], s[7 * 33]);
        *(GAS u32x4*)(WT + (size_t)(n0 + n) * K + k0 + 8 * c) = o; }
    LDS_WAIT(); asm volatile("" ::: "memory");
}
__device__ __forceinline__ void rms_row_to_bf16(const float* xrow, const float* g, bf16* orow, int lane) {
    const GAS f32x4* xr = (const GAS f32x4*)xrow + lane; const GAS f32x4* gr = (const GAS f32x4*)g + lane;
    f32x4 v[4]; float s2 = 0.f;
#pragma unroll
    for (int j = 0; j < 4; ++j) { v[j] = xr[64 * j]; s2 += (v[j].x * v[j].x + v[j].y * v[j].y) + (v[j].z * v[j].z + v[j].w * v[j].w); }
    const float rstd = 1.0f / sqrtf(wave_sum(s2) * (1.f / DM) + 1e-6f);
    GAS u32x2* o8 = (GAS u32x2*)orow + lane;
#pragma unroll
    for (int j = 0; j < 4; ++j) { const f32x4 gg = gr[64 * j]; u32x2 w; w.x = pk2(v[j].x * rstd * gg.x, v[j].y * rstd * gg.y); w.y = pk2(v[j].z * rstd * gg.z, v[j].w * rstd * gg.w); o8[64 * j] = w; }
}

constexpr int SB_W = 0, SB_B = 2048, SB_K = 4096, SB_KK = 6144, SB_R = 8192, SB_V = 10240, SB_BETA = 12288, SB_BYTES = 49280, STG_OFF = 2 * SB_BYTES, STG_BYTES = 4608;

__device__ __forceinline__ void load_xm8(const bf16* prow, int c, bool first, const float* shift0, const float* mu, float (&o)[8]) {
    float cur[8], prv[8];
    unpack8(gld16(prow + c), cur);
    if (!first) { unpack8(gld16(prow - IC + c), prv); }
    else if (shift0) { const f32x4 a = gldf4(shift0 + c), b = gldf4(shift0 + c + 4); prv[0] = a.x; prv[1] = a.y; prv[2] = a.z; prv[3] = a.w; prv[4] = b.x; prv[5] = b.y; prv[6] = b.z; prv[7] = b.w; }
    else {
#pragma unroll
        for (int i = 0; i < 8; ++i) prv[i] = 0.f;
    }
    const f32x4 m0 = gldf4(mu + c), m1 = gldf4(mu + c + 4);
    const float mm[8] = {m0.x, m0.y, m0.z, m0.w, m1.x, m1.y, m1.z, m1.w};
#pragma unroll
    for (int i = 0; i < 8; ++i) o[i] = cur[i] + (prv[i] - cur[i]) * mm[i];
}

constexpr int PREP_MU = 10752, PREP_SCR = 12544;
__device__ __forceinline__ void prep_cols(int h, int cgp, int (&col)[7]) {
    col[0] = h * 64 + 8 * cgp; col[1] = 512 + h * 64 + 8 * cgp; col[2] = 1024 + h * 64 + 8 * cgp; col[3] = 1536 + 8 * cgp; col[4] = 1600 + 8 * cgp; col[5] = 1664 + 16 * cgp; col[6] = 1664 + 16 * cgp + 8;
}
struct PrepRaw { u32x4 c[7]; u32x4 p[7]; };
__device__ __forceinline__ void prep_load(const Args& a, PrepRaw& R, int lane, int row0, int h) {
    const bool smp = row0 >= TP;
    const int tok = lane >> 3, cgp = lane & 7, row = row0 + tok;
    const int t = smp ? tok : (row & 2047);
    const bf16* prow = (const bf16*)(a.ws + WS_PROJ) + (size_t)row * IC + PRW;
    int col[7]; prep_cols(h, cgp, col);
#pragma unroll
    for (int i = 0; i < 7; ++i) { R.c[i] = gld16(prow + col[i]); R.p[i] = (u32x4){0u, 0u, 0u, 0u}; }
    if (t != 0) {
#pragma unroll
        for (int i = 0; i < 7; ++i) R.p[i] = gld16(prow - IC + col[i]);
    }
}
__device__ __forceinline__ void xm8_raw(const u32x4 cu, const u32x4 pu, int c, bool fs, const float* shift0, const float* mu, float (&o)[8]) {
    float cur[8], prv[8];
    unpack8(cu, cur); unpack8(pu, prv);
    if (fs) { const f32x4 a = gldf4(shift0 + c), b = gldf4(shift0 + c + 4); prv[0] = a.x; prv[1] = a.y; prv[2] = a.z; prv[3] = a.w; prv[4] = b.x; prv[5] = b.y; prv[6] = b.z; prv[7] = b.w; }
    const f32x4 m0 = gldf4(mu + c), m1 = gldf4(mu + c + 4);
    const float mm[8] = {m0.x, m0.y, m0.z, m0.w, m1.x, m1.y, m1.z, m1.w};
#pragma unroll
    for (int i = 0; i < 8; ++i) o[i] = cur[i] + (prv[i] - cur[i]) * mm[i];
}
__device__ __forceinline__ void xm8_pre(const u32x4 cu, const u32x4 pu, int c, bool fs, const float* shift0, const f32x4 m0, const f32x4 m1, float (&o)[8]) {
    float cur[8], prv[8];
    unpack8(cu, cur); unpack8(pu, prv);
    if (fs) { const f32x4 a = gldf4(shift0 + c), b = gldf4(shift0 + c + 4); prv[0] = a.x; prv[1] = a.y; prv[2] = a.z; prv[3] = a.w; prv[4] = b.x; prv[5] = b.y; prv[6] = b.z; prv[7] = b.w; }
    const float mm[8] = {m0.x, m0.y, m0.z, m0.w, m1.x, m1.y, m1.z, m1.w};
#pragma unroll
    for (int i = 0; i < 8; ++i) o[i] = cur[i] + (prv[i] - cur[i]) * mm[i];
}
struct PrepConst { int unused; };
__device__ __forceinline__ void prep_item(const Args& a, const PrepConst& C, const PrepRaw& R, LAS unsigned char* scr, int lane, int row0, int h) {
    const bool smp = row0 >= TP;
    const int b = smp ? ((row0 - TP) >> 3) : (row0 >> 11);
    const int tok = lane >> 3, cgp = lane & 7;
    const int row = row0 + tok;
    const int t = smp ? tok : (row & 2047);
    const bool fs = (t == 0) && smp;
    const float* shift0 = a.in[3] + (size_t)b * RWC;
    int col[7]; prep_cols(h, cgp, col);
    const LAS float* MUs = (const LAS float*)(scr + PREP_MU);
    LAS float* KKs = (LAS float*)scr; LAS float* KRs = KKs + 512; LAS float* Rs = KRs + 512;
    LAS bf16* Lw = (LAS bf16*)(scr + 6144); LAS bf16* La = Lw + 8 * 72; LAS bf16* Lg = La + 8 * 72;
    const size_t go = (size_t)row * 512 + h * 64 + 8 * cgp;
    {
        float xr[8], xk[8], xv[8];
        xm8_pre(R.c[0], R.p[0], col[0], fs, shift0, *(const LAS f32x4*)(MUs + (0 * 8 + cgp) * 8), *(const LAS f32x4*)(MUs + (0 * 8 + cgp) * 8 + 4), xr);
        xm8_pre(R.c[1], R.p[1], col[1], fs, shift0, *(const LAS f32x4*)(MUs + (1 * 8 + cgp) * 8), *(const LAS f32x4*)(MUs + (1 * 8 + cgp) * 8 + 4), xk);
        xm8_pre(R.c[2], R.p[2], col[2], fs, shift0, *(const LAS f32x4*)(MUs + (2 * 8 + cgp) * 8), *(const LAS f32x4*)(MUs + (2 * 8 + cgp) * 8 + 4), xv);
        *(GAS u32x4*)((bf16*)(a.ws + WS_RR) + go) = pack8(xr);
        *(GAS u32x4*)((bf16*)(a.out + OS_V) + go) = pack8(xv);
        *(LAS f32x4*)(Rs + tok * 64 + 8 * cgp) = (f32x4){xr[0], xr[1], xr[2], xr[3]}; *(LAS f32x4*)(Rs + tok * 64 + 8 * cgp + 4) = (f32x4){xr[4], xr[5], xr[6], xr[7]};
        *(LAS f32x4*)(KRs + tok * 64 + 8 * cgp) = (f32x4){xk[0], xk[1], xk[2], xk[3]}; *(LAS f32x4*)(KRs + tok * 64 + 8 * cgp + 4) = (f32x4){xk[4], xk[5], xk[6], xk[7]};
        const f32x4 c0 = gldf4(a.in[14] + h * 64 + 8 * cgp), c1 = gldf4(a.in[14] + h * 64 + 8 * cgp + 4);
        float kkv[8] = {xk[0] * c0.x, xk[1] * c0.y, xk[2] * c0.z, xk[3] * c0.w, xk[4] * c1.x, xk[5] * c1.y, xk[6] * c1.z, xk[7] * c1.w};
        float n2 = 0.f;
#pragma unroll
        for (int i = 0; i < 8; ++i) n2 += kkv[i] * kkv[i];
        n2 += __shfl_xor(n2, 1); n2 += __shfl_xor(n2, 2); n2 += __shfl_xor(n2, 4);
        const float inv = __builtin_amdgcn_rsqf(fmaxf(n2, 1e-24f));
#pragma unroll
        for (int i = 0; i < 8; ++i) kkv[i] *= inv;
        *(GAS u32x4*)((bf16*)(a.ws + WS_KK) + go) = pack8(kkv);
        *(LAS f32x4*)(KKs + tok * 64 + 8 * cgp) = (f32x4){kkv[0], kkv[1], kkv[2], kkv[3]}; *(LAS f32x4*)(KKs + tok * 64 + 8 * cgp + 4) = (f32x4){kkv[4], kkv[5], kkv[6], kkv[7]};
    }
    {
        float xw[8], xa[8], xg[8];
        xm8_pre(R.c[3], R.p[3], col[3], fs, shift0, *(const LAS f32x4*)(MUs + (3 * 8 + cgp) * 8), *(const LAS f32x4*)(MUs + (3 * 8 + cgp) * 8 + 4), xw);
#pragma unroll
        for (int i = 0; i < 8; ++i) xw[i] = tanhf_(xw[i]);
        *(LAS u32x4*)(Lw + tok * 72 + 8 * cgp) = pack8(xw);
        xm8_pre(R.c[4], R.p[4], col[4], fs, shift0, *(const LAS f32x4*)(MUs + (4 * 8 + cgp) * 8), *(const LAS f32x4*)(MUs + (4 * 8 + cgp) * 8 + 4), xa);
        *(LAS u32x4*)(La + tok * 72 + 8 * cgp) = pack8(xa);
        xm8_pre(R.c[5], R.p[5], col[5], fs, shift0, *(const LAS f32x4*)(MUs + (5 * 8 + cgp) * 8), *(const LAS f32x4*)(MUs + (5 * 8 + cgp) * 8 + 4), xg);
#pragma unroll
        for (int i = 0; i < 8; ++i) xg[i] = sigmoidf_(xg[i]);
        *(LAS u32x4*)(Lg + tok * 136 + 16 * cgp) = pack8(xg);
        xm8_pre(R.c[6], R.p[6], col[6], fs, shift0, *(const LAS f32x4*)(MUs + (6 * 8 + cgp) * 8), *(const LAS f32x4*)(MUs + (6 * 8 + cgp) * 8 + 4), xg);
#pragma unroll
        for (int i = 0; i < 8; ++i) xg[i] = sigmoidf_(xg[i]);
        *(LAS u32x4*)(Lg + tok * 136 + 16 * cgp + 8) = pack8(xg);
    }
    LDS_WAIT();
    const int fr = lane & 15, fq = lane >> 4, arow = fr & 7;
    const bf16* W2T = (const bf16*)(a.ws + WS_W2T); const bf16* A2T = (const bf16*)(a.ws + WS_A2T); const bf16* G2T = (const bf16*)(a.ws + WS_G2T);
    const bf16x8 Aw0 = *(const LAS bf16x8*)(Lw + arow * 72 + 8 * fq), Aw1 = *(const LAS bf16x8*)(Lw + arow * 72 + 32 + 8 * fq);
    const bf16x8 Aa0 = *(const LAS bf16x8*)(La + arow * 72 + 8 * fq), Aa1 = *(const LAS bf16x8*)(La + arow * 72 + 32 + 8 * fq);
    f32x4 accw[4], acca[4];
#pragma unroll
    for (int nt = 0; nt < 4; ++nt) {
        const size_t bo = (size_t)(h * 64 + 16 * nt + fr) * 64 + 8 * fq;
        const bf16x8 bw0 = __builtin_bit_cast(bf16x8, gld16(W2T + bo)), bw1 = __builtin_bit_cast(bf16x8, gld16(W2T + bo + 32));
        const bf16x8 ba0 = __builtin_bit_cast(bf16x8, gld16(A2T + bo)), ba1 = __builtin_bit_cast(bf16x8, gld16(A2T + bo + 32));
        f32x4 z = {0.f, 0.f, 0.f, 0.f};
        accw[nt] = __builtin_amdgcn_mfma_f32_16x16x32_bf16(Aw0, bw0, z, 0, 0, 0); accw[nt] = __builtin_amdgcn_mfma_f32_16x16x32_bf16(Aw1, bw1, accw[nt], 0, 0, 0);
        acca[nt] = __builtin_amdgcn_mfma_f32_16x16x32_bf16(Aa0, ba0, z, 0, 0, 0); acca[nt] = __builtin_amdgcn_mfma_f32_16x16x32_bf16(Aa1, ba1, acca[nt], 0, 0, 0);
    }
    const bool lowh = fq < 2;
    const int ntb = lowh ? 0 : 2, tokb = 4 * (fq & 1);
    f32x4 Wsel[2], Asel[2];
    Wsel[0] = lowh ? accw[0] : accw[2]; Wsel[1] = lowh ? accw[1] : accw[3];
    Asel[0] = lowh ? acca[0] : acca[2]; Asel[1] = lowh ? acca[1] : acca[3];
    float rkp[4] = {0.f, 0.f, 0.f, 0.f};
    float* WD = (float*)(a.ws + WS_WD); bf16* BBp = (bf16*)(a.ws + WS_BB); bf16* KMp = (bf16*)(a.ws + WS_KM);
#pragma unroll
    for (int u = 0; u < 2; ++u) {
        const int c = 16 * (ntb + u) + fr, hc = h * 64 + c;
        const float w0c = a.in[9][hc], a0c = a.in[11][hc], kac = a.in[15][hc], rkc = a.in[16][hc];
#pragma unroll
        for (int e = 0; e < 4; ++e) {
            const int o = (tokb + e) * 64 + c;
            const float sg = sigmoidf_(Wsel[u][e] + w0c);
            const float decay = __expf(-0.6065306597126334f * sg);
            const float av = sigmoidf_(Asel[u][e] + a0c);
            const float kkv = KKs[o], kr = KRs[o], rv = Rs[o];
            const float kmod = kr * (1.0f + (av - 1.0f) * kac);
            Rs[o] = decay; KKs[o] = kkv * av; KRs[o] = kmod;
            rkp[e] += rv * kmod * rkc;
        }
    }
    float* RK = (float*)(a.ws + WS_RK);
#pragma unroll
    for (int e = 0; e < 4; ++e) { rkp[e] = row16_sum(rkp[e]); rkp[e] += __shfl_xor(rkp[e], 32); }
    if (fr == 0 && lowh) {
#pragma unroll
        for (int e = 0; e < 4; ++e) RK[(size_t)(row0 + tokb + e) * 8 + h] = rkp[e];
    }
    LDS_WAIT();
    {
        const LAS float* ps = Rs + tok * 64 + 8 * cgp; const f32x4 d0 = *(const LAS f32x4*)ps, d1 = *(const LAS f32x4*)(ps + 4);
        *(GAS f32x4*)(WD + go) = d0; *(GAS f32x4*)(WD + go + 4) = d1;
        const LAS float* pb = KKs + tok * 64 + 8 * cgp; const f32x4 b0 = *(const LAS f32x4*)pb, b1 = *(const LAS f32x4*)(pb + 4);
        const float bv[8] = {b0.x, b0.y, b0.z, b0.w, b1.x, b1.y, b1.z, b1.w};
        *(GAS u32x4*)(BBp + go) = pack8(bv);
        const LAS float* pk = KRs + tok * 64 + 8 * cgp; const f32x4 k0 = *(const LAS f32x4*)pk, k1 = *(const LAS f32x4*)(pk + 4);
        const float kv[8] = {k0.x, k0.y, k0.z, k0.w, k1.x, k1.y, k1.z, k1.w};
        *(GAS u32x4*)(KMp + go) = pack8(kv);
    }
    bf16x8 Ag[4];
#pragma unroll
    for (int ks = 0; ks < 4; ++ks) Ag[ks] = *(const LAS bf16x8*)(Lg + arow * 136 + 32 * ks + 8 * fq);
    bf16* Gb = (bf16*)(a.out + OS_G);
    LDS_WAIT();
    LAS float* Gs = (LAS float*)Lw;
    for (int nt = 0; nt < 4; ++nt) {
        const size_t bo = (size_t)(h * 64 + 16 * nt + fr) * 128 + 8 * fq;
        f32x4 acc = {0.f, 0.f, 0.f, 0.f};
#pragma unroll
        for (int ks = 0; ks < 4; ++ks) acc = __builtin_amdgcn_mfma_f32_16x16x32_bf16(Ag[ks], __builtin_bit_cast(bf16x8, gld16(G2T + bo + 32 * ks)), acc, 0, 0, 0);
        if (lowh) {
#pragma unroll
            for (int e = 0; e < 4; ++e) Gs[(4 * fq + e) * 64 + 16 * nt + fr] = acc[e];
        }
    }
    LDS_WAIT();
    {
        const LAS float* pg = Gs + tok * 64 + 8 * cgp; const f32x4 g0 = *(const LAS f32x4*)pg, g1 = *(const LAS f32x4*)(pg + 4);
        const float gv[8] = {g0.x, g0.y, g0.z, g0.w, g1.x, g1.y, g1.z, g1.w};
        *(GAS u32x4*)(Gb + go) = pack8(gv);
    }
    LDS_WAIT();
}

struct LdRaw { f32x4 w0, w1; u32x4 kk, b, k, r, v, kkn; };
__device__ __forceinline__ void loader_load(const Args& a, LdRaw& R, int pw, int lane, bool is_sample, int chain, int t0) {
    const int b = chain >> 3, h = chain & 7, tok = lane >> 3, cgp = lane & 7;
    const int row = (is_sample ? TP + b * DSEQ : b * SEQ + t0 + 8 * pw) + tok;
    const size_t go = (size_t)row * 512 + h * 64 + 8 * cgp;
    R.w0 = gldf4((const float*)(a.ws + WS_WD) + go); R.w1 = gldf4((const float*)(a.ws + WS_WD) + go + 4);
    R.kk = gld16((const bf16*)(a.ws + WS_KK) + go); R.b = gld16((const bf16*)(a.ws + WS_BB) + go); R.k = gld16((const bf16*)(a.ws + WS_KM) + go);
    R.r = gld16((const bf16*)(a.ws + WS_RR) + go); R.v = gld16((const bf16*)(a.out + OS_V) + go);
    R.kkn = gld16((const bf16*)(a.ws + WS_KK) + go + 512);
}
__device__ __forceinline__ void st8(LAS float* p, const u32x4 u) {
    float f[8]; unpack8(u, f);
    *(LAS f32x4*)p = (f32x4){f[0], f[1], f[2], f[3]}; *(LAS f32x4*)(p + 4) = (f32x4){f[4], f[5], f[6], f[7]};
}
__device__ __forceinline__ void loader_store(const LdRaw& R, LAS unsigned char* lds, int buf, int pw, int lane) {
    LAS float* B = (LAS float*)(lds + buf * SB_BYTES);
    const int o = (8 * pw + (lane >> 3)) * 64 + 8 * (lane & 7);
    *(LAS f32x4*)(B + SB_W + o) = R.w0; *(LAS f32x4*)(B + SB_W + o + 4) = R.w1;
    st8(B + SB_KK + o, R.kk); st8(B + SB_B + o, R.b); st8(B + SB_K + o, R.k); st8(B + SB_R + o, R.r); st8(B + SB_V + o, R.v);
    float bb[8], kn[8]; unpack8(R.b, bb); unpack8(R.kkn, kn);
    float part = 0.f;
#pragma unroll
    for (int i = 0; i < 8; ++i) part += bb[i] * kn[i];
    part += __shfl_xor(part, 1); part += __shfl_xor(part, 2); part += __shfl_xor(part, 4);
    if ((lane & 7) == 0) B[SB_BETA + 8 * pw + (lane >> 3)] = part;
}

typedef float f32x2 __attribute__((ext_vector_type(2)));
struct StepOps { f32x4 kk, w, b, k, r; float v; };
__device__ __forceinline__ void ld_step(StepOps& o, const LAS float* B, int off, int voff) {
    o.kk = *(const LAS f32x4*)(B + SB_KK + off); o.w = *(const LAS f32x4*)(B + SB_W + off); o.b = *(const LAS f32x4*)(B + SB_B + off);
    o.k = *(const LAS f32x4*)(B + SB_K + off); o.r = *(const LAS f32x4*)(B + SB_R + off); o.v = B[SB_V + voff];
}
__device__ __forceinline__ float wkv_step2(f32x2& Sa, f32x2& Sb, const f32x4 kk, const f32x4 w, const f32x4 b, const f32x4 k, const f32x4 r, const float vv) {
    f32x2 t = Sa * (f32x2){kk.x, kk.y}; t = Sb * (f32x2){kk.z, kk.w} + t;
    const float p = row16_sum(t.x + t.y);
    const float nu = -p;
    Sa = Sa * (f32x2){w.x, w.y} + (f32x2){b.x, b.y} * nu + (f32x2){k.x, k.y} * vv;
    Sb = Sb * (f32x2){w.z, w.w} + (f32x2){b.z, b.w} * nu + (f32x2){k.z, k.w} * vv;
    f32x2 u = Sa * (f32x2){r.x, r.y}; u = Sb * (f32x2){r.z, r.w} + u;
    return row16_sum(u.x + u.y);
}
__device__ __forceinline__ float wkv_step(f32x4& S, const f32x4 kk, const f32x4 w, const f32x4 b, const f32x4 k, const f32x4 r, const float vv) {
    f32x2 Sa = {S.x, S.y}, Sb = {S.z, S.w};
    const float y = wkv_step2(Sa, Sb, kk, w, b, k, r, vv);
    S = (f32x4){Sa.x, Sa.y, Sb.x, Sb.y};
    return y;
}

__device__ __forceinline__ void p2_scan(const Args& a, LAS unsigned char* lds, int G, int vcu, int wave, int lane) {
    const int nPI = (vcu < 256) ? (256 - vcu + G - 1) / G : 0;
    const int nSG = nPI;
    const int NT = nPI * 64 + nSG;
    const bool scanw = wave < 4;
    const int sw = wave & 3;
    const int jj = lane & 15, lr = 4 * sw + (lane >> 4);
    float* Yraw = a.out + OS_YRAW;
    f32x4 S = {0.f, 0.f, 0.f, 0.f};
#define TASK_DECODE(j, is_sample, item, chunk) const bool is_sample = (j) >= nPI * 64; const int item = is_sample ? vcu + ((j) - nPI * 64) * G : vcu + ((j) >> 6) * G; const int chunk = (j) & 63;
    LdRaw R;
    R.w0 = R.w1 = (f32x4){0.f, 0.f, 0.f, 0.f}; R.kk = R.b = R.k = R.r = R.v = R.kkn = (u32x4){0u, 0u, 0u, 0u};
    if (!scanw && NT > 0) {
        { TASK_DECODE(0, smp, item, chunk); loader_load(a, R, sw, lane, smp, smp ? 4 * item + sw : (item >> 2), chunk * 32); loader_store(R, lds, 0, sw, lane); }
        if (NT > 1) { TASK_DECODE(1, smp, item, chunk); loader_load(a, R, sw, lane, smp, smp ? 4 * item + sw : (item >> 2), chunk * 32); }
    }
    LDS_WAIT(); __builtin_amdgcn_s_barrier(); asm volatile("" ::: "memory");
    for (int j = 0; j < NT; ++j) {
        if (scanw) {
            TASK_DECODE(j, smp, item, chunk);
            const LAS float* B = (const LAS float*)(lds + (j & 1) * SB_BYTES);
            if (!smp) {
                const int chain = item >> 2, q = item & 3, b = chain >> 3, h = chain & 7;
                if (chunk == 0) S = (f32x4){0.f, 0.f, 0.f, 0.f};
                const int rowb = b * SEQ + chunk * 32;
                const int vrow = 16 * q + lr;
                f32x2 Sa = {S.x, S.y}, Sb = {S.z, S.w};
                StepOps c0, c1, c2;
                ld_step(c0, B, 4 * jj, vrow); ld_step(c1, B, 64 + 4 * jj, 64 + vrow);
                float p;
                { f32x2 t = Sa * (f32x2){c0.kk.x, c0.kk.y}; t = Sb * (f32x2){c0.kk.z, c0.kk.w} + t; p = row16_sum(t.x + t.y); }
                for (int blk = 0; blk < 2; ++blk) {
                    float ykeep = 0.f;
#pragma unroll
                    for (int s2 = 0; s2 < 16; ++s2) {
                        const int sc_ = blk * 16 + s2;
                        const int sn = (sc_ + 2) & 31;
                        ld_step(c2, B, sn * 64 + 4 * jj, sn * 64 + vrow);
                        const float beta = B[SB_BETA + sc_];
                        const f32x2 Aa = Sa * (f32x2){c0.w.x, c0.w.y} + (f32x2){c0.k.x, c0.k.y} * c0.v;
                        const f32x2 Ab = Sb * (f32x2){c0.w.z, c0.w.w} + (f32x2){c0.k.z, c0.k.w} * c0.v;
                        f32x2 tq = Aa * (f32x2){c1.kk.x, c1.kk.y}; tq = Ab * (f32x2){c1.kk.z, c1.kk.w} + tq;
                        const float q = row16_sum(tq.x + tq.y);
                        const float np = -p;
                        Sa = Aa + (f32x2){c0.b.x, c0.b.y} * np; Sb = Ab + (f32x2){c0.b.z, c0.b.w} * np;
                        f32x2 u = Sa * (f32x2){c0.r.x, c0.r.y}; u = Sb * (f32x2){c0.r.z, c0.r.w} + u;
                        const float y = row16_sum(u.x + u.y);
                        ykeep = (s2 == jj) ? y : ykeep;
                        p = q + np * beta;
                        c0 = c1; c1 = c2;
                    }
                    Yraw[(size_t)(rowb + blk * 16 + jj) * 512 + h * 64 + vrow] = ykeep;
                }
                S = (f32x4){Sa.x, Sa.y, Sb.x, Sb.y};
                if (chunk == 63) *(GAS f32x4*)(a.out + O_WKVP + ((size_t)(chain * 64 + vrow)) * 64 + 4 * jj) = S;
            } else {
                for (int cs = 0; cs < 4; ++cs) {
                    const int chain = 4 * item + cs, b = chain >> 3, h = chain & 7;
                    const float* st = a.in[4] + (size_t)chain * 4096;
                    f32x4 Sq[4]; float yk[4] = {0.f, 0.f, 0.f, 0.f};
#pragma unroll
                    for (int qq = 0; qq < 4; ++qq) Sq[qq] = gldf4(st + (16 * qq + lr) * 64 + 4 * jj);
#pragma unroll
                    for (int t = 0; t < 8; ++t) {
                        const int s = 8 * cs + t;
                        const f32x4 kk = *(const LAS f32x4*)(B + SB_KK + s * 64 + 4 * jj), w = *(const LAS f32x4*)(B + SB_W + s * 64 + 4 * jj), bb = *(const LAS f32x4*)(B + SB_B + s * 64 + 4 * jj);
                        const f32x4 k = *(const LAS f32x4*)(B + SB_K + s * 64 + 4 * jj), r = *(const LAS f32x4*)(B + SB_R + s * 64 + 4 * jj);
#pragma unroll
                        for (int qq = 0; qq < 4; ++qq) {
                            const float vv = B[SB_V + s * 64 + 16 * qq + lr];
                            const float y = wkv_step(Sq[qq], kk, w, bb, k, r, vv);
                            yk[qq] = (t == jj) ? y : yk[qq];
                        }
                    }
#pragma unroll
                    for (int qq = 0; qq < 4; ++qq) {
                        if (jj < 8) Yraw[(size_t)(TP + b * DSEQ + jj) * 512 + h * 64 + 16 * qq + lr] = yk[qq];
                        *(GAS f32x4*)(a.out + O_WKVS + ((size_t)(chain * 64 + 16 * qq + lr)) * 64 + 4 * jj) = Sq[qq];
                    }
                }
            }
        } else if (j + 1 < NT) {
            loader_store(R, lds, (j + 1) & 1, sw, lane);
            if (j + 2 < NT) { TASK_DECODE(j + 2, smp, item, chunk); loader_load(a, R, sw, lane, smp, smp ? 4 * item + sw : (item >> 2), chunk * 32); }
        }
        LDS_WAIT(); __builtin_amdgcn_s_barrier(); asm volatile("" ::: "memory");
    }
#undef TASK_DECODE
}

struct MixConst { f32x4 w[6]; f32x4 l[4]; };
struct MixRaw { u32x4 cb, cc0, cx0, cc1, cx1, cc2, cx2, g, v; f32x4 y0, y1; float rk; };
__device__ __forceinline__ void p3_load(const Args& a, MixRaw& R, int row, int lane) {
    const bool smp = row >= TP;
    const int t = smp ? ((row - TP) & 7) : (row & 2047);
    const bf16* pr = (const bf16*)(a.ws + WS_PROJ) + (size_t)row * IC;
    const int c8 = 8 * lane;
    const u32x4 z = {0u, 0u, 0u, 0u};
    R.cb = gld16(pr + c8); R.cc0 = gld16(pr + 512 + c8); R.cx0 = gld16(pr + 1024 + c8);
    R.cc1 = z; R.cx1 = z; R.cc2 = z; R.cx2 = z;
    if (t >= 1) { R.cc1 = gld16(pr - IC + 512 + c8); R.cx1 = gld16(pr - IC + 1024 + c8); }
    if (t >= 2) { R.cc2 = gld16(pr - 2 * IC + 512 + c8); R.cx2 = gld16(pr - 2 * IC + 1024 + c8); }
    const float* yr = a.out + OS_YRAW + (size_t)row * 512 + c8;
    R.y0 = gldf4(yr); R.y1 = gldf4(yr + 4);
    R.v = gld16((const bf16*)(a.out + OS_V) + (size_t)row * 512 + c8);
    R.g = gld16((const bf16*)(a.out + OS_G) + (size_t)row * 512 + c8);
    R.rk = ((const float*)(a.ws + WS_RK))[(size_t)row * 8 + (lane >> 3)];
}
__device__ __forceinline__ void p3_token(const Args& a, const MixConst& K, const MixRaw& R, int row, int lane) {
    const bool smp = row >= TP;
    const int rr = row - TP;
    const int b = smp ? (rr >> 3) : (row >> 11), t = smp ? (rr & 7) : (row & 2047), L = smp ? DSEQ : SEQ;
    const bf16* pr = (const bf16*)(a.ws + WS_PROJ) + (size_t)row * IC;
    const int c8 = 8 * lane;
    float yconv[8], yrw[8];
    {
        float cb[8], cc[8], cx[8], u0[8], f1[8], f2[8];
        unpack8(R.cb, cb); unpack8(R.cc0, cc); unpack8(R.cx0, cx);
#pragma unroll
        for (int i = 0; i < 8; ++i) u0[i] = cc[i] * cx[i];
        unpack8(R.cc1, cc); unpack8(R.cx1, cx);
#pragma unroll
        for (int i = 0; i < 8; ++i) f1[i] = cc[i] * cx[i];
        unpack8(R.cc2, cc); unpack8(R.cx2, cx);
#pragma unroll
        for (int i = 0; i < 8; ++i) f2[i] = cc[i] * cx[i];
        if (smp && t < 2) {
            const float* sc = a.in[2] + (size_t)b * 1024;
            if (t == 0) { const f32x4 s0 = gldf4(sc + 512 + c8), s1 = gldf4(sc + 512 + c8 + 4); f1[0] = s0.x; f1[1] = s0.y; f1[2] = s0.z; f1[3] = s0.w; f1[4] = s1.x; f1[5] = s1.y; f1[6] = s1.z; f1[7] = s1.w; }
            const float* sp = sc + (t == 1 ? 512 : 0) + c8; const f32x4 s0 = gldf4(sp), s1 = gldf4(sp + 4);
            f2[0] = s0.x; f2[1] = s0.y; f2[2] = s0.z; f2[3] = s0.w; f2[4] = s1.x; f2[5] = s1.y; f2[6] = s1.z; f2[7] = s1.w;
        }
        const f32x4 w00 = K.w[0], w01 = K.w[1], w10 = K.w[2], w11 = K.w[3], w20 = K.w[4], w21 = K.w[5];
        const float W0[8] = {w00.x, w00.y, w00.z, w00.w, w01.x, w01.y, w01.z, w01.w}, W1[8] = {w10.x, w10.y, w10.z, w10.w, w11.x, w11.y, w11.z, w11.w}, W2[8] = {w20.x, w20.y, w20.z, w20.w, w21.x, w21.y, w21.z, w21.w};
#pragma unroll
        for (int i = 0; i < 8; ++i) yconv[i] = cb[i] * (f2[i] * W0[i] + f1[i] * W1[i] + u0[i] * W2[i]);
        if (t >= L - 2) {
            float* oc = a.out + (smp ? O_CONVS : O_CONVP) + (size_t)b * 1024 + (t == L - 1 ? 512 : 0) + c8;
            *(GAS f32x4*)oc = (f32x4){u0[0], u0[1], u0[2], u0[3]}; *(GAS f32x4*)(oc + 4) = (f32x4){u0[4], u0[5], u0[6], u0[7]};
        }
    }
    {
        const f32x4 y0 = R.y0, y1 = R.y1;
        float y[8] = {y0.x, y0.y, y0.z, y0.w, y1.x, y1.y, y1.z, y1.w};
        float s = 0.f;
#pragma unroll
        for (int i = 0; i < 8; ++i) s += y[i];
        s += __shfl_xor(s, 1); s += __shfl_xor(s, 2); s += __shfl_xor(s, 4);
        const float mean = s * (1.f / 64.f);
        float qv = 0.f;
#pragma unroll
        for (int i = 0; i < 8; ++i) { y[i] -= mean; qv += y[i] * y[i]; }
        qv += __shfl_xor(qv, 1); qv += __shfl_xor(qv, 2); qv += __shfl_xor(qv, 4);
        const float rs = 1.0f / sqrtf(qv * (1.f / 64.f) + 64e-5f);
        float xv[8], g[8];
        unpack8(R.v, xv); unpack8(R.g, g);
        const float rk = R.rk;
        const f32x4 l0 = K.l[0], l1 = K.l[1], b0 = K.l[2], b1 = K.l[3];
        const float lg[8] = {l0.x, l0.y, l0.z, l0.w, l1.x, l1.y, l1.z, l1.w}, lb[8] = {b0.x, b0.y, b0.z, b0.w, b1.x, b1.y, b1.z, b1.w};
#pragma unroll
        for (int i = 0; i < 8; ++i) yrw[i] = (y[i] * rs * lg[i] + lb[i] + rk * xv[i]) * g[i];
    }
    bf16* ym = (bf16*)(a.ws + WS_XN) + (size_t)row * 1024;
    *(GAS u32x4*)(ym + c8) = pack8(yconv);
    *(GAS u32x4*)(ym + 512 + c8) = pack8(yrw);
    if (t == L - 1) {
        float* os = a.out + (smp ? O_SHIFTS : O_SHIFTP) + (size_t)b * RWC;
#pragma unroll
        for (int i = 0; i < 7; ++i) { const int c = i * 256 + 4 * lane; const u32x2 u = *(const GAS u32x2*)(pr + PRW + c);
            *(GAS f32x4*)(os + c) = (f32x4){bflo(u.x), bfhi(u.x), bflo(u.y), bfhi(u.y)}; }
    }
}

#define XB_TMO      128
#define XB_XCNT(j)  (256  + 64 * (j))
#define XB_XSUB(j)  (1280 + 64 * (j))
#define XB_XGEN(j)  (2304 + 64 * (j))
#define XB_TOP      3328
#define XB_TOPGEN   3392
#define XCD_BAR_WORDS 3456
#define XB_SPIN_CAP (1u << 18)

__device__ __forceinline__ unsigned xb_ld(unsigned* p)              { return __hip_atomic_load(p, __ATOMIC_RELAXED, __HIP_MEMORY_SCOPE_AGENT); }
__device__ __forceinline__ unsigned xb_add(unsigned* p, unsigned v) { return __hip_atomic_fetch_add(p, v, __ATOMIC_RELAXED, __HIP_MEMORY_SCOPE_AGENT); }
__device__ __forceinline__ unsigned xb_xcc_id() { return (unsigned)__builtin_amdgcn_s_getreg((3 << 11) | 20) & 0xFu; }
#define XB_SPIN(cond, bar) do { unsigned _sp = 0; while (cond) { __builtin_amdgcn_s_sleep(1); \
    if ((++_sp & 255u) == 0u) { if (xb_ld(&(bar)[XB_TMO])) break; if (_sp > XB_SPIN_CAP) { atomicAdd(&(bar)[XB_TMO], 1u); break; } } } } while (0)

struct XcdBarrier {
    unsigned* bar; unsigned x;
    volatile LAS unsigned* st;
};

__device__ __forceinline__ XcdBarrier xcd_barrier_post(unsigned* bar, volatile LAS unsigned* st) {
    XcdBarrier b; b.bar = bar; b.x = xb_xcc_id(); b.st = st;
    if (threadIdx.x == 0) (void)xb_add(&bar[XB_XCNT(b.x)], 1u);
    return b;
}
__device__ __forceinline__ void xcd_barrier_complete(unsigned* bar, unsigned x, unsigned& nloc, unsigned& nx) {
    const unsigned G = gridDim.x * gridDim.y * gridDim.z;
    unsigned sum, cnt, mine, sp = 0u;
    for (;;) {
        sum = 0u; cnt = 0u; mine = 0u;
#pragma unroll
        for (unsigned j = 0; j < 16; ++j) { const unsigned c = xb_ld(&bar[XB_XCNT(j)]); sum += c; cnt += (c > 0u) ? 1u : 0u; mine = (j == x) ? c : mine; }
        if (sum == G) break;
        __builtin_amdgcn_s_sleep(1);
        if ((++sp & 255u) == 0u) { if (xb_ld(&bar[XB_TMO])) break; if (sp > XB_SPIN_CAP) { atomicAdd(&bar[XB_TMO], 1u); break; } }
    }
    nloc = mine > 0u ? mine : 1u; nx = cnt > 0u ? cnt : 1u;
}

__device__ __forceinline__ void xcd_barrier(const XcdBarrier& b) {
    asm volatile("s_waitcnt vmcnt(0)" ::: "memory");
    __syncthreads();
    if (threadIdx.x == 0) {
        unsigned* bar = b.bar;
        __builtin_amdgcn_s_waitcnt(0);
        unsigned nloc = b.st[0], nx = b.st[1];
        if (nloc == 0u) { xcd_barrier_complete(bar, b.x, nloc, nx); b.st[0] = nloc; b.st[1] = nx; }
        const unsigned old = xb_add(&bar[XB_XSUB(b.x)], 1u);
        const unsigned gen = old / nloc;
        if (old + 1u == (gen + 1u) * nloc) {
            __builtin_amdgcn_fence(__ATOMIC_RELEASE, "agent");
            asm volatile("s_waitcnt vmcnt(0)" ::: "memory");
            const unsigned og = xb_add(&bar[XB_TOP], 1u);
            const unsigned tg = og / nx;
            if (og + 1u == (tg + 1u) * nx) xb_add(&bar[XB_TOPGEN], 1u);
            else XB_SPIN(xb_ld(&bar[XB_TOPGEN]) == tg, bar);
            __builtin_amdgcn_fence(__ATOMIC_ACQUIRE, "agent");
            xb_add(&bar[XB_XGEN(b.x)], 1u);
            asm volatile("s_waitcnt vmcnt(0)" ::: "memory");
        } else {
            XB_SPIN(xb_ld(&bar[XB_XGEN(b.x)]) == gen, bar);
            __builtin_amdgcn_fence(__ATOMIC_ACQUIRE, "agent");
            asm volatile("s_waitcnt vmcnt(0)" ::: "memory");
        }
    }
    __syncthreads();
}

__global__ void __launch_bounds__(512, 2) fwd_kernel(Args a) {
    extern __shared__ __attribute__((aligned(16))) unsigned char lds_raw[];
    LAS unsigned char* lds = (LAS unsigned char*)lds_raw;
    cg::grid_group grid = cg::this_grid();
    const int tid = threadIdx.x, lane = tid & 63, wave = __builtin_amdgcn_readfirstlane(tid >> 6);
    const int G = gridDim.x, bx = blockIdx.x;
    const int vcu = (G % 8 == 0) ? (bx % 8) * (G / 8) + bx / 8 : bx;
    const int gw = vcu * 8 + wave, NGW = G * 8;
    const int lo = a.ph_lo, hi = a.ph_hi;
#define IN(k) (lo <= (k) && (k) < hi)
    volatile LAS unsigned* barst = (volatile LAS unsigned*)(lds + LDS_BARST);
    if (tid == 0) { barst[0] = 0u; barst[1] = 0u; }
    __syncthreads();
    const XcdBarrier bar = xcd_barrier_post((unsigned*)(a.ws + WS_BAR) + a.li * XCD_BAR_WORDS, barst);
    if (a.ph_lo < 0) grid.sync();
#define SEAM(k) do { if (IN(k) && IN((k) + 1)) xcd_barrier(bar); } while (0)
    unsigned char* ws = a.ws;
    bf16* WT_IN = (bf16*)(ws + WS_WIN); bf16* WT_OUT = (bf16*)(ws + WS_WOUT); bf16* WT_FF1 = (bf16*)(ws + WS_WFF1); bf16* WT_FF2 = (bf16*)(ws + WS_WFF2);
    bf16* XN = (bf16*)(ws + WS_XN); bf16* XG = (bf16*)(ws + WS_XG); bf16* PROJ = (bf16*)(ws + WS_PROJ); bf16* HB = (bf16*)(ws + WS_H);
    float* SS1 = (float*)(ws + WS_SS1); float* SS2 = (float*)(ws + WS_SS2);

    if (IN(0)) {
        LAS float* scr = (LAS float*)(lds + wave * 16384);
        constexpr int I_IN = 16 * (IC / 32), I_OUT = 16 * 32, I_F1 = 16 * (FFD / 32), I_F2 = 64 * 32, I_W2 = 16, I_A2 = 16, I_G2 = 2 * 16;
        constexpr int NITEMS = I_IN + I_W2 + I_A2 + I_G2;
        for (int it = gw; it < NITEMS; it += NGW) {
            int r = it;
            if (r < I_IN) { p0_transpose_item(a.in[6], DM, IC, WT_IN, scr, r, lane); continue; } r -= I_IN;
            if (r < I_W2) { p0_transpose_item(a.in[10], 64, 512, (bf16*)(ws + WS_W2T), scr, r, lane); continue; } r -= I_W2;
            if (r < I_A2) { p0_transpose_item(a.in[12], 64, 512, (bf16*)(ws + WS_A2T), scr, r, lane); continue; } r -= I_A2;
            p0_transpose_item(a.in[13], 128, 512, (bf16*)(ws + WS_G2T), scr, r, lane);
        }
        {
            const GAS f32x4* gr = (const GAS f32x4*)a.in[5] + lane;
            const f32x4 g0 = gr[0], g1 = gr[64], g2 = gr[128], g3 = gr[192];
            for (int m0 = gw; m0 < TT; m0 += 4 * NGW) {
                f32x4 v[4][4];
#pragma unroll
                for (int k = 0; k < 4; ++k) { const int m = m0 + k * NGW;
                    if (m < TT) { const float* xrow = (m < TP) ? a.in[0] + (size_t)m * DM : a.in[1] + (size_t)(m - TP) * DM; const GAS f32x4* xr = (const GAS f32x4*)xrow + lane;
                        v[k][0] = xr[0]; v[k][1] = xr[64]; v[k][2] = xr[128]; v[k][3] = xr[192]; }
                    else { v[k][0] = v[k][1] = v[k][2] = v[k][3] = (f32x4){0.f, 0.f, 0.f, 0.f}; } }
#pragma unroll
                for (int k = 0; k < 4; ++k) { const int m = m0 + k * NGW;
                    float s2 = 0.f;
#pragma unroll
                    for (int j = 0; j < 4; ++j) s2 += (v[k][j].x * v[k][j].x + v[k][j].y * v[k][j].y) + (v[k][j].z * v[k][j].z + v[k][j].w * v[k][j].w);
                    const float rstd = 1.0f / sqrtf(wave_sum(s2) * (1.f / DM) + 1e-6f);
                    if (m < TT) { GAS u32x2* o8 = (GAS u32x2*)(XN + (size_t)m * DM) + lane;
                        u32x2 w; w.x = pk2(v[k][0].x * rstd * g0.x, v[k][0].y * rstd * g0.y); w.y = pk2(v[k][0].z * rstd * g0.z, v[k][0].w * rstd * g0.w); o8[0] = w;
                        w.x = pk2(v[k][1].x * rstd * g1.x, v[k][1].y * rstd * g1.y); w.y = pk2(v[k][1].z * rstd * g1.z, v[k][1].w * rstd * g1.w); o8[64] = w;
                        w.x = pk2(v[k][2].x * rstd * g2.x, v[k][2].y * rstd * g2.y); w.y = pk2(v[k][2].z * rstd * g2.z, v[k][2].w * rstd * g2.w); o8[128] = w;
                        w.x = pk2(v[k][3].x * rstd * g3.x, v[k][3].y * rstd * g3.y); w.y = pk2(v[k][3].z * rstd * g3.z, v[k][3].w * rstd * g3.w); o8[192] = w; }
                }
            }
        }
    }
    SEAM(0);
    if (IN(1)) {
        pg8::Gemm g{XN, WT_IN, TT, IC, DM}; pg8::StaticOrder S; S.init(TT, IC, G, bx);
        pg8::EpiStore<0> E{PROJ, IC};
        pg8::gemm_phase<pg8::EpiStore<0>, pg8::StaticOrder, true, true>(lds, g, S, E);
        {
            const int ntile = (TT / 256) * (IC / 256), full = ntile / G, nbusy = ntile - full * G;
            if (bx >= nbusy) {
                constexpr int I_OUT = 16 * 32, I_F1 = 16 * (FFD / 32), I_F2 = 64 * 32;
                LAS float* scr = (LAS float*)(lds + wave * 16384);
                for (int it = (bx - nbusy) * 8 + wave; it < I_OUT + I_F1 + I_F2; it += (G - nbusy) * 8) {
                    int r = it;
                    if (r < I_OUT) { p0_transpose_item(a.in[19], DM, DM, WT_OUT, scr, r, lane); continue; } r -= I_OUT;
                    if (r < I_F1) { p0_transpose_item(a.in[21], DM, FFD, WT_FF1, scr, r, lane); continue; } r -= I_F1;
                    p0_transpose_item(a.in[22], FFD, DM, WT_FF2, scr, r, lane);
                }
            }
        }
    }
    SEAM(1);
    if (IN(2)) {
        LAS unsigned char* scr = lds + wave * PREP_SCR;
        PrepConst C; C.unused = 0;
        {
            const int h = gw & 7, cgp = lane & 7;
            int col[7]; prep_cols(h, cgp, col);
            LAS float* MUw = (LAS float*)(scr + PREP_MU);
#pragma unroll
            for (int i = 0; i < 7; ++i) { *(LAS f32x4*)(MUw + (i * 8 + cgp) * 8) = gldf4(a.in[8] + col[i]); *(LAS f32x4*)(MUw + (i * 8 + cgp) * 8 + 4) = gldf4(a.in[8] + col[i] + 4); }
            LDS_WAIT();
        }
        PrepRaw R, Rn;
        int it = gw;
        if (it < TT) prep_load(a, R, lane, (it >> 3) * 8, it & 7);
        while (it < TT) {
            const int nit = it + NGW;
            if (nit < TT) prep_load(a, Rn, lane, (nit >> 3) * 8, nit & 7);
            prep_item(a, C, R, scr, lane, (it >> 3) * 8, it & 7);
            R = Rn; it = nit;
        }
    }
    SEAM(2);
    if (IN(3)) p2_scan(a, lds, G, vcu, wave, lane);
    SEAM(3);
    if (IN(4)) {
        MixConst K; { const int c8 = 8 * lane; const float* cw = a.in[7];
            K.w[0] = gldf4(cw + c8); K.w[1] = gldf4(cw + c8 + 4); K.w[2] = gldf4(cw + 512 + c8); K.w[3] = gldf4(cw + 512 + c8 + 4); K.w[4] = gldf4(cw + 1024 + c8); K.w[5] = gldf4(cw + 1024 + c8 + 4);
            K.l[0] = gldf4(a.in[17] + c8); K.l[1] = gldf4(a.in[17] + c8 + 4); K.l[2] = gldf4(a.in[18] + c8); K.l[3] = gldf4(a.in[18] + c8 + 4); }
        MixRaw R, Rn;
        int m = gw;
        if (m < TT) p3_load(a, R, m, lane);
        while (m < TT) {
            const int mn = m + NGW;
            if (mn < TT) p3_load(a, Rn, mn, lane);
            p3_token(a, K, R, m, lane);
            R = Rn; m = mn;
        }
    }
    SEAM(4);
    if (IN(5)) {
        unsigned* ocnt = (unsigned*)(ws + WS_BAR) + 30000;
        if (G == 256) {
            { pg8::Gemm g{XN, WT_OUT, TT, DM, DM}; pg8::OutOrder S{G, bx, ocnt};
              pg8::EpiRes<0> E{a.in[0], a.in[1], a.out, XG, a.in[20], nullptr, SS1};
              pg8::gemm_phase<pg8::EpiRes<0>, pg8::OutOrder, true, true>(lds, g, S, E); }
            {
              pg8::Gemm g{XG, WT_FF1, TT, FFD, DM}; pg8::SampleFF1Order S{G, bx, ocnt, 16u * 8u};
              pg8::EpiStore<1> E{HB, FFD};
              pg8::gemm_phase<pg8::EpiStore<1>, pg8::SampleFF1Order, true, true>(lds, g, S, E); }
        } else {
            pg8::Gemm g{XN, WT_OUT, TT, DM, DM}; pg8::StaticOrder S; S.init(TT, DM, G, bx);
            pg8::EpiRes<0> E{a.in[0], a.in[1], a.out, XG, a.in[20], nullptr, SS1};
            pg8::gemm_phase<pg8::EpiRes<0>, pg8::StaticOrder, true, true>(lds, g, S, E);
        }
    }
    SEAM(5);
    if (IN(6)) {
        const int mrows = (G == 256) ? TP : TT;
        pg8::Gemm g{XG, WT_FF1, mrows, FFD, DM}; pg8::StaticOrder S; S.init(mrows, FFD, G, bx);
        pg8::EpiStore<1> E{HB, FFD};
        pg8::gemm_phase<pg8::EpiStore<1>, pg8::StaticOrder, true, true>(lds, g, S, E);
    }
    SEAM(6);
    if (IN(7)) {
        {
            pg8::Gemm g{HB, WT_FF2, TP, DM, FFD, 0}; pg8::StaticOrder S; S.init(TP, DM, G, bx);
            if (G == 256) {
                pg8::EpiResNorm E{a.out, SS1, a.in[23], (float*)(ws + WS_XSTAT), (unsigned*)(ws + WS_BAR) + 20000};
                pg8::gemm_phase<pg8::EpiResNorm, pg8::StaticOrder, false, true>(lds, g, S, E);
            } else {
                pg8::EpiRes<1> E{nullptr, nullptr, a.out, nullptr, nullptr, SS1, SS2};
                pg8::gemm_phase<pg8::EpiRes<1>, pg8::StaticOrder, true, true>(lds, g, S, E);
            }
        }
        {
            pg8::Gemm g{HB, WT_FF2, TT, DM, 512, FFD}; pg8::SplitOrder S{G, bx};
            pg8::EpiPart E{(float*)(ws + WS_PART)};
            pg8::gemm_phase<pg8::EpiPart, pg8::SplitOrder, true, true>(lds, g, S, E);
        }
    }
    SEAM(7);
    if (IN(8)) {
        for (int m = gw; m < TT; m += NGW) {
            GAS f32x4* xr = (GAS f32x4*)(a.out + (size_t)m * DM) + lane; const GAS f32x4* gr = (const GAS f32x4*)a.in[23] + lane;
            if (m < TP) {
                if (G == 256) continue;
                float s = (lane < 16) ? SS2[(size_t)m * 16 + lane] : 0.f;
                const float rstd = 1.0f / sqrtf(wave_sum(s) * (1.f / DM) + 1e-6f);
#pragma unroll
                for (int j = 0; j < 4; ++j) { const f32x4 v = xr[64 * j], gg = gr[64 * j]; xr[64 * j] = v * rstd * gg; }
            } else {
                float s1 = (lane < 16) ? SS1[(size_t)m * 16 + lane] : 0.f;
                const float sc = 1.0f / (wave_sum(s1) * (1.f / DM) + 1e-6f);
                const GAS f32x4* pr = (const GAS f32x4*)((const float*)(ws + WS_PART) + (size_t)(m - TP) * 1024) + lane;
                f32x4 x2[4]; float s2 = 0.f;
#pragma unroll
                for (int j = 0; j < 4; ++j) {
                    f32x4 acc = pr[64 * j];
#pragma unroll
                    for (int kc = 1; kc < 8; ++kc) acc = acc + pr[(size_t)kc * (1024 * 1024 / 4) + 64 * j];
                    x2[j] = xr[64 * j] + acc * sc;
                    s2 += (x2[j].x * x2[j].x + x2[j].y * x2[j].y) + (x2[j].z * x2[j].z + x2[j].w * x2[j].w);
                }
                const float rstd = 1.0f / sqrtf(wave_sum(s2) * (1.f / DM) + 1e-6f);
#pragma unroll
                for (int j = 0; j < 4; ++j) xr[64 * j] = x2[j] * rstd * gr[64 * j];
            }
        }
    }
#undef IN
#undef SEAM
}

extern "C" void kernel_launch(void* const* d_in, const int* in_sizes, int n_in, void* d_out, int out_size, void* d_ws, size_t ws_size, hipStream_t stream) {
    static int grid = 0;
    if (grid == 0) {
        int dev = 0, cus = 0, per_cu = 0;
        (void)hipGetDevice(&dev);
        (void)hipDeviceGetAttribute(&cus, hipDeviceAttributeMultiprocessorCount, dev);
        if (hipFuncSetAttribute((const void*)fwd_kernel, hipFuncAttributeMaxDynamicSharedMemorySize, LDS_BYTES) != hipSuccess) fprintf(stderr, "hipFuncSetAttribute failed\n");
        if (hipOccupancyMaxActiveBlocksPerMultiprocessor(&per_cu, (const void*)fwd_kernel, 512, LDS_BYTES) != hipSuccess || per_cu < 1) { fprintf(stderr, "occupancy query: %d\n", per_cu); per_cu = 1; }
        (void)hipGetLastError();
        grid = cus * 1;
        if (n_in != 24 || ws_size < WS_END) fprintf(stderr, "unexpected n_in %d ws %zu\n", n_in, ws_size);
    }
    Args a{};
    for (int i = 0; i < 24; ++i) a.in[i] = (const float*)d_in[i];
    a.out = (float*)d_out; a.ws = (unsigned char*)d_ws;
#ifndef PROBE_SEQ
#define PROBE_SEQ {0, 9}
#endif
    static const int seq[] = PROBE_SEQ;
    (void)hipMemsetAsync((unsigned char*)d_ws + WS_BAR, 0, BAR_ZERO_BYTES, stream);
    for (unsigned i = 0; i + 1 < sizeof(seq) / sizeof(seq[0]); i += 2) {
        a.ph_lo = seq[i]; a.ph_hi = seq[i + 1]; a.li = (int)(i / 2);
        void* args[] = {&a};
        hipError_t e = hipLaunchCooperativeKernel((const void*)fwd_kernel, dim3(grid), dim3(512), args, LDS_BYTES, stream);
        if (e != hipSuccess) fprintf(stderr, "cooperative launch failed: %s (grid %d)\n", hipGetErrorString(e), grid);
    }
}
```

```cpp
#include <hip/hip_runtime.h>
#include <hip/hip_cooperative_groups.h>
#include <cstdio>
#include <cstdint>
namespace cg = cooperative_groups;
namespace pg8 {
#define PG8_LAS __attribute__((address_space(3)))
typedef unsigned short bf16_t;
typedef short bf16x8 __attribute__((ext_vector_type(8)));
typedef float f32x4 __attribute__((ext_vector_type(4)));
typedef unsigned u32x4 __attribute__((ext_vector_type(4)));
constexpr int BM = 256, BK = 64, HALF = 128, HTB = HALF * BK * 2  , STAGE_BYTES = 8 * HTB, NXCD = 8, WGM = 8;

__host__ __device__ __forceinline__ int lds_byte(int r, int c) { const int st = (r >> 4) * 2 + (c >> 5), rr = r & 15, cc = c & 31, ob = rr * 64 + cc * 2; return st * 1024 + (ob ^ (((ob >> 9) & 1) << 5)); }
__host__ __device__ __forceinline__ void stage_rc(int b, int& R, int& C) { const int st = b / 1024, sb = b % 1024, swz = sb ^ (((sb >> 9) & 1) << 5); R = (st >> 1) * 16 + swz / 64; C = (st & 1) * 32 + (swz % 64) / 2; }
__host__ __device__ __forceinline__ int perm32(int rho) { const int n = rho >> 4, i = rho & 15; return 8 * (i >> 2) + 4 * n + (i & 3); }

struct Unit { int pm, pn, ko; };
struct Gemm { const bf16_t* A; const bf16_t* Bt; int M, N, K, ld; };

struct StaticOrder {
    int nM, nN, nwg, G, c;
    __host__ __device__ void init(int M, int N, int G_, int c_) { nM = M / BM; nN = N / BM; nwg = nM * nN; G = G_; c = c_; }
    __host__ __device__ bool next(int i, Unit& u) const {
        const long L = (long)i * G + c; if (L >= nwg) return false;
        int wgid = (int)L; { const int q = nwg / NXCD, r = nwg % NXCD, xcd = wgid % NXCD, off = wgid / NXCD; wgid = (xcd < r ? xcd * (q + 1) : r * (q + 1) + (xcd - r) * q) + off; }
        const int nig = WGM * nN, gid = wgid / nig, fm = gid * WGM, gsz = (nM - fm) < WGM ? (nM - fm) : WGM;
        u.pm = fm + ((wgid % nig) % gsz); u.pn = (wgid % nig) / gsz; u.ko = 0; return true;
    }
    __device__ __forceinline__ void a_ready(const Unit&) const {}
    __device__ __forceinline__ void done(const Unit&) const {}
};

__device__ __forceinline__ unsigned cvt_pk_bf16(float lo, float hi) { unsigned r; asm volatile("v_cvt_pk_bf16_f32 %0, %1, %2" : "=v"(r) : "v"(lo), "v"(hi)); return r; }
#define PG8_GAS __attribute__((address_space(1)))
template <int ACT  > struct EpiStore {
    static constexpr bool PERM = true, AFTER_DRAIN = false;
    bf16_t* O; int ldc;
    __device__ __forceinline__ void operator()(const f32x4 (&acc)[2][2][4][2], const Unit& u, int wr, int wc, int fr, int fq) const {
        const int row0 = u.pm * BM + wr * 64 + fr, col0 = u.pn * BM + wc * 32 + 8 * fq;
#pragma unroll
        for (int ai = 0; ai < 2; ++ai)
#pragma unroll
            for (int m = 0; m < 4; ++m) { bf16_t* rowp = O + (size_t)(row0 + ai * HALF + m * 16) * ldc + col0;
#pragma unroll
                for (int bj = 0; bj < 2; ++bj) { f32x4 v0 = acc[ai][bj][m][0], v1 = acc[ai][bj][m][1];
                    if (ACT == 1) { v0 = __builtin_elementwise_max(v0, (f32x4){0.f, 0.f, 0.f, 0.f}); v1 = __builtin_elementwise_max(v1, (f32x4){0.f, 0.f, 0.f, 0.f}); v0 = v0 * v0; v1 = v1 * v1; }
                    u32x4 w; w.x = cvt_pk_bf16(v0[0], v0[1]); w.y = cvt_pk_bf16(v0[2], v0[3]); w.z = cvt_pk_bf16(v1[0], v1[1]); w.w = cvt_pk_bf16(v1[2], v1[3]);
                    *(PG8_GAS u32x4*)(rowp + bj * HALF) = w; } }
    }
};
template <int MODE> struct EpiRes {
    static constexpr bool PERM = true, AFTER_DRAIN = false;
    const float* xp; const float* xs; float* out; bf16_t* XG; const float* gam; const float* ss_in; float* ssq;
    __device__ __forceinline__ void operator()(const f32x4 (&acc)[2][2][4][2], const Unit& u, int wr, int wc, int fr, int fq) const {
        const int row0 = u.pm * BM + wr * 64 + fr, col0 = u.pn * BM + wc * 32 + 8 * fq;
        f32x4 gv[2][2];
        if (MODE == 0) {
#pragma unroll
            for (int bj = 0; bj < 2; ++bj)
#pragma unroll
                for (int n = 0; n < 2; ++n) gv[bj][n] = *(const PG8_GAS f32x4*)(gam + col0 + bj * HALF + 4 * n);
        }
#pragma unroll
        for (int ai = 0; ai < 2; ++ai)
#pragma unroll
            for (int m = 0; m < 4; ++m) {
                const int row = row0 + ai * HALF + m * 16;
                const float* xin; float sc = 1.f;
                if (MODE == 0) { xin = (row < 16384) ? xp + (size_t)row * 1024 : xs + (size_t)(row - 16384) * 1024; }
                else { xin = out + (size_t)row * 1024;
                    const PG8_GAS f32x4* sp = (const PG8_GAS f32x4*)(ss_in + (size_t)row * 16);
                    const f32x4 s0 = sp[0], s1 = sp[1], s2 = sp[2], s3 = sp[3];
                    const f32x4 st = (s0 + s1) + (s2 + s3);
                    const float tot = (st[0] + st[1]) + (st[2] + st[3]);
                    sc = 1.0f / (tot * (1.0f / 1024.0f) + 1e-6f); }
                float* op = out + (size_t)row * 1024 + col0;
                float ss = 0.f;
#pragma unroll
                for (int bj = 0; bj < 2; ++bj) {
                    const f32x4 a0 = *(const PG8_GAS f32x4*)(xin + col0 + bj * HALF), a1 = *(const PG8_GAS f32x4*)(xin + col0 + bj * HALF + 4);
                    const f32x4 v0 = a0 + acc[ai][bj][m][0] * sc, v1 = a1 + acc[ai][bj][m][1] * sc;
                    *(PG8_GAS f32x4*)(op + bj * HALF) = v0; *(PG8_GAS f32x4*)(op + bj * HALF + 4) = v1;
                    ss += (v0[0] * v0[0] + v0[1] * v0[1]) + (v0[2] * v0[2] + v0[3] * v0[3]);
                    ss += (v1[0] * v1[0] + v1[1] * v1[1]) + (v1[2] * v1[2] + v1[3] * v1[3]);
                    if (MODE == 0) { const f32x4 g0 = v0 * gv[bj][0], g1 = v1 * gv[bj][1];
                        u32x4 w; w.x = cvt_pk_bf16(g0[0], g0[1]); w.y = cvt_pk_bf16(g0[2], g0[3]); w.z = cvt_pk_bf16(g1[0], g1[1]); w.w = cvt_pk_bf16(g1[2], g1[3]);
                        *(PG8_GAS u32x4*)(XG + (size_t)row * 1024 + col0 + bj * HALF) = w; }
                }
                ss += __shfl_xor(ss, 16); ss += __shfl_xor(ss, 32);
                if (fq == 0) ssq[(size_t)row * 16 + u.pn * 4 + wc] = ss;
            }
    }
};
struct SplitOrder {
    int G, c;
    __device__ bool next(int i, Unit& u) const { const int L = i * G + c; if (L >= 128) return false; const int tile = L >> 3, kc = L & 7; u.pm = 64 + (tile >> 2); u.pn = tile & 3; u.ko = kc * 512; return true; }
    __device__ __forceinline__ void a_ready(const Unit&) const {}
    __device__ __forceinline__ void done(const Unit&) const {}
};
struct EpiPart {
    static constexpr bool PERM = true, AFTER_DRAIN = false;
    float* P;
    __device__ __forceinline__ void operator()(const f32x4 (&acc)[2][2][4][2], const Unit& u, int wr, int wc, int fr, int fq) const {
        const int row0 = (u.pm - 64) * BM + wr * 64 + fr, col0 = u.pn * BM + wc * 32 + 8 * fq;
        float* base = P + (size_t)(u.ko >> 9) * (1024 * 1024);
#pragma unroll
        for (int ai = 0; ai < 2; ++ai)
#pragma unroll
            for (int m = 0; m < 4; ++m) { float* rowp = base + (size_t)(row0 + ai * HALF + m * 16) * 1024 + col0;
#pragma unroll
                for (int bj = 0; bj < 2; ++bj) { *(PG8_GAS f32x4*)(rowp + bj * HALF) = acc[ai][bj][m][0]; *(PG8_GAS f32x4*)(rowp + bj * HALF + 4) = acc[ai][bj][m][1]; } }
    }
};
struct OutOrder {
    int G, c; unsigned* cnt;
    __device__ bool next(int i, Unit& u) const { const int t = i * G + c; if (t >= 272) return false; if (t < 16) { u.pm = 64 + (t >> 2); u.pn = t & 3; } else { const int p = t - 16; u.pm = p >> 2; u.pn = p & 3; } u.ko = 0; return true; }
    __device__ __forceinline__ void a_ready(const Unit&) const {}
    __device__ __forceinline__ void done(const Unit& u) const {
        if (u.pm >= 64) {
            asm volatile("s_waitcnt vmcnt(0)" ::: "memory");
            __builtin_amdgcn_fence(__ATOMIC_RELEASE, "agent");
            if ((threadIdx.x & 63) == 0) __hip_atomic_fetch_add(cnt, 1u, __ATOMIC_RELAXED, __HIP_MEMORY_SCOPE_AGENT);
        }
    }
};
struct SampleFF1Order {
    int G, c; const unsigned* cnt; unsigned need;
    __device__ bool next(int i, Unit& u) const { const int t = c - 16; if (i != 0 || t < 0 || t >= 64) return false; u.pm = 64 + (t >> 4); u.pn = t & 15; u.ko = 0; return true; }
    __device__ __forceinline__ void a_ready(const Unit&) const {
        if (threadIdx.x < 64) {
            unsigned polls = 0;
            while ((unsigned)__builtin_amdgcn_readfirstlane(__hip_atomic_load(cnt, __ATOMIC_RELAXED, __HIP_MEMORY_SCOPE_AGENT)) < need) { if (++polls > (1u << 22)) break; __builtin_amdgcn_s_sleep(2); }
            __builtin_amdgcn_fence(__ATOMIC_ACQUIRE, "agent");
            asm volatile("s_waitcnt vmcnt(0)" ::: "memory");
        }
        asm volatile("" ::: "memory"); __builtin_amdgcn_s_barrier(); asm volatile("" ::: "memory");
    }
    __device__ __forceinline__ void done(const Unit&) const {}
};
struct EpiResNorm {
    static constexpr bool PERM = true, AFTER_DRAIN = true;
    float* out; const float* ss_in; const float* gam; float* xbuf; unsigned* cnt;
    __device__ __forceinline__ void fused(f32x4 (&acc)[2][2][4][2], const Unit& u, int wr, int wc, int fr, int fq, PG8_LAS unsigned char* lds, int wid, int lane) const {
        PG8_LAS float* P = (PG8_LAS float*)lds;
        PG8_LAS float* S = (PG8_LAS float*)(lds + 4096);
        const int row0 = u.pm * BM + wr * 64 + fr, col0 = u.pn * BM + wc * 32 + 8 * fq;
#pragma unroll
        for (int ai = 0; ai < 2; ++ai)
#pragma unroll
            for (int m = 0; m < 4; ++m) {
                const int row = row0 + ai * HALF + m * 16;
                const PG8_GAS f32x4* sp = (const PG8_GAS f32x4*)(ss_in + (size_t)row * 16);
                const f32x4 s0 = sp[0], s1 = sp[1], s2 = sp[2], s3 = sp[3];
                const f32x4 st = (s0 + s1) + (s2 + s3);
                const float sc = 1.0f / (((st[0] + st[1]) + (st[2] + st[3])) * (1.0f / 1024.0f) + 1e-6f);
                const float* xin = out + (size_t)row * 1024 + col0;
                float ss = 0.f;
#pragma unroll
                for (int bj = 0; bj < 2; ++bj) {
                    const f32x4 a0 = *(const PG8_GAS f32x4*)(xin + bj * HALF), a1 = *(const PG8_GAS f32x4*)(xin + bj * HALF + 4);
                    const f32x4 v0 = a0 + acc[ai][bj][m][0] * sc, v1 = a1 + acc[ai][bj][m][1] * sc;
                    acc[ai][bj][m][0] = v0; acc[ai][bj][m][1] = v1;
                    ss += (v0[0] * v0[0] + v0[1] * v0[1]) + (v0[2] * v0[2] + v0[3] * v0[3]);
                    ss += (v1[0] * v1[0] + v1[1] * v1[1]) + (v1[2] * v1[2] + v1[3] * v1[3]);
                }
                ss += __shfl_xor(ss, 16); ss += __shfl_xor(ss, 32);
                if (fq == 0) P[(ai * HALF + wr * 64 + m * 16 + fr) * 4 + wc] = ss;
            }
        asm volatile("s_waitcnt lgkmcnt(0)" ::: "memory"); __builtin_amdgcn_s_barrier(); asm volatile("" ::: "memory");
        const int rowl = wid * 32 + (lane & 31);
        if (lane < 32) {
            const float t = (P[rowl * 4 + 0] + P[rowl * 4 + 1]) + (P[rowl * 4 + 2] + P[rowl * 4 + 3]);
            __hip_atomic_store(xbuf + ((size_t)(u.pm * BM + rowl) * 4 + u.pn), t, __ATOMIC_RELAXED, __HIP_MEMORY_SCOPE_AGENT);
        }
        asm volatile("s_waitcnt vmcnt(0)" ::: "memory");
        if (lane == 0) __hip_atomic_fetch_add(cnt + 64 * u.pm, 1u, __ATOMIC_RELAXED, __HIP_MEMORY_SCOPE_AGENT);
        if (wid == 0) {
            unsigned polls = 0;
            while ((unsigned)__builtin_amdgcn_readfirstlane(__hip_atomic_load(cnt + 64 * u.pm, __ATOMIC_RELAXED, __HIP_MEMORY_SCOPE_AGENT)) < 32u) { if (++polls > (1u << 22)) break; __builtin_amdgcn_s_sleep(2); }
            __builtin_amdgcn_fence(__ATOMIC_ACQUIRE, "agent");
        }
        asm volatile("s_waitcnt vmcnt(0) lgkmcnt(0)" ::: "memory"); __builtin_amdgcn_s_barrier(); asm volatile("" ::: "memory");
        if (lane < 32) {
            const float* slot = xbuf + (size_t)(u.pm * BM + rowl) * 4; float tot = 0.f;
#pragma unroll
            for (int t = 0; t < 4; ++t) tot += __hip_atomic_load(slot + t, __ATOMIC_RELAXED, __HIP_MEMORY_SCOPE_AGENT);
            S[rowl] = 1.0f / sqrtf(tot * (1.0f / 1024.0f) + 1e-6f);
        }
        asm volatile("s_waitcnt lgkmcnt(0)" ::: "memory"); __builtin_amdgcn_s_barrier(); asm volatile("" ::: "memory");
        f32x4 gv[2][2];
#pragma unroll
        for (int bj = 0; bj < 2; ++bj)
#pragma unroll
            for (int n = 0; n < 2; ++n) gv[bj][n] = *(const PG8_GAS f32x4*)(gam + col0 + bj * HALF + 4 * n);
#pragma unroll
        for (int ai = 0; ai < 2; ++ai)
#pragma unroll
            for (int m = 0; m < 4; ++m) {
                const int rl = ai * HALF + wr * 64 + m * 16 + fr; const float rs = S[rl];
                float* op = out + (size_t)(u.pm * BM + rl) * 1024 + col0;
#pragma unroll
                for (int bj = 0; bj < 2; ++bj) { *(PG8_GAS f32x4*)(op + bj * HALF) = acc[ai][bj][m][0] * rs * gv[bj][0]; *(PG8_GAS f32x4*)(op + bj * HALF + 4) = acc[ai][bj][m][1] * rs * gv[bj][1]; }
            }
    }
};
template <class Epi, class Sched, bool ALIGN_EPI = false, bool SP2 = false>
__device__ __forceinline__ void gemm_phase(PG8_LAS unsigned char* lds, const Gemm g, const Sched& S, const Epi& E) {
    const int tid = threadIdx.x, wid = __builtin_amdgcn_readfirstlane(tid >> 6), lane = tid & 63, wr = wid >> 2, wc = wid & 3, fr = lane & 15, fq = lane >> 4;
    const int K = g.K, nt = K / BK, LD = g.ld ? g.ld : g.K;
    unsigned voffA[2], voffB[2];
#pragma unroll
    for (int i = 0; i < 2; ++i) { int R, C; stage_rc(tid * 16 + i * 8192, R, C); const int Rb = Epi::PERM ? ((R & ~31) + perm32(R & 31)) : R;
        voffA[i] = (unsigned)(R * LD + C) * 2u; voffB[i] = (unsigned)(Rb * LD + C) * 2u; }
    const size_t kstep = (size_t)(BK * 2);
    const size_t hstep = (size_t)HALF * LD * 2;
    const size_t tstep = 2 * hstep;
    const unsigned ldsw = (unsigned)wid * 1024u;
    const int aoff = lds_byte(wr * 64 + fr, fq * 8), boff = lds_byte(wc * 32 + fr, fq * 8);
#define PG8_SA(b, h) (((b) * 2 + (h)) * HTB)
#define PG8_SB(b, h) ((4 + (b) * 2 + (h)) * HTB)
#define PG8_STAGE(bufoff, gbase, voff) do { _Pragma("unroll") for (int _i = 0; _i < 2; ++_i) \
        __builtin_amdgcn_global_load_lds((const unsigned*)((const char*)(gbase) + (voff)[_i]), (PG8_LAS unsigned*)(lds + (bufoff) + ldsw + _i * 8192), 16, 0, 0); } while (0)
#define PG8_LDA(dst, b, h) do { _Pragma("unroll") for (int m = 0; m < 4; ++m) _Pragma("unroll") for (int k = 0; k < 2; ++k) dst[m][k] = *(const PG8_LAS bf16x8*)(lds + PG8_SA(b, h) + aoff + m * 2048 + k * 1024); } while (0)
#define PG8_LDB(dst, b, h) do { _Pragma("unroll") for (int n = 0; n < 2; ++n) _Pragma("unroll") for (int k = 0; k < 2; ++k) dst[n][k] = *(const PG8_LAS bf16x8*)(lds + PG8_SB(b, h) + boff + n * 2048 + k * 1024); } while (0)
#define PG8_MMA(ai, bj, At, Bt) do { __builtin_amdgcn_s_setprio(1); _Pragma("unroll") for (int m = 0; m < 4; ++m) _Pragma("unroll") for (int n = 0; n < 2; ++n) _Pragma("unroll") for (int k = 0; k < 2; ++k) \
        acc[ai][bj][m][n] = __builtin_amdgcn_mfma_f32_16x16x32_bf16(Bt[n][k], At[m][k], acc[ai][bj][m][n], 0, 0, 0); __builtin_amdgcn_s_setprio(0); } while (0)
#define PG8_WAIT_V(n) asm volatile("s_waitcnt vmcnt(" #n ")" ::: "memory")
#define PG8_WAIT_L(n) asm volatile("s_waitcnt lgkmcnt(" #n ")" ::: "memory")
#define PG8_BAR __builtin_amdgcn_s_barrier()
#define PG8_SCHED __builtin_amdgcn_sched_barrier(0)
    Unit cur, nxt; int ui = 0;
    if (!S.next(0, cur)) return;
    f32x4 acc[2][2][4][2];
#pragma unroll
    for (int a = 0; a < 2; ++a)
#pragma unroll
        for (int b = 0; b < 2; ++b)
#pragma unroll
            for (int m = 0; m < 4; ++m)
#pragma unroll
                for (int n = 0; n < 2; ++n) acc[a][b][m][n] = (f32x4){0.f, 0.f, 0.f, 0.f};
    bf16x8 At[4][2], B0[2][2], B1[2][2];
    const char* cA = (const char*)g.A + (size_t)cur.pm * tstep + (size_t)cur.ko * 2; const char* cB = (const char*)g.Bt + (size_t)cur.pn * tstep + (size_t)cur.ko * 2;
    S.a_ready(cur);
    if constexpr (SP2) {
        PG8_STAGE(PG8_SB(0, 0), cB, voffB); PG8_STAGE(PG8_SB(0, 1), cB + hstep, voffB); PG8_STAGE(PG8_SA(0, 0), cA, voffA); PG8_STAGE(PG8_SA(0, 1), cA + hstep, voffA);
        if (wr == 1) PG8_BAR;
        PG8_WAIT_V(2); PG8_BAR;
        PG8_STAGE(PG8_SB(1, 0), cB + kstep, voffB); PG8_STAGE(PG8_SA(1, 0), cA + kstep, voffA); PG8_STAGE(PG8_SB(1, 1), cB + hstep + kstep, voffB);
        PG8_WAIT_V(6); PG8_BAR;
    } else {
        PG8_STAGE(PG8_SB(0, 0), cB, voffB); PG8_STAGE(PG8_SA(0, 0), cA, voffA); PG8_STAGE(PG8_SB(0, 1), cB + hstep, voffB); PG8_STAGE(PG8_SA(0, 1), cA + hstep, voffA);
        if (wr == 1) PG8_BAR;
        PG8_WAIT_V(4); PG8_BAR;
        PG8_STAGE(PG8_SB(1, 0), cB + kstep, voffB); PG8_STAGE(PG8_SA(1, 0), cA + kstep, voffA); PG8_STAGE(PG8_SB(1, 1), cB + hstep + kstep, voffB);
        PG8_WAIT_V(6); PG8_BAR;
    }
    for (;;) {
        const bool has_next = S.next(ui + 1, nxt);
        const char* nA = has_next ? (const char*)g.A + (size_t)nxt.pm * tstep + (size_t)nxt.ko * 2 : cA; const char* nB = has_next ? (const char*)g.Bt + (size_t)nxt.pn * tstep + (size_t)nxt.ko * 2 : cB;
        for (int t = 0; t < nt; t += 2) {
            const bool last = (t == nt - 2);
            const char* a1 = cA + (size_t)(t + 1) * kstep;
            const char* a2 = last ? nA : cA + (size_t)(t + 2) * kstep; const char* b2 = last ? nB : cB + (size_t)(t + 2) * kstep;
            const char* a3 = a2 + kstep; const char* b3 = b2 + kstep;
            if (last && has_next) S.a_ready(nxt);
            if constexpr (SP2) {
            PG8_LDB(B0, 0, 0); PG8_LDB(B1, 0, 1); PG8_SCHED; PG8_LDA(At, 0, 0); PG8_STAGE(PG8_SA(1, 1), a1 + hstep, voffA);
            PG8_WAIT_V(8); PG8_WAIT_L(0); PG8_BAR; PG8_MMA(0, 0, At, B0); PG8_MMA(0, 1, At, B1); PG8_BAR; PG8_SCHED;
            PG8_LDA(At, 0, 1); PG8_STAGE(PG8_SB(0, 0), b2, voffB); PG8_STAGE(PG8_SB(0, 1), b2 + hstep, voffB); PG8_STAGE(PG8_SA(0, 0), a2, voffA);
            PG8_WAIT_V(8); PG8_WAIT_L(0); PG8_BAR; PG8_MMA(1, 0, At, B0); PG8_MMA(1, 1, At, B1); PG8_BAR; PG8_SCHED;
            PG8_LDB(B0, 1, 0); PG8_LDB(B1, 1, 1); PG8_SCHED; PG8_LDA(At, 1, 0); PG8_STAGE(PG8_SA(0, 1), a2 + hstep, voffA);
            PG8_WAIT_V(8); PG8_WAIT_L(0); PG8_BAR; PG8_MMA(0, 0, At, B0); PG8_MMA(0, 1, At, B1); PG8_BAR; PG8_SCHED;
            PG8_LDA(At, 1, 1); PG8_STAGE(PG8_SB(1, 0), b3, voffB); PG8_STAGE(PG8_SB(1, 1), b3 + hstep, voffB); PG8_STAGE(PG8_SA(1, 0), a3, voffA);
            PG8_WAIT_V(8); PG8_WAIT_L(0); PG8_BAR; PG8_MMA(1, 0, At, B0); PG8_MMA(1, 1, At, B1); PG8_BAR; PG8_SCHED;
            } else {
            PG8_LDB(B0, 0, 0); PG8_SCHED; PG8_LDA(At, 0, 0); PG8_STAGE(PG8_SA(1, 1), a1 + hstep, voffA);
            PG8_WAIT_L(8); PG8_BAR; PG8_WAIT_L(0); PG8_MMA(0, 0, At, B0); PG8_BAR; PG8_SCHED;
            PG8_LDB(B1, 0, 1); PG8_STAGE(PG8_SB(0, 0), b2, voffB);
            PG8_BAR; PG8_WAIT_L(0); PG8_MMA(0, 1, At, B1); PG8_BAR;
            PG8_LDA(At, 0, 1); PG8_STAGE(PG8_SA(0, 0), a2, voffA);
            PG8_BAR; PG8_WAIT_L(0); PG8_MMA(1, 0, At, B0); PG8_BAR; PG8_SCHED;
            PG8_STAGE(PG8_SB(0, 1), b2 + hstep, voffB);
            PG8_WAIT_V(6); PG8_BAR; PG8_MMA(1, 1, At, B1); PG8_BAR;
            PG8_LDB(B0, 1, 0); PG8_SCHED; PG8_LDA(At, 1, 0); PG8_STAGE(PG8_SA(0, 1), a2 + hstep, voffA);
            PG8_WAIT_L(8); PG8_BAR; PG8_WAIT_L(0); PG8_MMA(0, 0, At, B0); PG8_BAR; PG8_SCHED;
            PG8_LDB(B1, 1, 1); PG8_STAGE(PG8_SB(1, 0), b3, voffB);
            PG8_BAR; PG8_WAIT_L(0); PG8_MMA(0, 1, At, B1); PG8_BAR;
            PG8_LDA(At, 1, 1); PG8_STAGE(PG8_SA(1, 0), a3, voffA);
            PG8_BAR; PG8_WAIT_L(0); PG8_MMA(1, 0, At, B0); PG8_BAR; PG8_SCHED;
            PG8_STAGE(PG8_SB(1, 1), b3 + hstep, voffB);
            PG8_WAIT_V(6); PG8_BAR; PG8_MMA(1, 1, At, B1); PG8_BAR;
            }
        }
        if constexpr (ALIGN_EPI) { if (wr == 0) PG8_BAR; }
        if constexpr (!Epi::AFTER_DRAIN) { E(acc, cur, wr, wc, fr, fq); S.done(cur); }
        if (!has_next) break;
#pragma unroll
        for (int a = 0; a < 2; ++a)
#pragma unroll
            for (int b = 0; b < 2; ++b)
#pragma unroll
                for (int m = 0; m < 4; ++m)
#pragma unroll
                    for (int n = 0; n < 2; ++n) acc[a][b][m][n] = (f32x4){0.f, 0.f, 0.f, 0.f};
        cur = nxt; cA = nA; cB = nB; ++ui;
        if constexpr (ALIGN_EPI) { if (wr == 1) PG8_BAR; }
    }
    PG8_WAIT_V(0);
    if constexpr (!ALIGN_EPI) { if (wr == 0) PG8_BAR; }
    PG8_BAR;
    if constexpr (Epi::AFTER_DRAIN) { E.fused(acc, cur, wr, wc, fr, fq, lds, wid, lane); S.done(cur); }
#undef PG8_SA
#undef PG8_SB
#undef PG8_STAGE
#undef PG8_LDA
#undef PG8_LDB
#undef PG8_MMA
#undef PG8_WAIT_V
#undef PG8_WAIT_L
#undef PG8_BAR
#undef PG8_SCHED
}
}
constexpr int DM = 1024, TP = 16384, TS = 1024, TT = TP + TS, SEQ = 2048, DSEQ = 8, DBATCH = 128;
constexpr int IC = 3328, RWC = 1792, PRW = 1536, FFD = 4096;
constexpr size_t MiB = 1u << 20;
constexpr size_t WS_WIN = 0, WS_WOUT = 7 * MiB, WS_WFF1 = 9 * MiB, WS_WFF2 = 17 * MiB, WS_W2T = 25 * MiB, WS_A2T = WS_W2T + 65536, WS_G2T = WS_A2T + 65536;
constexpr size_t WS_SS1 = 26 * MiB, WS_SS2 = 28 * MiB, WS_XN = 30 * MiB, WS_XG = 64 * MiB, WS_PROJ = 98 * MiB, WS_H = 98 * MiB, WS_END = 234 * MiB;
constexpr size_t O_Y = 0, O_CONVP = (size_t)TT * 1024, O_SHIFTP = O_CONVP + 8192, O_WKVP = O_SHIFTP + 14336, O_CONVS = O_WKVP + 262144, O_SHIFTS = O_CONVS + 131072, O_WKVS = O_SHIFTS + 229376;
constexpr size_t OS_YRAW = 0, OS_G = (size_t)TT * 512, OS_V = OS_G + (size_t)TT * 256;
constexpr size_t WS_WD = 30 * MiB, WS_KK = 64 * MiB, WS_BB = 81 * MiB, WS_KM = 209 * MiB, WS_RR = 226 * MiB, WS_RK = 27 * MiB + 262144;
constexpr int LDS_BYTES = 147456;
constexpr size_t WS_BAR = 29 * MiB + 524288, BAR_ZERO_BYTES = 131072;
constexpr size_t WS_PART = 30 * MiB;
constexpr size_t WS_XSTAT = 29 * MiB + 131072;
constexpr int LDS_BARST = 131072 + 64;

#define GAS __attribute__((address_space(1)))
#define LAS __attribute__((address_space(3)))
typedef unsigned short bf16;
typedef unsigned u32x4 __attribute__((ext_vector_type(4)));
typedef unsigned u32x2 __attribute__((ext_vector_type(2)));
typedef float f32x4 __attribute__((ext_vector_type(4)));
typedef short bf16x8 __attribute__((ext_vector_type(8)));
#define LDS_WAIT() asm volatile("s_waitcnt lgkmcnt(0)" ::: "memory")

__device__ __forceinline__ unsigned pk2(float lo, float hi) { return pg8::cvt_pk_bf16(lo, hi); }
__device__ __forceinline__ bf16 f2bf_sw(float f) { const unsigned u = __builtin_bit_cast(unsigned, f); return (bf16)((u + 0x7fffu + ((u >> 16) & 1u)) >> 16); }
__device__ __forceinline__ float bflo(unsigned u) { return __builtin_bit_cast(float, u << 16); }
__device__ __forceinline__ float bfhi(unsigned u) { return __builtin_bit_cast(float, u & 0xffff0000u); }
__device__ __forceinline__ u32x4 gld16(const void* p) { return *(const GAS u32x4*)p; }
__device__ __forceinline__ f32x4 gldf4(const float* p) { return *(const GAS f32x4*)p; }
__device__ __forceinline__ void unpack8(const u32x4 u, float (&o)[8]) { o[0] = bflo(u.x); o[1] = bfhi(u.x); o[2] = bflo(u.y); o[3] = bfhi(u.y); o[4] = bflo(u.z); o[5] = bfhi(u.z); o[6] = bflo(u.w); o[7] = bfhi(u.w); }
__device__ __forceinline__ u32x4 pack8(const float (&v)[8]) { u32x4 w; w.x = pk2(v[0], v[1]); w.y = pk2(v[2], v[3]); w.z = pk2(v[4], v[5]); w.w = pk2(v[6], v[7]); return w; }
__device__ __forceinline__ float wave_sum(float v) {
#pragma unroll
    for (int o = 1; o < 64; o <<= 1) v += __shfl_xor(v, o);
    return v;
}
template <int CTRL> __device__ __forceinline__ float dppf(float x) { return __builtin_bit_cast(float, __builtin_amdgcn_update_dpp(0, __builtin_bit_cast(int, x), CTRL, 0xF, 0xF, true)); }
__device__ __forceinline__ float row16_sum(float x) {
    x += dppf<0xB1>(x); x += dppf<0x4E>(x); x += dppf<0x124>(x); x += dppf<0x128>(x); return x;
}
__device__ __forceinline__ float sigmoidf_(float x) { return __builtin_amdgcn_rcpf(1.0f + __expf(-x)); }
__device__ __forceinline__ float tanhf_(float x) { const float e = __expf(2.0f * x); return 1.0f - 2.0f * __builtin_amdgcn_rcpf(e + 1.0f); }

struct Args { const float* in[24]; float* out; unsigned char* ws; int ph_lo, ph_hi, li, pad; };

__device__ __forceinline__ void p0_transpose_item(const float* W, int K, int N, bf16* WT, LAS float* scr, int item, int lane) {
    const int nblk = N / 32, kb = item / nblk, nb = item % nblk, k0 = 64 * kb, n0 = 32 * nb;
#pragma unroll 8
    for (int i = 0; i < 32; ++i) { const int kk = 2 * i + (lane >> 5); scr[kk * 33 + (lane & 31)] = W[(size_t)(k0 + kk) * N + n0 + (lane & 31)]; }
    LDS_WAIT(); asm volatile("" ::: "memory");
    const int c = lane & 7;
#pragma unroll
    for (int j = 0; j < 4; ++j) { const int n = (lane >> 3) + 8 * j; const LAS float* s = scr + (8 * c) * 33 + n;
        u32x4 o; o.x = pk2(s[0 * 33], s[1 * 33]); o.y = pk2(s[2 * 33], s[3 * 33]); o.z = pk2(s[4 * 33], s[5 * 33]); o.w = pk2(s[6 * 33], s[7 * 33]);
        *(GAS u32x4*)(WT + (size_t)(n0 + n) * K + k0 + 8 * c) = o; }
    LDS_WAIT(); asm volatile("" ::: "memory");
}
__device__ __forceinline__ void rms_row_to_bf16(const float* xrow, const float* g, bf16* orow, int lane) {
    const GAS f32x4* xr = (const GAS f32x4*)xrow + lane; const GAS f32x4* gr = (const GAS f32x4*)g + lane;
    f32x4 v[4]; float s2 = 0.f;
#pragma unroll
    for (int j = 0; j < 4; ++j) { v[j] = xr[64 * j]; s2 += (v[j].x * v[j].x + v[j].y * v[j].y) + (v[j].z * v[j].z + v[j].w * v[j].w); }
    const float rstd = 1.0f / sqrtf(wave_sum(s2) * (1.f / DM) + 1e-6f);
    GAS u32x2* o8 = (GAS u32x2*)orow + lane;
#pragma unroll
    for (int j = 0; j < 4; ++j) { const f32x4 gg = gr[64 * j]; u32x2 w; w.x = pk2(v[j].x * rstd * gg.x, v[j].y * rstd * gg.y); w.y = pk2(v[j].z * rstd * gg.z, v[j].w * rstd * gg.w); o8[64 * j] = w; }
}

constexpr int SB_W = 0, SB_B = 2048, SB_K = 4096, SB_KK = 6144, SB_R = 8192, SB_V = 10240, SB_BETA = 12288, SB_BYTES = 49280, STG_OFF = 2 * SB_BYTES, STG_BYTES = 4608;

__device__ __forceinline__ void load_xm8(const bf16* prow, int c, bool first, const float* shift0, const float* mu, float (&o)[8]) {
    float cur[8], prv[8];
    unpack8(gld16(prow + c), cur);
    if (!first) { unpack8(gld16(prow - IC + c), prv); }
    else if (shift0) { const f32x4 a = gldf4(shift0 + c), b = gldf4(shift0 + c + 4); prv[0] = a.x; prv[1] = a.y; prv[2] = a.z; prv[3] = a.w; prv[4] = b.x; prv[5] = b.y; prv[6] = b.z; prv[7] = b.w; }
    else {
#pragma unroll
        for (int i = 0; i < 8; ++i) prv[i] = 0.f;
    }
    const f32x4 m0 = gldf4(mu + c), m1 = gldf4(mu + c + 4);
    const float mm[8] = {m0.x, m0.y, m0.z, m0.w, m1.x, m1.y, m1.z, m1.w};
#pragma unroll
    for (int i = 0; i < 8; ++i) o[i] = cur[i] + (prv[i] - cur[i]) * mm[i];
}

constexpr int PREP_MU = 10752, PREP_SCR = 12544;
__device__ __forceinline__ void prep_cols(int h, int cgp, int (&col)[7]) {
    col[0] = h * 64 + 8 * cgp; col[1] = 512 + h * 64 + 8 * cgp; col[2] = 1024 + h * 64 + 8 * cgp; col[3] = 1536 + 8 * cgp; col[4] = 1600 + 8 * cgp; col[5] = 1664 + 16 * cgp; col[6] = 1664 + 16 * cgp + 8;
}
struct PrepRaw { u32x4 c[7]; u32x4 p[7]; };
__device__ __forceinline__ void prep_load(const Args& a, PrepRaw& R, int lane, int row0, int h) {
    const bool smp = row0 >= TP;
    const int tok = lane >> 3, cgp = lane & 7, row = row0 + tok;
    const int t = smp ? tok : (row & 2047);
    const bf16* prow = (const bf16*)(a.ws + WS_PROJ) + (size_t)row * IC + PRW;
    int col[7]; prep_cols(h, cgp, col);
#pragma unroll
    for (int i = 0; i < 7; ++i) { R.c[i] = gld16(prow + col[i]); R.p[i] = (u32x4){0u, 0u, 0u, 0u}; }
    if (t != 0) {
#pragma unroll
        for (int i = 0; i < 7; ++i) R.p[i] = gld16(prow - IC + col[i]);
    }
}
__device__ __forceinline__ void xm8_raw(const u32x4 cu, const u32x4 pu, int c, bool fs, const float* shift0, const float* mu, float (&o)[8]) {
    float cur[8], prv[8];
    unpack8(cu, cur); unpack8(pu, prv);
    if (fs) { const f32x4 a = gldf4(shift0 + c), b = gldf4(shift0 + c + 4); prv[0] = a.x; prv[1] = a.y; prv[2] = a.z; prv[3] = a.w; prv[4] = b.x; prv[5] = b.y; prv[6] = b.z; prv[7] = b.w; }
    const f32x4 m0 = gldf4(mu + c), m1 = gldf4(mu + c + 4);
    const float mm[8] = {m0.x, m0.y, m0.z, m0.w, m1.x, m1.y, m1.z, m1.w};
#pragma unroll
    for (int i = 0; i < 8; ++i) o[i] = cur[i] + (prv[i] - cur[i]) * mm[i];
}
__device__ __forceinline__ void xm8_pre(const u32x4 cu, const u32x4 pu, int c, bool fs, const float* shift0, const f32x4 m0, const f32x4 m1, float (&o)[8]) {
    float cur[8], prv[8];
    unpack8(cu, cur); unpack8(pu, prv);
    if (fs) { const f32x4 a = gldf4(shift0 + c), b = gldf4(shift0 + c + 4); prv[0] = a.x; prv[1] = a.y; prv[2] = a.z; prv[3] = a.w; prv[4] = b.x; prv[5] = b.y; prv[6] = b.z; prv[7] = b.w; }
    const float mm[8] = {m0.x, m0.y, m0.z, m0.w, m1.x, m1.y, m1.z, m1.w};
#pragma unroll
    for (int i = 0; i < 8; ++i) o[i] = cur[i] + (prv[i] - cur[i]) * mm[i];
}
struct PrepConst { int unused; };
__device__ __forceinline__ void prep_item(const Args& a, const PrepConst& C, const PrepRaw& R, LAS unsigned char* scr, int lane, int row0, int h) {
    const bool smp = row0 >= TP;
    const int b = smp ? ((row0 - TP) >> 3) : (row0 >> 11);
    const int tok = lane >> 3, cgp = lane & 7;
    const int row = row0 + tok;
    const int t = smp ? tok : (row & 2047);
    const bool fs = (t == 0) && smp;
    const float* shift0 = a.in[3] + (size_t)b * RWC;
    int col[7]; prep_cols(h, cgp, col);
    const LAS float* MUs = (const LAS float*)(scr + PREP_MU);
    LAS float* KKs = (LAS float*)scr; LAS float* KRs = KKs + 512; LAS float* Rs = KRs + 512;
    LAS bf16* Lw = (LAS bf16*)(scr + 6144); LAS bf16* La = Lw + 8 * 72; LAS bf16* Lg = La + 8 * 72;
    const size_t go = (size_t)row * 512 + h * 64 + 8 * cgp;
    {
        float xr[8], xk[8], xv[8];
        xm8_pre(R.c[0], R.p[0], col[0], fs, shift0, *(const LAS f32x4*)(MUs + (0 * 8 + cgp) * 8), *(const LAS f32x4*)(MUs + (0 * 8 + cgp) * 8 + 4), xr);
        xm8_pre(R.c[1], R.p[1], col[1], fs, shift0, *(const LAS f32x4*)(MUs + (1 * 8 + cgp) * 8), *(const LAS f32x4*)(MUs + (1 * 8 + cgp) * 8 + 4), xk);
        xm8_pre(R.c[2], R.p[2], col[2], fs, shift0, *(const LAS f32x4*)(MUs + (2 * 8 + cgp) * 8), *(const LAS f32x4*)(MUs + (2 * 8 + cgp) * 8 + 4), xv);
        *(GAS u32x4*)((bf16*)(a.ws + WS_RR) + go) = pack8(xr);
        *(GAS u32x4*)((bf16*)(a.out + OS_V) + go) = pack8(xv);
        *(LAS f32x4*)(Rs + tok * 64 + 8 * cgp) = (f32x4){xr[0], xr[1], xr[2], xr[3]}; *(LAS f32x4*)(Rs + tok * 64 + 8 * cgp + 4) = (f32x4){xr[4], xr[5], xr[6], xr[7]};
        *(LAS f32x4*)(KRs + tok * 64 + 8 * cgp) = (f32x4){xk[0], xk[1], xk[2], xk[3]}; *(LAS f32x4*)(KRs + tok * 64 + 8 * cgp + 4) = (f32x4){xk[4], xk[5], xk[6], xk[7]};
        const f32x4 c0 = gldf4(a.in[14] + h * 64 + 8 * cgp), c1 = gldf4(a.in[14] + h * 64 + 8 * cgp + 4);
        float kkv[8] = {xk[0] * c0.x, xk[1] * c0.y, xk[2] * c0.z, xk[3] * c0.w, xk[4] * c1.x, xk[5] * c1.y, xk[6] * c1.z, xk[7] * c1.w};
        float n2 = 0.f;
#pragma unroll
        for (int i = 0; i < 8; ++i) n2 += kkv[i] * kkv[i];
        n2 += __shfl_xor(n2, 1); n2 += __shfl_xor(n2, 2); n2 += __shfl_xor(n2, 4);
        const float inv = __builtin_amdgcn_rsqf(fmaxf(n2, 1e-24f));
#pragma unroll
        for (int i = 0; i < 8; ++i) kkv[i] *= inv;
        *(GAS u32x4*)((bf16*)(a.ws + WS_KK) + go) = pack8(kkv);
        *(LAS f32x4*)(KKs + tok * 64 + 8 * cgp) = (f32x4){kkv[0], kkv[1], kkv[2], kkv[3]}; *(LAS f32x4*)(KKs + tok * 64 + 8 * cgp + 4) = (f32x4){kkv[4], kkv[5], kkv[6], kkv[7]};
    }
    {
        float xw[8], xa[8], xg[8];
        xm8_pre(R.c[3], R.p[3], col[3], fs, shift0, *(const LAS f32x4*)(MUs + (3 * 8 + cgp) * 8), *(const LAS f32x4*)(MUs + (3 * 8 + cgp) * 8 + 4), xw);
#pragma unroll
        for (int i = 0; i < 8; ++i) xw[i] = tanhf_(xw[i]);
        *(LAS u32x4*)(Lw + tok * 72 + 8 * cgp) = pack8(xw);
        xm8_pre(R.c[4], R.p[4], col[4], fs, shift0, *(const LAS f32x4*)(MUs + (4 * 8 + cgp) * 8), *(const LAS f32x4*)(MUs + (4 * 8 + cgp) * 8 + 4), xa);
        *(LAS u32x4*)(La + tok * 72 + 8 * cgp) = pack8(xa);
        xm8_pre(R.c[5], R.p[5], col[5], fs, shift0, *(const LAS f32x4*)(MUs + (5 * 8 + cgp) * 8), *(const LAS f32x4*)(MUs + (5 * 8 + cgp) * 8 + 4), xg);
#pragma unroll
        for (int i = 0; i < 8; ++i) xg[i] = sigmoidf_(xg[i]);
        *(LAS u32x4*)(Lg + tok * 136 + 16 * cgp) = pack8(xg);
        xm8_pre(R.c[6], R.p[6], col[6], fs, shift0, *(const LAS f32x4*)(MUs + (6 * 8 + cgp) * 8), *(const LAS f32x4*)(MUs + (6 * 8 + cgp) * 8 + 4), xg);
#pragma unroll
        for (int i = 0; i < 8; ++i) xg[i] = sigmoidf_(xg[i]);
        *(LAS u32x4*)(Lg + tok * 136 + 16 * cgp + 8) = pack8(xg);
    }
    LDS_WAIT();
    const int fr = lane & 15, fq = lane >> 4, arow = fr & 7;
    const bf16* W2T = (const bf16*)(a.ws + WS_W2T); const bf16* A2T = (const bf16*)(a.ws + WS_A2T); const bf16* G2T = (const bf16*)(a.ws + WS_G2T);
    const bf16x8 Aw0 = *(const LAS bf16x8*)(Lw + arow * 72 + 8 * fq), Aw1 = *(const LAS bf16x8*)(Lw + arow * 72 + 32 + 8 * fq);
    const bf16x8 Aa0 = *(const LAS bf16x8*)(La + arow * 72 + 8 * fq), Aa1 = *(const LAS bf16x8*)(La + arow * 72 + 32 + 8 * fq);
    f32x4 accw[4], acca[4];
#pragma unroll
    for (int nt = 0; nt < 4; ++nt) {
        const size_t bo = (size_t)(h * 64 + 16 * nt + fr) * 64 + 8 * fq;
        const bf16x8 bw0 = __builtin_bit_cast(bf16x8, gld16(W2T + bo)), bw1 = __builtin_bit_cast(bf16x8, gld16(W2T + bo + 32));
        const bf16x8 ba0 = __builtin_bit_cast(bf16x8, gld16(A2T + bo)), ba1 = __builtin_bit_cast(bf16x8, gld16(A2T + bo + 32));
        f32x4 z = {0.f, 0.f, 0.f, 0.f};
        accw[nt] = __builtin_amdgcn_mfma_f32_16x16x32_bf16(Aw0, bw0, z, 0, 0, 0); accw[nt] = __builtin_amdgcn_mfma_f32_16x16x32_bf16(Aw1, bw1, accw[nt], 0, 0, 0);
        acca[nt] = __builtin_amdgcn_mfma_f32_16x16x32_bf16(Aa0, ba0, z, 0, 0, 0); acca[nt] = __builtin_amdgcn_mfma_f32_16x16x32_bf16(Aa1, ba1, acca[nt], 0, 0, 0);
    }
    const bool lowh = fq < 2;
    const int ntb = lowh ? 0 : 2, tokb = 4 * (fq & 1);
    f32x4 Wsel[2], Asel[2];
    Wsel[0] = lowh ? accw[0] : accw[2]; Wsel[1] = lowh ? accw[1] : accw[3];
    Asel[0] = lowh ? acca[0] : acca[2]; Asel[1] = lowh ? acca[1] : acca[3];
    float rkp[4] = {0.f, 0.f, 0.f, 0.f};
    float* WD = (float*)(a.ws + WS_WD); bf16* BBp = (bf16*)(a.ws + WS_BB); bf16* KMp = (bf16*)(a.ws + WS_KM);
#pragma unroll
    for (int u = 0; u < 2; ++u) {
        const int c = 16 * (ntb + u) + fr, hc = h * 64 + c;
        const float w0c = a.in[9][hc], a0c = a.in[11][hc], kac = a.in[15][hc], rkc = a.in[16][hc];
#pragma unroll
        for (int e = 0; e < 4; ++e) {
            const int o = (tokb + e) * 64 + c;
            const float sg = sigmoidf_(Wsel[u][e] + w0c);
            const float decay = __expf(-0.6065306597126334f * sg);
            const float av = sigmoidf_(Asel[u][e] + a0c);
            const float kkv = KKs[o], kr = KRs[o], rv = Rs[o];
            const float kmod = kr * (1.0f + (av - 1.0f) * kac);
            Rs[o] = decay; KKs[o] = kkv * av; KRs[o] = kmod;
            rkp[e] += rv * kmod * rkc;
        }
    }
    float* RK = (float*)(a.ws + WS_RK);
#pragma unroll
    for (int e = 0; e < 4; ++e) { rkp[e] = row16_sum(rkp[e]); rkp[e] += __shfl_xor(rkp[e], 32); }
    if (fr == 0 && lowh) {
#pragma unroll
        for (int e = 0; e < 4; ++e) RK[(size_t)(row0 + tokb + e) * 8 + h] = rkp[e];
    }
    LDS_WAIT();
    {
        const LAS float* ps = Rs + tok * 64 + 8 * cgp; const f32x4 d0 = *(const LAS f32x4*)ps, d1 = *(const LAS f32x4*)(ps + 4);
        *(GAS f32x4*)(WD + go) = d0; *(GAS f32x4*)(WD + go + 4) = d1;
        const LAS float* pb = KKs + tok * 64 + 8 * cgp; const f32x4 b0 = *(const LAS f32x4*)pb, b1 = *(const LAS f32x4*)(pb + 4);
        const float bv[8] = {b0.x, b0.y, b0.z, b0.w, b1.x, b1.y, b1.z, b1.w};
        *(GAS u32x4*)(BBp + go) = pack8(bv);
        const LAS float* pk = KRs + tok * 64 + 8 * cgp; const f32x4 k0 = *(const LAS f32x4*)pk, k1 = *(const LAS f32x4*)(pk + 4);
        const float kv[8] = {k0.x, k0.y, k0.z, k0.w, k1.x, k1.y, k1.z, k1.w};
        *(GAS u32x4*)(KMp + go) = pack8(kv);
    }
    bf16x8 Ag[4];
#pragma unroll
    for (int ks = 0; ks < 4; ++ks) Ag[ks] = *(const LAS bf16x8*)(Lg + arow * 136 + 32 * ks + 8 * fq);
    bf16* Gb = (bf16*)(a.out + OS_G);
    LDS_WAIT();
    LAS float* Gs = (LAS float*)Lw;
    for (int nt = 0; nt < 4; ++nt) {
        const size_t bo = (size_t)(h * 64 + 16 * nt + fr) * 128 + 8 * fq;
        f32x4 acc = {0.f, 0.f, 0.f, 0.f};
#pragma unroll
        for (int ks = 0; ks < 4; ++ks) acc = __builtin_amdgcn_mfma_f32_16x16x32_bf16(Ag[ks], __builtin_bit_cast(bf16x8, gld16(G2T + bo + 32 * ks)), acc, 0, 0, 0);
        if (lowh) {
#pragma unroll
            for (int e = 0; e < 4; ++e) Gs[(4 * fq + e) * 64 + 16 * nt + fr] = acc[e];
        }
    }
    LDS_WAIT();
    {
        const LAS float* pg = Gs + tok * 64 + 8 * cgp; const f32x4 g0 = *(const LAS f32x4*)pg, g1 = *(const LAS f32x4*)(pg + 4);
        const float gv[8] = {g0.x, g0.y, g0.z, g0.w, g1.x, g1.y, g1.z, g1.w};
        *(GAS u32x4*)(Gb + go) = pack8(gv);
    }
    LDS_WAIT();
}

struct LdRaw { f32x4 w0, w1; u32x4 kk, b, k, r, v, kkn; };
__device__ __forceinline__ void loader_load(const Args& a, LdRaw& R, int pw, int lane, bool is_sample, int chain, int t0) {
    const int b = chain >> 3, h = chain & 7, tok = lane >> 3, cgp = lane & 7;
    const int row = (is_sample ? TP + b * DSEQ : b * SEQ + t0 + 8 * pw) + tok;
    const size_t go = (size_t)row * 512 + h * 64 + 8 * cgp;
    R.w0 = gldf4((const float*)(a.ws + WS_WD) + go); R.w1 = gldf4((const float*)(a.ws + WS_WD) + go + 4);
    R.kk = gld16((const bf16*)(a.ws + WS_KK) + go); R.b = gld16((const bf16*)(a.ws + WS_BB) + go); R.k = gld16((const bf16*)(a.ws + WS_KM) + go);
    R.r = gld16((const bf16*)(a.ws + WS_RR) + go); R.v = gld16((const bf16*)(a.out + OS_V) + go);
    R.kkn = gld16((const bf16*)(a.ws + WS_KK) + go + 512);
}
__device__ __forceinline__ void st8(LAS float* p, const u32x4 u) {
    float f[8]; unpack8(u, f);
    *(LAS f32x4*)p = (f32x4){f[0], f[1], f[2], f[3]}; *(LAS f32x4*)(p + 4) = (f32x4){f[4], f[5], f[6], f[7]};
}
__device__ __forceinline__ void loader_store(const LdRaw& R, LAS unsigned char* lds, int buf, int pw, int lane) {
    LAS float* B = (LAS float*)(lds + buf * SB_BYTES);
    const int o = (8 * pw + (lane >> 3)) * 64 + 8 * (lane & 7);
    *(LAS f32x4*)(B + SB_W + o) = R.w0; *(LAS f32x4*)(B + SB_W + o + 4) = R.w1;
    st8(B + SB_KK + o, R.kk); st8(B + SB_B + o, R.b); st8(B + SB_K + o, R.k); st8(B + SB_R + o, R.r); st8(B + SB_V + o, R.v);
    float bb[8], kn[8]; unpack8(R.b, bb); unpack8(R.kkn, kn);
    float part = 0.f;
#pragma unroll
    for (int i = 0; i < 8; ++i) part += bb[i] * kn[i];
    part += __shfl_xor(part, 1); part += __shfl_xor(part, 2); part += __shfl_xor(part, 4);
    if ((lane & 7) == 0) B[SB_BETA + 8 * pw + (lane >> 3)] = part;
}

typedef float f32x2 __attribute__((ext_vector_type(2)));
struct StepOps { f32x4 kk, w, b, k, r; float v; };
__device__ __forceinline__ void ld_step(StepOps& o, const LAS float* B, int off, int voff) {
    o.kk = *(const LAS f32x4*)(B + SB_KK + off); o.w = *(const LAS f32x4*)(B + SB_W + off); o.b = *(const LAS f32x4*)(B + SB_B + off);
    o.k = *(const LAS f32x4*)(B + SB_K + off); o.r = *(const LAS f32x4*)(B + SB_R + off); o.v = B[SB_V + voff];
}
__device__ __forceinline__ float wkv_step2(f32x2& Sa, f32x2& Sb, const f32x4 kk, const f32x4 w, const f32x4 b, const f32x4 k, const f32x4 r, const float vv) {
    f32x2 t = Sa * (f32x2){kk.x, kk.y}; t = Sb * (f32x2){kk.z, kk.w} + t;
    const float p = row16_sum(t.x + t.y);
    const float nu = -p;
    Sa = Sa * (f32x2){w.x, w.y} + (f32x2){b.x, b.y} * nu + (f32x2){k.x, k.y} * vv;
    Sb = Sb * (f32x2){w.z, w.w} + (f32x2){b.z, b.w} * nu + (f32x2){k.z, k.w} * vv;
    f32x2 u = Sa * (f32x2){r.x, r.y}; u = Sb * (f32x2){r.z, r.w} + u;
    return row16_sum(u.x + u.y);
}
__device__ __forceinline__ float wkv_step(f32x4& S, const f32x4 kk, const f32x4 w, const f32x4 b, const f32x4 k, const f32x4 r, const float vv) {
    f32x2 Sa = {S.x, S.y}, Sb = {S.z, S.w};
    const float y = wkv_step2(Sa, Sb, kk, w, b, k, r, vv);
    S = (f32x4){Sa.x, Sa.y, Sb.x, Sb.y};
    return y;
}

__device__ __forceinline__ void p2_scan(const Args& a, LAS unsigned char* lds, int G, int vcu, int wave, int lane) {
    const int nPI = (vcu < 256) ? (256 - vcu + G - 1) / G : 0;
    const int nSG = nPI;
    const int NT = nPI * 64 + nSG;
    const bool scanw = wave < 4;
    const int sw = wave & 3;
    const int jj = lane & 15, lr = 4 * sw + (lane >> 4);
    float* Yraw = a.out + OS_YRAW;
    f32x4 S = {0.f, 0.f, 0.f, 0.f};
#define TASK_DECODE(j, is_sample, item, chunk) const bool is_sample = (j) >= nPI * 64; const int item = is_sample ? vcu + ((j) - nPI * 64) * G : vcu + ((j) >> 6) * G; const int chunk = (j) & 63;
    LdRaw R;
    R.w0 = R.w1 = (f32x4){0.f, 0.f, 0.f, 0.f}; R.kk = R.b = R.k = R.r = R.v = R.kkn = (u32x4){0u, 0u, 0u, 0u};
    if (!scanw && NT > 0) {
        { TASK_DECODE(0, smp, item, chunk); loader_load(a, R, sw, lane, smp, smp ? 4 * item + sw : (item >> 2), chunk * 32); loader_store(R, lds, 0, sw, lane); }
        if (NT > 1) { TASK_DECODE(1, smp, item, chunk); loader_load(a, R, sw, lane, smp, smp ? 4 * item + sw : (item >> 2), chunk * 32); }
    }
    LDS_WAIT(); __builtin_amdgcn_s_barrier(); asm volatile("" ::: "memory");
    for (int j = 0; j < NT; ++j) {
        const bool smp_task = j >= nPI * 64;
        if (scanw || smp_task) {
            TASK_DECODE(j, smp, item, chunk);
            const LAS float* B = (const LAS float*)(lds + (j & 1) * SB_BYTES);
            if (!smp) {
                const int chain = item >> 2, q = item & 3, b = chain >> 3, h = chain & 7;
                if (chunk == 0) S = (f32x4){0.f, 0.f, 0.f, 0.f};
                const int rowb = b * SEQ + chunk * 32;
                const int vrow = 16 * q + lr;
                f32x2 Sa = {S.x, S.y}, Sb = {S.z, S.w};
                StepOps c0, c1, c2;
                ld_step(c0, B, 4 * jj, vrow); ld_step(c1, B, 64 + 4 * jj, 64 + vrow);
                float p;
                { f32x2 t = Sa * (f32x2){c0.kk.x, c0.kk.y}; t = Sb * (f32x2){c0.kk.z, c0.kk.w} + t; p = row16_sum(t.x + t.y); }
                for (int blk = 0; blk < 2; ++blk) {
                    float ykeep = 0.f;
#pragma unroll
                    for (int s2 = 0; s2 < 16; ++s2) {
                        const int sc_ = blk * 16 + s2;
                        const int sn = (sc_ + 2) & 31;
                        ld_step(c2, B, sn * 64 + 4 * jj, sn * 64 + vrow);
                        const float beta = B[SB_BETA + sc_];
                        const f32x2 Aa = Sa * (f32x2){c0.w.x, c0.w.y} + (f32x2){c0.k.x, c0.k.y} * c0.v;
                        const f32x2 Ab = Sb * (f32x2){c0.w.z, c0.w.w} + (f32x2){c0.k.z, c0.k.w} * c0.v;
                        f32x2 tq = Aa * (f32x2){c1.kk.x, c1.kk.y}; tq = Ab * (f32x2){c1.kk.z, c1.kk.w} + tq;
                        const float q = row16_sum(tq.x + tq.y);
                        const float np = -p;
                        Sa = Aa + (f32x2){c0.b.x, c0.b.y} * np; Sb = Ab + (f32x2){c0.b.z, c0.b.w} * np;
                        f32x2 u = Sa * (f32x2){c0.r.x, c0.r.y}; u = Sb * (f32x2){c0.r.z, c0.r.w} + u;
                        const float y = row16_sum(u.x + u.y);
                        ykeep = (s2 == jj) ? y : ykeep;
                        p = q + np * beta;
                        c0 = c1; c1 = c2;
                    }
                    Yraw[(size_t)(rowb + blk * 16 + jj) * 512 + h * 64 + vrow] = ykeep;
                }
                S = (f32x4){Sa.x, Sa.y, Sb.x, Sb.y};
                if (chunk == 63) *(GAS f32x4*)(a.out + O_WKVP + ((size_t)(chain * 64 + vrow)) * 64 + 4 * jj) = S;
            } else {
                for (int cs = scanw ? 0 : 2; cs < (scanw ? 2 : 4); ++cs) {
                    const int chain = 4 * item + cs, b = chain >> 3, h = chain & 7;
                    const float* st = a.in[4] + (size_t)chain * 4096;
                    f32x4 Sq[4]; float yk[4] = {0.f, 0.f, 0.f, 0.f};
#pragma unroll
                    for (int qq = 0; qq < 4; ++qq) Sq[qq] = gldf4(st + (16 * qq + lr) * 64 + 4 * jj);
#pragma unroll
                    for (int t = 0; t < 8; ++t) {
                        const int s = 8 * cs + t;
                        const f32x4 kk = *(const LAS f32x4*)(B + SB_KK + s * 64 + 4 * jj), w = *(const LAS f32x4*)(B + SB_W + s * 64 + 4 * jj), bb = *(const LAS f32x4*)(B + SB_B + s * 64 + 4 * jj);
                        const f32x4 k = *(const LAS f32x4*)(B + SB_K + s * 64 + 4 * jj), r = *(const LAS f32x4*)(B + SB_R + s * 64 + 4 * jj);
#pragma unroll
                        for (int qq = 0; qq < 4; ++qq) {
                            const float vv = B[SB_V + s * 64 + 16 * qq + lr];
                            const float y = wkv_step(Sq[qq], kk, w, bb, k, r, vv);
                            yk[qq] = (t == jj) ? y : yk[qq];
                        }
                    }
#pragma unroll
                    for (int qq = 0; qq < 4; ++qq) {
                        if (jj < 8) Yraw[(size_t)(TP + b * DSEQ + jj) * 512 + h * 64 + 16 * qq + lr] = yk[qq];
                        *(GAS f32x4*)(a.out + O_WKVS + ((size_t)(chain * 64 + 16 * qq + lr)) * 64 + 4 * jj) = Sq[qq];
                    }
                }
            }
        }
        if (!scanw && j + 1 < NT) {
            loader_store(R, lds, (j + 1) & 1, sw, lane);
            if (j + 2 < NT) { TASK_DECODE(j + 2, smp, item, chunk); loader_load(a, R, sw, lane, smp, smp ? 4 * item + sw : (item >> 2), chunk * 32); }
        }
        LDS_WAIT(); __builtin_amdgcn_s_barrier(); asm volatile("" ::: "memory");
    }
#undef TASK_DECODE
}

struct MixConst { f32x4 w[6]; f32x4 l[4]; };
struct MixRaw { u32x4 cb, cc0, cx0, cc1, cx1, cc2, cx2, g, v; f32x4 y0, y1; float rk; };
__device__ __forceinline__ void p3_load(const Args& a, MixRaw& R, int row, int lane) {
    const bool smp = row >= TP;
    const int t = smp ? ((row - TP) & 7) : (row & 2047);
    const bf16* pr = (const bf16*)(a.ws + WS_PROJ) + (size_t)row * IC;
    const int c8 = 8 * lane;
    const u32x4 z = {0u, 0u, 0u, 0u};
    R.cb = gld16(pr + c8); R.cc0 = gld16(pr + 512 + c8); R.cx0 = gld16(pr + 1024 + c8);
    R.cc1 = z; R.cx1 = z; R.cc2 = z; R.cx2 = z;
    if (t >= 1) { R.cc1 = gld16(pr - IC + 512 + c8); R.cx1 = gld16(pr - IC + 1024 + c8); }
    if (t >= 2) { R.cc2 = gld16(pr - 2 * IC + 512 + c8); R.cx2 = gld16(pr - 2 * IC + 1024 + c8); }
    const float* yr = a.out + OS_YRAW + (size_t)row * 512 + c8;
    R.y0 = gldf4(yr); R.y1 = gldf4(yr + 4);
    R.v = gld16((const bf16*)(a.out + OS_V) + (size_t)row * 512 + c8);
    R.g = gld16((const bf16*)(a.out + OS_G) + (size_t)row * 512 + c8);
    R.rk = ((const float*)(a.ws + WS_RK))[(size_t)row * 8 + (lane >> 3)];
}
__device__ __forceinline__ void p3_token(const Args& a, const MixConst& K, const MixRaw& R, int row, int lane) {
    const bool smp = row >= TP;
    const int rr = row - TP;
    const int b = smp ? (rr >> 3) : (row >> 11), t = smp ? (rr & 7) : (row & 2047), L = smp ? DSEQ : SEQ;
    const bf16* pr = (const bf16*)(a.ws + WS_PROJ) + (size_t)row * IC;
    const int c8 = 8 * lane;
    float yconv[8], yrw[8];
    {
        float cb[8], cc[8], cx[8], u0[8], f1[8], f2[8];
        unpack8(R.cb, cb); unpack8(R.cc0, cc); unpack8(R.cx0, cx);
#pragma unroll
        for (int i = 0; i < 8; ++i) u0[i] = cc[i] * cx[i];
        unpack8(R.cc1, cc); unpack8(R.cx1, cx);
#pragma unroll
        for (int i = 0; i < 8; ++i) f1[i] = cc[i] * cx[i];
        unpack8(R.cc2, cc); unpack8(R.cx2, cx);
#pragma unroll
        for (int i = 0; i < 8; ++i) f2[i] = cc[i] * cx[i];
        if (smp && t < 2) {
            const float* sc = a.in[2] + (size_t)b * 1024;
            if (t == 0) { const f32x4 s0 = gldf4(sc + 512 + c8), s1 = gldf4(sc + 512 + c8 + 4); f1[0] = s0.x; f1[1] = s0.y; f1[2] = s0.z; f1[3] = s0.w; f1[4] = s1.x; f1[5] = s1.y; f1[6] = s1.z; f1[7] = s1.w; }
            const float* sp = sc + (t == 1 ? 512 : 0) + c8; const f32x4 s0 = gldf4(sp), s1 = gldf4(sp + 4);
            f2[0] = s0.x; f2[1] = s0.y; f2[2] = s0.z; f2[3] = s0.w; f2[4] = s1.x; f2[5] = s1.y; f2[6] = s1.z; f2[7] = s1.w;
        }
        const f32x4 w00 = K.w[0], w01 = K.w[1], w10 = K.w[2], w11 = K.w[3], w20 = K.w[4], w21 = K.w[5];
        const float W0[8] = {w00.x, w00.y, w00.z, w00.w, w01.x, w01.y, w01.z, w01.w}, W1[8] = {w10.x, w10.y, w10.z, w10.w, w11.x, w11.y, w11.z, w11.w}, W2[8] = {w20.x, w20.y, w20.z, w20.w, w21.x, w21.y, w21.z, w21.w};
#pragma unroll
        for (int i = 0; i < 8; ++i) yconv[i] = cb[i] * (f2[i] * W0[i] + f1[i] * W1[i] + u0[i] * W2[i]);
        if (t >= L - 2) {
            float* oc = a.out + (smp ? O_CONVS : O_CONVP) + (size_t)b * 1024 + (t == L - 1 ? 512 : 0) + c8;
            *(GAS f32x4*)oc = (f32x4){u0[0], u0[1], u0[2], u0[3]}; *(GAS f32x4*)(oc + 4) = (f32x4){u0[4], u0[5], u0[6], u0[7]};
        }
    }
    {
        const f32x4 y0 = R.y0, y1 = R.y1;
        float y[8] = {y0.x, y0.y, y0.z, y0.w, y1.x, y1.y, y1.z, y1.w};
        float s = 0.f;
#pragma unroll
        for (int i = 0; i < 8; ++i) s += y[i];
        s += __shfl_xor(s, 1); s += __shfl_xor(s, 2); s += __shfl_xor(s, 4);
        const float mean = s * (1.f / 64.f);
        float qv = 0.f;
#pragma unroll
        for (int i = 0; i < 8; ++i) { y[i] -= mean; qv += y[i] * y[i]; }
        qv += __shfl_xor(qv, 1); qv += __shfl_xor(qv, 2); qv += __shfl_xor(qv, 4);
        const float rs = 1.0f / sqrtf(qv * (1.f / 64.f) + 64e-5f);
        float xv[8], g[8];
        unpack8(R.v, xv); unpack8(R.g, g);
        const float rk = R.rk;
        const f32x4 l0 = K.l[0], l1 = K.l[1], b0 = K.l[2], b1 = K.l[3];
        const float lg[8] = {l0.x, l0.y, l0.z, l0.w, l1.x, l1.y, l1.z, l1.w}, lb[8] = {b0.x, b0.y, b0.z, b0.w, b1.x, b1.y, b1.z, b1.w};
#pragma unroll
        for (int i = 0; i < 8; ++i) yrw[i] = (y[i] * rs * lg[i] + lb[i] + rk * xv[i]) * g[i];
    }
    bf16* ym = (bf16*)(a.ws + WS_XN) + (size_t)row * 1024;
    *(GAS u32x4*)(ym + c8) = pack8(yconv);
    *(GAS u32x4*)(ym + 512 + c8) = pack8(yrw);
    if (t == L - 1) {
        float* os = a.out + (smp ? O_SHIFTS : O_SHIFTP) + (size_t)b * RWC;
#pragma unroll
        for (int i = 0; i < 7; ++i) { const int c = i * 256 + 4 * lane; const u32x2 u = *(const GAS u32x2*)(pr + PRW + c);
            *(GAS f32x4*)(os + c) = (f32x4){bflo(u.x), bfhi(u.x), bflo(u.y), bfhi(u.y)}; }
    }
}

#define XB_TMO      128
#define XB_XCNT(j)  (256  + 64 * (j))
#define XB_XSUB(j)  (1280 + 64 * (j))
#define XB_XGEN(j)  (2304 + 64 * (j))
#define XB_TOP      3328
#define XB_TOPGEN   3392
#define XCD_BAR_WORDS 3456
#define XB_SPIN_CAP (1u << 18)

__device__ __forceinline__ unsigned xb_ld(unsigned* p)              { return __hip_atomic_load(p, __ATOMIC_RELAXED, __HIP_MEMORY_SCOPE_AGENT); }
__device__ __forceinline__ unsigned xb_add(unsigned* p, unsigned v) { return __hip_atomic_fetch_add(p, v, __ATOMIC_RELAXED, __HIP_MEMORY_SCOPE_AGENT); }
__device__ __forceinline__ unsigned xb_xcc_id() { return (unsigned)__builtin_amdgcn_s_getreg((3 << 11) | 20) & 0xFu; }
#define XB_SPIN(cond, bar) do { unsigned _sp = 0; while (cond) { __builtin_amdgcn_s_sleep(1); \
    if ((++_sp & 255u) == 0u) { if (xb_ld(&(bar)[XB_TMO])) break; if (_sp > XB_SPIN_CAP) { atomicAdd(&(bar)[XB_TMO], 1u); break; } } } } while (0)

struct XcdBarrier {
    unsigned* bar; unsigned x;
    volatile LAS unsigned* st;
};

__device__ __forceinline__ XcdBarrier xcd_barrier_post(unsigned* bar, volatile LAS unsigned* st) {
    XcdBarrier b; b.bar = bar; b.x = xb_xcc_id(); b.st = st;
    if (threadIdx.x == 0) (void)xb_add(&bar[XB_XCNT(b.x)], 1u);
    return b;
}
__device__ __forceinline__ void xcd_barrier_complete(unsigned* bar, unsigned x, unsigned& nloc, unsigned& nx) {
    const unsigned G = gridDim.x * gridDim.y * gridDim.z;
    unsigned sum, cnt, mine, sp = 0u;
    for (;;) {
        sum = 0u; cnt = 0u; mine = 0u;
#pragma unroll
        for (unsigned j = 0; j < 16; ++j) { const unsigned c = xb_ld(&bar[XB_XCNT(j)]); sum += c; cnt += (c > 0u) ? 1u : 0u; mine = (j == x) ? c : mine; }
        if (sum == G) break;
        __builtin_amdgcn_s_sleep(1);
        if ((++sp & 255u) == 0u) { if (xb_ld(&bar[XB_TMO])) break; if (sp > XB_SPIN_CAP) { atomicAdd(&bar[XB_TMO], 1u); break; } }
    }
    nloc = mine > 0u ? mine : 1u; nx = cnt > 0u ? cnt : 1u;
}

__device__ __forceinline__ void xcd_barrier(const XcdBarrier& b) {
    asm volatile("s_waitcnt vmcnt(0)" ::: "memory");
    __syncthreads();
    if (threadIdx.x == 0) {
        unsigned* bar = b.bar;
        __builtin_amdgcn_s_waitcnt(0);
        unsigned nloc = b.st[0], nx = b.st[1];
        if (nloc == 0u) { xcd_barrier_complete(bar, b.x, nloc, nx); b.st[0] = nloc; b.st[1] = nx; }
        const unsigned old = xb_add(&bar[XB_XSUB(b.x)], 1u);
        const unsigned gen = old / nloc;
        if (old + 1u == (gen + 1u) * nloc) {
            __builtin_amdgcn_fence(__ATOMIC_RELEASE, "agent");
            asm volatile("s_waitcnt vmcnt(0)" ::: "memory");
            const unsigned og = xb_add(&bar[XB_TOP], 1u);
            const unsigned tg = og / nx;
            if (og + 1u == (tg + 1u) * nx) xb_add(&bar[XB_TOPGEN], 1u);
            else XB_SPIN(xb_ld(&bar[XB_TOPGEN]) == tg, bar);
            __builtin_amdgcn_fence(__ATOMIC_ACQUIRE, "agent");
            xb_add(&bar[XB_XGEN(b.x)], 1u);
            asm volatile("s_waitcnt vmcnt(0)" ::: "memory");
        } else {
            XB_SPIN(xb_ld(&bar[XB_XGEN(b.x)]) == gen, bar);
            __builtin_amdgcn_fence(__ATOMIC_ACQUIRE, "agent");
            asm volatile("s_waitcnt vmcnt(0)" ::: "memory");
        }
    }
    __syncthreads();
}

__global__ void __launch_bounds__(512, 2) fwd_kernel(Args a) {
    extern __shared__ __attribute__((aligned(16))) unsigned char lds_raw[];
    LAS unsigned char* lds = (LAS unsigned char*)lds_raw;
    cg::grid_group grid = cg::this_grid();
    const int tid = threadIdx.x, lane = tid & 63, wave = __builtin_amdgcn_readfirstlane(tid >> 6);
    const int G = gridDim.x, bx = blockIdx.x;
    const int vcu = (G % 8 == 0) ? (bx % 8) * (G / 8) + bx / 8 : bx;
    const int gw = vcu * 8 + wave, NGW = G * 8;
    const int lo = a.ph_lo, hi = a.ph_hi;
#define IN(k) (lo <= (k) && (k) < hi)
    volatile LAS unsigned* barst = (volatile LAS unsigned*)(lds + LDS_BARST);
    if (tid == 0) { barst[0] = 0u; barst[1] = 0u; }
    __syncthreads();
    const XcdBarrier bar = xcd_barrier_post((unsigned*)(a.ws + WS_BAR) + a.li * XCD_BAR_WORDS, barst);
    if (a.ph_lo < 0) grid.sync();
#define SEAM(k) do { if (IN(k) && IN((k) + 1)) xcd_barrier(bar); } while (0)
    unsigned char* ws = a.ws;
    bf16* WT_IN = (bf16*)(ws + WS_WIN); bf16* WT_OUT = (bf16*)(ws + WS_WOUT); bf16* WT_FF1 = (bf16*)(ws + WS_WFF1); bf16* WT_FF2 = (bf16*)(ws + WS_WFF2);
    bf16* XN = (bf16*)(ws + WS_XN); bf16* XG = (bf16*)(ws + WS_XG); bf16* PROJ = (bf16*)(ws + WS_PROJ); bf16* HB = (bf16*)(ws + WS_H);
    float* SS1 = (float*)(ws + WS_SS1); float* SS2 = (float*)(ws + WS_SS2);

    if (IN(0)) {
        LAS float* scr = (LAS float*)(lds + wave * 16384);
        constexpr int I_IN = 16 * (IC / 32), I_OUT = 16 * 32, I_F1 = 16 * (FFD / 32), I_F2 = 64 * 32, I_W2 = 16, I_A2 = 16, I_G2 = 2 * 16;
        constexpr int NITEMS = I_IN + I_W2 + I_A2 + I_G2;
        for (int it = gw; it < NITEMS; it += NGW) {
            int r = it;
            if (r < I_IN) { p0_transpose_item(a.in[6], DM, IC, WT_IN, scr, r, lane); continue; } r -= I_IN;
            if (r < I_W2) { p0_transpose_item(a.in[10], 64, 512, (bf16*)(ws + WS_W2T), scr, r, lane); continue; } r -= I_W2;
            if (r < I_A2) { p0_transpose_item(a.in[12], 64, 512, (bf16*)(ws + WS_A2T), scr, r, lane); continue; } r -= I_A2;
            p0_transpose_item(a.in[13], 128, 512, (bf16*)(ws + WS_G2T), scr, r, lane);
        }
        {
            const GAS f32x4* gr = (const GAS f32x4*)a.in[5] + lane;
            const f32x4 g0 = gr[0], g1 = gr[64], g2 = gr[128], g3 = gr[192];
            for (int m0 = gw; m0 < TT; m0 += 4 * NGW) {
                f32x4 v[4][4];
#pragma unroll
                for (int k = 0; k < 4; ++k) { const int m = m0 + k * NGW;
                    if (m < TT) { const float* xrow = (m < TP) ? a.in[0] + (size_t)m * DM : a.in[1] + (size_t)(m - TP) * DM; const GAS f32x4* xr = (const GAS f32x4*)xrow + lane;
                        v[k][0] = xr[0]; v[k][1] = xr[64]; v[k][2] = xr[128]; v[k][3] = xr[192]; }
                    else { v[k][0] = v[k][1] = v[k][2] = v[k][3] = (f32x4){0.f, 0.f, 0.f, 0.f}; } }
#pragma unroll
                for (int k = 0; k < 4; ++k) { const int m = m0 + k * NGW;
                    float s2 = 0.f;
#pragma unroll
                    for (int j = 0; j < 4; ++j) s2 += (v[k][j].x * v[k][j].x + v[k][j].y * v[k][j].y) + (v[k][j].z * v[k][j].z + v[k][j].w * v[k][j].w);
                    const float rstd = 1.0f / sqrtf(wave_sum(s2) * (1.f / DM) + 1e-6f);
                    if (m < TT) { GAS u32x2* o8 = (GAS u32x2*)(XN + (size_t)m * DM) + lane;
                        u32x2 w; w.x = pk2(v[k][0].x * rstd * g0.x, v[k][0].y * rstd * g0.y); w.y = pk2(v[k][0].z * rstd * g0.z, v[k][0].w * rstd * g0.w); o8[0] = w;
                        w.x = pk2(v[k][1].x * rstd * g1.x, v[k][1].y * rstd * g1.y); w.y = pk2(v[k][1].z * rstd * g1.z, v[k][1].w * rstd * g1.w); o8[64] = w;
                        w.x = pk2(v[k][2].x * rstd * g2.x, v[k][2].y * rstd * g2.y); w.y = pk2(v[k][2].z * rstd * g2.z, v[k][2].w * rstd * g2.w); o8[128] = w;
                        w.x = pk2(v[k][3].x * rstd * g3.x, v[k][3].y * rstd * g3.y); w.y = pk2(v[k][3].z * rstd * g3.z, v[k][3].w * rstd * g3.w); o8[192] = w; }
                }
            }
        }
    }
    SEAM(0);
    if (IN(1)) {
        pg8::Gemm g{XN, WT_IN, TT, IC, DM}; pg8::StaticOrder S; S.init(TT, IC, G, bx);
        pg8::EpiStore<0> E{PROJ, IC};
        pg8::gemm_phase<pg8::EpiStore<0>, pg8::StaticOrder, true, true>(lds, g, S, E);
        {
            const int ntile = (TT / 256) * (IC / 256), full = ntile / G, nbusy = ntile - full * G;
            if (bx >= nbusy) {
                constexpr int I_OUT = 16 * 32, I_F1 = 16 * (FFD / 32), I_F2 = 64 * 32;
                LAS float* scr = (LAS float*)(lds + wave * 16384);
                for (int it = (bx - nbusy) * 8 + wave; it < I_OUT + I_F1 + I_F2; it += (G - nbusy) * 8) {
                    int r = it;
                    if (r < I_OUT) { p0_transpose_item(a.in[19], DM, DM, WT_OUT, scr, r, lane); continue; } r -= I_OUT;
                    if (r < I_F1) { p0_transpose_item(a.in[21], DM, FFD, WT_FF1, scr, r, lane); continue; } r -= I_F1;
                    p0_transpose_item(a.in[22], FFD, DM, WT_FF2, scr, r, lane);
                }
            }
        }
    }
    SEAM(1);
    if (IN(2)) {
        LAS unsigned char* scr = lds + wave * PREP_SCR;
        PrepConst C; C.unused = 0;
        {
            const int h = gw & 7, cgp = lane & 7;
            int col[7]; prep_cols(h, cgp, col);
            LAS float* MUw = (LAS float*)(scr + PREP_MU);
#pragma unroll
            for (int i = 0; i < 7; ++i) { *(LAS f32x4*)(MUw + (i * 8 + cgp) * 8) = gldf4(a.in[8] + col[i]); *(LAS f32x4*)(MUw + (i * 8 + cgp) * 8 + 4) = gldf4(a.in[8] + col[i] + 4); }
            LDS_WAIT();
        }
        PrepRaw R, Rn;
        int it = gw;
        if (it < TT) prep_load(a, R, lane, (it >> 3) * 8, it & 7);
        while (it < TT) {
            const int nit = it + NGW;
            if (nit < TT) prep_load(a, Rn, lane, (nit >> 3) * 8, nit & 7);
            prep_item(a, C, R, scr, lane, (it >> 3) * 8, it & 7);
            R = Rn; it = nit;
        }
    }
    SEAM(2);
    if (IN(3)) p2_scan(a, lds, G, vcu, wave, lane);
    SEAM(3);
    if (IN(4)) {
        MixConst K; { const int c8 = 8 * lane; const float* cw = a.in[7];
            K.w[0] = gldf4(cw + c8); K.w[1] = gldf4(cw + c8 + 4); K.w[2] = gldf4(cw + 512 + c8); K.w[3] = gldf4(cw + 512 + c8 + 4); K.w[4] = gldf4(cw + 1024 + c8); K.w[5] = gldf4(cw + 1024 + c8 + 4);
            K.l[0] = gldf4(a.in[17] + c8); K.l[1] = gldf4(a.in[17] + c8 + 4); K.l[2] = gldf4(a.in[18] + c8); K.l[3] = gldf4(a.in[18] + c8 + 4); }
        MixRaw R, Rn;
        int m = gw;
        if (m < TT) p3_load(a, R, m, lane);
        while (m < TT) {
            const int mn = m + NGW;
            if (mn < TT) p3_load(a, Rn, mn, lane);
            p3_token(a, K, R, m, lane);
            R = Rn; m = mn;
        }
    }
    SEAM(4);
    if (IN(5)) {
        unsigned* ocnt = (unsigned*)(ws + WS_BAR) + 30000;
        if (G == 256) {
            { pg8::Gemm g{XN, WT_OUT, TT, DM, DM}; pg8::OutOrder S{G, bx, ocnt};
              pg8::EpiRes<0> E{a.in[0], a.in[1], a.out, XG, a.in[20], nullptr, SS1};
              pg8::gemm_phase<pg8::EpiRes<0>, pg8::OutOrder, true, true>(lds, g, S, E); }
            {
              pg8::Gemm g{XG, WT_FF1, TT, FFD, DM}; pg8::SampleFF1Order S{G, bx, ocnt, 16u * 8u};
              pg8::EpiStore<1> E{HB, FFD};
              pg8::gemm_phase<pg8::EpiStore<1>, pg8::SampleFF1Order, true, true>(lds, g, S, E); }
        } else {
            pg8::Gemm g{XN, WT_OUT, TT, DM, DM}; pg8::StaticOrder S; S.init(TT, DM, G, bx);
            pg8::EpiRes<0> E{a.in[0], a.in[1], a.out, XG, a.in[20], nullptr, SS1};
            pg8::gemm_phase<pg8::EpiRes<0>, pg8::StaticOrder, true, true>(lds, g, S, E);
        }
    }
    SEAM(5);
    if (IN(6)) {
        const int mrows = (G == 256) ? TP : TT;
        pg8::Gemm g{XG, WT_FF1, mrows, FFD, DM}; pg8::StaticOrder S; S.init(mrows, FFD, G, bx);
        pg8::EpiStore<1> E{HB, FFD};
        pg8::gemm_phase<pg8::EpiStore<1>, pg8::StaticOrder, true, true>(lds, g, S, E);
    }
    SEAM(6);
    if (IN(7)) {
        {
            pg8::Gemm g{HB, WT_FF2, TP, DM, FFD, 0}; pg8::StaticOrder S; S.init(TP, DM, G, bx);
            if (G == 256) {
                pg8::EpiResNorm E{a.out, SS1, a.in[23], (float*)(ws + WS_XSTAT), (unsigned*)(ws + WS_BAR) + 20000};
                pg8::gemm_phase<pg8::EpiResNorm, pg8::StaticOrder, false, true>(lds, g, S, E);
            } else {
                pg8::EpiRes<1> E{nullptr, nullptr, a.out, nullptr, nullptr, SS1, SS2};
                pg8::gemm_phase<pg8::EpiRes<1>, pg8::StaticOrder, true, true>(lds, g, S, E);
            }
        }
        {
            pg8::Gemm g{HB, WT_FF2, TT, DM, 512, FFD}; pg8::SplitOrder S{G, bx};
            pg8::EpiPart E{(float*)(ws + WS_PART)};
            pg8::gemm_phase<pg8::EpiPart, pg8::SplitOrder, true, true>(lds, g, S, E);
        }
    }
    SEAM(7);
    if (IN(8)) {
        for (int m = gw; m < TT; m += NGW) {
            GAS f32x4* xr = (GAS f32x4*)(a.out + (size_t)m * DM) + lane; const GAS f32x4* gr = (const GAS f32x4*)a.in[23] + lane;
            if (m < TP) {
                if (G == 256) continue;
                float s = (lane < 16) ? SS2[(size_t)m * 16 + lane] : 0.f;
                const float rstd = 1.0f / sqrtf(wave_sum(s) * (1.f / DM) + 1e-6f);
#pragma unroll
                for (int j = 0; j < 4; ++j) { const f32x4 v = xr[64 * j], gg = gr[64 * j]; xr[64 * j] = v * rstd * gg; }
            } else {
                float s1 = (lane < 16) ? SS1[(size_t)m * 16 + lane] : 0.f;
                const float sc = 1.0f / (wave_sum(s1) * (1.f / DM) + 1e-6f);
                const GAS f32x4* pr = (const GAS f32x4*)((const float*)(ws + WS_PART) + (size_t)(m - TP) * 1024) + lane;
                f32x4 x2[4]; float s2 = 0.f;
#pragma unroll
                for (int j = 0; j < 4; ++j) {
                    f32x4 acc = pr[64 * j];
#pragma unroll
                    for (int kc = 1; kc < 8; ++kc) acc = acc + pr[(size_t)kc * (1024 * 1024 / 4) + 64 * j];
                    x2[j] = xr[64 * j] + acc * sc;
                    s2 += (x2[j].x * x2[j].x + x2[j].y * x2[j].y) + (x2[j].z * x2[j].z + x2[j].w * x2[j].w);
                }
                const float rstd = 1.0f / sqrtf(wave_sum(s2) * (1.f / DM) + 1e-6f);
#pragma unroll
                for (int j = 0; j < 4; ++j) xr[64 * j] = x2[j] * rstd * gr[64 * j];
            }
        }
    }
#undef IN
#undef SEAM
}

extern "C" void kernel_launch(void* const* d_in, const int* in_sizes, int n_in, void* d_out, int out_size, void* d_ws, size_t ws_size, hipStream_t stream) {
    static int grid = 0;
    if (grid == 0) {
        int dev = 0, cus = 0, per_cu = 0;
        (void)hipGetDevice(&dev);
        (void)hipDeviceGetAttribute(&cus, hipDeviceAttributeMultiprocessorCount, dev);
        if (hipFuncSetAttribute((const void*)fwd_kernel, hipFuncAttributeMaxDynamicSharedMemorySize, LDS_BYTES) != hipSuccess) fprintf(stderr, "hipFuncSetAttribute failed\n");
        if (hipOccupancyMaxActiveBlocksPerMultiprocessor(&per_cu, (const void*)fwd_kernel, 512, LDS_BYTES) != hipSuccess || per_cu < 1) { fprintf(stderr, "occupancy query: %d\n", per_cu); per_cu = 1; }
        (void)hipGetLastError();
        grid = cus * 1;
        if (n_in != 24 || ws_size < WS_END) fprintf(stderr, "unexpected n_in %d ws %zu\n", n_in, ws_size);
    }
    Args a{};
    for (int i = 0; i < 24; ++i) a.in[i] = (const float*)d_in[i];
    a.out = (float*)d_out; a.ws = (unsigned char*)d_ws;
#ifndef PROBE_SEQ
#define PROBE_SEQ {0, 9}
#endif
    static const int seq[] = PROBE_SEQ;
    (void)hipMemsetAsync((unsigned char*)d_ws + WS_BAR, 0, BAR_ZERO_BYTES, stream);
    for (unsigned i = 0; i + 1 < sizeof(seq) / sizeof(seq[0]); i += 2) {
        a.ph_lo = seq[i]; a.ph_hi = seq[i + 1]; a.li = (int)(i / 2);
        void* args[] = {&a};
        hipError_t e = hipLaunchCooperativeKernel((const void*)fwd_kernel, dim3(grid), dim3(512), args, LDS_BYTES, stream);
        if (e != hipSuccess) fprintf(stderr, "cooperative launch failed: %s (grid %d)\n", hipGetErrorString(e), grid);
    }
}
```

```cpp
#include <hip/hip_runtime.h>
#include <hip/hip_cooperative_groups.h>
#include <cstdio>
#include <cstdint>
namespace cg = cooperative_groups;
namespace pg8 {
#define PG8_LAS __attribute__((address_space(3)))
typedef unsigned short bf16_t;
typedef short bf16x8 __attribute__((ext_vector_type(8)));
typedef float f32x4 __attribute__((ext_vector_type(4)));
typedef unsigned u32x4 __attribute__((ext_vector_type(4)));
constexpr int BM = 256, BK = 64, HALF = 128, HTB = HALF * BK * 2  , STAGE_BYTES = 8 * HTB, NXCD = 8, WGM = 8;

__host__ __device__ __forceinline__ int lds_byte(int r, int c) { const int st = (r >> 4) * 2 + (c >> 5), rr = r & 15, cc = c & 31, ob = rr * 64 + cc * 2; return st * 1024 + (ob ^ (((ob >> 9) & 1) << 5)); }
__host__ __device__ __forceinline__ void stage_rc(int b, int& R, int& C) { const int st = b / 1024, sb = b % 1024, swz = sb ^ (((sb >> 9) & 1) << 5); R = (st >> 1) * 16 + swz / 64; C = (st & 1) * 32 + (swz % 64) / 2; }
__host__ __device__ __forceinline__ int perm32(int rho) { const int n = rho >> 4, i = rho & 15; return 8 * (i >> 2) + 4 * n + (i & 3); }

struct Unit { int pm, pn, ko; };
struct Gemm { const bf16_t* A; const bf16_t* Bt; int M, N, K, ld; };

struct StaticOrder {
    int nM, nN, nwg, G, c;
    __host__ __device__ void init(int M, int N, int G_, int c_) { nM = M / BM; nN = N / BM; nwg = nM * nN; G = G_; c = c_; }
    __host__ __device__ bool next(int i, Unit& u) const {
        const long L = (long)i * G + c; if (L >= nwg) return false;
        int wgid = (int)L; { const int q = nwg / NXCD, r = nwg % NXCD, xcd = wgid % NXCD, off = wgid / NXCD; wgid = (xcd < r ? xcd * (q + 1) : r * (q + 1) + (xcd - r) * q) + off; }
        const int nig = WGM * nN, gid = wgid / nig, fm = gid * WGM, gsz = (nM - fm) < WGM ? (nM - fm) : WGM;
        u.pm = fm + ((wgid % nig) % gsz); u.pn = (wgid % nig) / gsz; u.ko = 0; return true;
    }
    __device__ __forceinline__ void a_ready(const Unit&) const {}
    __device__ __forceinline__ void done(const Unit&) const {}
};

__device__ __forceinline__ unsigned cvt_pk_bf16(float lo, float hi) { unsigned r; asm volatile("v_cvt_pk_bf16_f32 %0, %1, %2" : "=v"(r) : "v"(lo), "v"(hi)); return r; }
#define PG8_GAS __attribute__((address_space(1)))
template <int ACT  > struct EpiStore {
    static constexpr bool PERM = true, AFTER_DRAIN = false;
    bf16_t* O; int ldc;
    __device__ __forceinline__ void operator()(const f32x4 (&acc)[2][2][4][2], const Unit& u, int wr, int wc, int fr, int fq) const {
        const int row0 = u.pm * BM + wr * 64 + fr, col0 = u.pn * BM + wc * 32 + 8 * fq;
#pragma unroll
        for (int ai = 0; ai < 2; ++ai)
#pragma unroll
            for (int m = 0; m < 4; ++m) { bf16_t* rowp = O + (size_t)(row0 + ai * HALF + m * 16) * ldc + col0;
#pragma unroll
                for (int bj = 0; bj < 2; ++bj) { f32x4 v0 = acc[ai][bj][m][0], v1 = acc[ai][bj][m][1];
                    if (ACT == 1) { v0 = __builtin_elementwise_max(v0, (f32x4){0.f, 0.f, 0.f, 0.f}); v1 = __builtin_elementwise_max(v1, (f32x4){0.f, 0.f, 0.f, 0.f}); v0 = v0 * v0; v1 = v1 * v1; }
                    u32x4 w; w.x = cvt_pk_bf16(v0[0], v0[1]); w.y = cvt_pk_bf16(v0[2], v0[3]); w.z = cvt_pk_bf16(v1[0], v1[1]); w.w = cvt_pk_bf16(v1[2], v1[3]);
                    asm volatile("global_store_dwordx4 %0, %1, off sc1\n\ts_nop 1" :: "v"(rowp + bj * HALF), "v"(w) : "memory"); } }
    }
};
template <int MODE> struct EpiRes {
    static constexpr bool PERM = true, AFTER_DRAIN = false;
    const float* xp; const float* xs; float* out; bf16_t* XG; const float* gam; const float* ss_in; float* ssq;
    __device__ __forceinline__ void operator()(const f32x4 (&acc)[2][2][4][2], const Unit& u, int wr, int wc, int fr, int fq) const {
        const int row0 = u.pm * BM + wr * 64 + fr, col0 = u.pn * BM + wc * 32 + 8 * fq;
        f32x4 gv[2][2];
        if (MODE == 0) {
#pragma unroll
            for (int bj = 0; bj < 2; ++bj)
#pragma unroll
                for (int n = 0; n < 2; ++n) gv[bj][n] = *(const PG8_GAS f32x4*)(gam + col0 + bj * HALF + 4 * n);
        }
#pragma unroll
        for (int ai = 0; ai < 2; ++ai)
#pragma unroll
            for (int m = 0; m < 4; ++m) {
                const int row = row0 + ai * HALF + m * 16;
                const float* xin; float sc = 1.f;
                if (MODE == 0) { xin = (row < 16384) ? xp + (size_t)row * 1024 : xs + (size_t)(row - 16384) * 1024; }
                else { xin = out + (size_t)row * 1024;
                    const PG8_GAS f32x4* sp = (const PG8_GAS f32x4*)(ss_in + (size_t)row * 16);
                    const f32x4 s0 = sp[0], s1 = sp[1], s2 = sp[2], s3 = sp[3];
                    const f32x4 st = (s0 + s1) + (s2 + s3);
                    const float tot = (st[0] + st[1]) + (st[2] + st[3]);
                    sc = 1.0f / (tot * (1.0f / 1024.0f) + 1e-6f); }
                float* op = out + (size_t)row * 1024 + col0;
                float ss = 0.f;
#pragma unroll
                for (int bj = 0; bj < 2; ++bj) {
                    const f32x4 a0 = *(const PG8_GAS f32x4*)(xin + col0 + bj * HALF), a1 = *(const PG8_GAS f32x4*)(xin + col0 + bj * HALF + 4);
                    const f32x4 v0 = a0 + acc[ai][bj][m][0] * sc, v1 = a1 + acc[ai][bj][m][1] * sc;
                    *(PG8_GAS f32x4*)(op + bj * HALF) = v0; *(PG8_GAS f32x4*)(op + bj * HALF + 4) = v1;
                    ss += (v0[0] * v0[0] + v0[1] * v0[1]) + (v0[2] * v0[2] + v0[3] * v0[3]);
                    ss += (v1[0] * v1[0] + v1[1] * v1[1]) + (v1[2] * v1[2] + v1[3] * v1[3]);
                    if (MODE == 0) { const f32x4 g0 = v0 * gv[bj][0], g1 = v1 * gv[bj][1];
                        u32x4 w; w.x = cvt_pk_bf16(g0[0], g0[1]); w.y = cvt_pk_bf16(g0[2], g0[3]); w.z = cvt_pk_bf16(g1[0], g1[1]); w.w = cvt_pk_bf16(g1[2], g1[3]);
                        *(PG8_GAS u32x4*)(XG + (size_t)row * 1024 + col0 + bj * HALF) = w; }
                }
                ss += __shfl_xor(ss, 16); ss += __shfl_xor(ss, 32);
                if (fq == 0) ssq[(size_t)row * 16 + u.pn * 4 + wc] = ss;
            }
    }
};
struct SplitOrder {
    int G, c;
    __device__ bool next(int i, Unit& u) const { const int L = i * G + c; if (L >= 128) return false; const int tile = L >> 3, kc = L & 7; u.pm = 64 + (tile >> 2); u.pn = tile & 3; u.ko = kc * 512; return true; }
    __device__ __forceinline__ void a_ready(const Unit&) const {}
    __device__ __forceinline__ void done(const Unit&) const {}
};
struct EpiPart {
    static constexpr bool PERM = true, AFTER_DRAIN = false;
    float* P;
    __device__ __forceinline__ void operator()(const f32x4 (&acc)[2][2][4][2], const Unit& u, int wr, int wc, int fr, int fq) const {
        const int row0 = (u.pm - 64) * BM + wr * 64 + fr, col0 = u.pn * BM + wc * 32 + 8 * fq;
        float* base = P + (size_t)(u.ko >> 9) * (1024 * 1024);
#pragma unroll
        for (int ai = 0; ai < 2; ++ai)
#pragma unroll
            for (int m = 0; m < 4; ++m) { float* rowp = base + (size_t)(row0 + ai * HALF + m * 16) * 1024 + col0;
#pragma unroll
                for (int bj = 0; bj < 2; ++bj) { *(PG8_GAS f32x4*)(rowp + bj * HALF) = acc[ai][bj][m][0]; *(PG8_GAS f32x4*)(rowp + bj * HALF + 4) = acc[ai][bj][m][1]; } }
    }
};
struct OutOrder {
    int G, c; unsigned* cnt;
    __device__ bool next(int i, Unit& u) const { const int t = i * G + c; if (t >= 272) return false; if (t < 16) { u.pm = 64 + (t >> 2); u.pn = t & 3; } else { const int p = t - 16; u.pm = p >> 2; u.pn = p & 3; } u.ko = 0; return true; }
    __device__ __forceinline__ void a_ready(const Unit&) const {}
    __device__ __forceinline__ void done(const Unit& u) const {
        if (u.pm >= 64) {
            asm volatile("s_waitcnt vmcnt(0)" ::: "memory");
            __builtin_amdgcn_fence(__ATOMIC_RELEASE, "agent");
            if ((threadIdx.x & 63) == 0) __hip_atomic_fetch_add(cnt, 1u, __ATOMIC_RELAXED, __HIP_MEMORY_SCOPE_AGENT);
        }
    }
};
struct SampleFF1Order {
    int G, c; const unsigned* cnt; unsigned need;
    __device__ bool next(int i, Unit& u) const { const int t = c - 16; if (i != 0 || t < 0 || t >= 64) return false; u.pm = 64 + (t >> 4); u.pn = t & 15; u.ko = 0; return true; }
    __device__ __forceinline__ void a_ready(const Unit&) const {
        if (threadIdx.x < 64) {
            unsigned polls = 0;
            while ((unsigned)__builtin_amdgcn_readfirstlane(__hip_atomic_load(cnt, __ATOMIC_RELAXED, __HIP_MEMORY_SCOPE_AGENT)) < need) { if (++polls > (1u << 22)) break; __builtin_amdgcn_s_sleep(2); }
            __builtin_amdgcn_fence(__ATOMIC_ACQUIRE, "agent");
            asm volatile("s_waitcnt vmcnt(0)" ::: "memory");
        }
        asm volatile("" ::: "memory"); __builtin_amdgcn_s_barrier(); asm volatile("" ::: "memory");
    }
    __device__ __forceinline__ void done(const Unit&) const {}
};
struct EpiResNorm {
    static constexpr bool PERM = true, AFTER_DRAIN = true;
    float* out; const float* ss_in; const float* gam; float* xbuf; unsigned* cnt;
    __device__ __forceinline__ void fused(f32x4 (&acc)[2][2][4][2], const Unit& u, int wr, int wc, int fr, int fq, PG8_LAS unsigned char* lds, int wid, int lane) const {
        PG8_LAS float* P = (PG8_LAS float*)lds;
        PG8_LAS float* S = (PG8_LAS float*)(lds + 4096);
        const int row0 = u.pm * BM + wr * 64 + fr, col0 = u.pn * BM + wc * 32 + 8 * fq;
#pragma unroll
        for (int ai = 0; ai < 2; ++ai)
#pragma unroll
            for (int m = 0; m < 4; ++m) {
                const int row = row0 + ai * HALF + m * 16;
                const PG8_GAS f32x4* sp = (const PG8_GAS f32x4*)(ss_in + (size_t)row * 16);
                const f32x4 s0 = sp[0], s1 = sp[1], s2 = sp[2], s3 = sp[3];
                const f32x4 st = (s0 + s1) + (s2 + s3);
                const float sc = 1.0f / (((st[0] + st[1]) + (st[2] + st[3])) * (1.0f / 1024.0f) + 1e-6f);
                const float* xin = out + (size_t)row * 1024 + col0;
                float ss = 0.f;
#pragma unroll
                for (int bj = 0; bj < 2; ++bj) {
                    const f32x4 a0 = *(const PG8_GAS f32x4*)(xin + bj * HALF), a1 = *(const PG8_GAS f32x4*)(xin + bj * HALF + 4);
                    const f32x4 v0 = a0 + acc[ai][bj][m][0] * sc, v1 = a1 + acc[ai][bj][m][1] * sc;
                    acc[ai][bj][m][0] = v0; acc[ai][bj][m][1] = v1;
                    ss += (v0[0] * v0[0] + v0[1] * v0[1]) + (v0[2] * v0[2] + v0[3] * v0[3]);
                    ss += (v1[0] * v1[0] + v1[1] * v1[1]) + (v1[2] * v1[2] + v1[3] * v1[3]);
                }
                ss += __shfl_xor(ss, 16); ss += __shfl_xor(ss, 32);
                if (fq == 0) P[(ai * HALF + wr * 64 + m * 16 + fr) * 4 + wc] = ss;
            }
        asm volatile("s_waitcnt lgkmcnt(0)" ::: "memory"); __builtin_amdgcn_s_barrier(); asm volatile("" ::: "memory");
        const int rowl = wid * 32 + (lane & 31);
        if (lane < 32) {
            const float t = (P[rowl * 4 + 0] + P[rowl * 4 + 1]) + (P[rowl * 4 + 2] + P[rowl * 4 + 3]);
            __hip_atomic_store(xbuf + ((size_t)(u.pm * BM + rowl) * 4 + u.pn), t, __ATOMIC_RELAXED, __HIP_MEMORY_SCOPE_AGENT);
        }
        asm volatile("s_waitcnt vmcnt(0)" ::: "memory");
        if (lane == 0) __hip_atomic_fetch_add(cnt + 64 * u.pm, 1u, __ATOMIC_RELAXED, __HIP_MEMORY_SCOPE_AGENT);
        if (wid == 0) {
            unsigned polls = 0;
            while ((unsigned)__builtin_amdgcn_readfirstlane(__hip_atomic_load(cnt + 64 * u.pm, __ATOMIC_RELAXED, __HIP_MEMORY_SCOPE_AGENT)) < 32u) { if (++polls > (1u << 22)) break; __builtin_amdgcn_s_sleep(2); }
            __builtin_amdgcn_fence(__ATOMIC_ACQUIRE, "agent");
        }
        asm volatile("s_waitcnt vmcnt(0) lgkmcnt(0)" ::: "memory"); __builtin_amdgcn_s_barrier(); asm volatile("" ::: "memory");
        if (lane < 32) {
            const float* slot = xbuf + (size_t)(u.pm * BM + rowl) * 4; float tot = 0.f;
#pragma unroll
            for (int t = 0; t < 4; ++t) tot += __hip_atomic_load(slot + t, __ATOMIC_RELAXED, __HIP_MEMORY_SCOPE_AGENT);
            S[rowl] = 1.0f / sqrtf(tot * (1.0f / 1024.0f) + 1e-6f);
        }
        asm volatile("s_waitcnt lgkmcnt(0)" ::: "memory"); __builtin_amdgcn_s_barrier(); asm volatile("" ::: "memory");
        f32x4 gv[2][2];
#pragma unroll
        for (int bj = 0; bj < 2; ++bj)
#pragma unroll
            for (int n = 0; n < 2; ++n) gv[bj][n] = *(const PG8_GAS f32x4*)(gam + col0 + bj * HALF + 4 * n);
#pragma unroll
        for (int ai = 0; ai < 2; ++ai)
#pragma unroll
            for (int m = 0; m < 4; ++m) {
                const int rl = ai * HALF + wr * 64 + m * 16 + fr; const float rs = S[rl];
                float* op = out + (size_t)(u.pm * BM + rl) * 1024 + col0;
#pragma unroll
                for (int bj = 0; bj < 2; ++bj) { *(PG8_GAS f32x4*)(op + bj * HALF) = acc[ai][bj][m][0] * rs * gv[bj][0]; *(PG8_GAS f32x4*)(op + bj * HALF + 4) = acc[ai][bj][m][1] * rs * gv[bj][1]; }
            }
    }
};
template <class Epi, class Sched, bool ALIGN_EPI = false, bool SP2 = false>
__device__ __forceinline__ void gemm_phase(PG8_LAS unsigned char* lds, const Gemm g, const Sched& S, const Epi& E) {
    const int tid = threadIdx.x, wid = __builtin_amdgcn_readfirstlane(tid >> 6), lane = tid & 63, wr = wid >> 2, wc = wid & 3, fr = lane & 15, fq = lane >> 4;
    const int K = g.K, nt = K / BK, LD = g.ld ? g.ld : g.K;
    unsigned voffA[2], voffB[2];
#pragma unroll
    for (int i = 0; i < 2; ++i) { int R, C; stage_rc(tid * 16 + i * 8192, R, C); const int Rb = Epi::PERM ? ((R & ~31) + perm32(R & 31)) : R;
        voffA[i] = (unsigned)(R * LD + C) * 2u; voffB[i] = (unsigned)(Rb * LD + C) * 2u; }
    const size_t kstep = (size_t)(BK * 2);
    const size_t hstep = (size_t)HALF * LD * 2;
    const size_t tstep = 2 * hstep;
    const unsigned ldsw = (unsigned)wid * 1024u;
    const int aoff = lds_byte(wr * 64 + fr, fq * 8), boff = lds_byte(wc * 32 + fr, fq * 8);
#define PG8_SA(b, h) (((b) * 2 + (h)) * HTB)
#define PG8_SB(b, h) ((4 + (b) * 2 + (h)) * HTB)
#define PG8_STAGE(bufoff, gbase, voff) do { _Pragma("unroll") for (int _i = 0; _i < 2; ++_i) \
        __builtin_amdgcn_global_load_lds((const unsigned*)((const char*)(gbase) + (voff)[_i]), (PG8_LAS unsigned*)(lds + (bufoff) + ldsw + _i * 8192), 16, 0, 0); } while (0)
#define PG8_LDA(dst, b, h) do { _Pragma("unroll") for (int m = 0; m < 4; ++m) _Pragma("unroll") for (int k = 0; k < 2; ++k) dst[m][k] = *(const PG8_LAS bf16x8*)(lds + PG8_SA(b, h) + aoff + m * 2048 + k * 1024); } while (0)
#define PG8_LDB(dst, b, h) do { _Pragma("unroll") for (int n = 0; n < 2; ++n) _Pragma("unroll") for (int k = 0; k < 2; ++k) dst[n][k] = *(const PG8_LAS bf16x8*)(lds + PG8_SB(b, h) + boff + n * 2048 + k * 1024); } while (0)
#define PG8_MMA(ai, bj, At, Bt) do { __builtin_amdgcn_s_setprio(1); _Pragma("unroll") for (int m = 0; m < 4; ++m) _Pragma("unroll") for (int n = 0; n < 2; ++n) _Pragma("unroll") for (int k = 0; k < 2; ++k) \
        acc[ai][bj][m][n] = __builtin_amdgcn_mfma_f32_16x16x32_bf16(Bt[n][k], At[m][k], acc[ai][bj][m][n], 0, 0, 0); __builtin_amdgcn_s_setprio(0); } while (0)
#define PG8_WAIT_V(n) asm volatile("s_waitcnt vmcnt(" #n ")" ::: "memory")
#define PG8_WAIT_L(n) asm volatile("s_waitcnt lgkmcnt(" #n ")" ::: "memory")
#define PG8_BAR __builtin_amdgcn_s_barrier()
#define PG8_SCHED __builtin_amdgcn_sched_barrier(0)
    Unit cur, nxt; int ui = 0;
    if (!S.next(0, cur)) return;
    f32x4 acc[2][2][4][2];
#pragma unroll
    for (int a = 0; a < 2; ++a)
#pragma unroll
        for (int b = 0; b < 2; ++b)
#pragma unroll
            for (int m = 0; m < 4; ++m)
#pragma unroll
                for (int n = 0; n < 2; ++n) acc[a][b][m][n] = (f32x4){0.f, 0.f, 0.f, 0.f};
    bf16x8 At[4][2], B0[2][2], B1[2][2];
    const char* cA = (const char*)g.A + (size_t)cur.pm * tstep + (size_t)cur.ko * 2; const char* cB = (const char*)g.Bt + (size_t)cur.pn * tstep + (size_t)cur.ko * 2;
    S.a_ready(cur);
    if constexpr (SP2) {
        PG8_STAGE(PG8_SB(0, 0), cB, voffB); PG8_STAGE(PG8_SB(0, 1), cB + hstep, voffB); PG8_STAGE(PG8_SA(0, 0), cA, voffA); PG8_STAGE(PG8_SA(0, 1), cA + hstep, voffA);
        if (wr == 1) PG8_BAR;
        PG8_WAIT_V(2); PG8_BAR;
        PG8_STAGE(PG8_SB(1, 0), cB + kstep, voffB); PG8_STAGE(PG8_SA(1, 0), cA + kstep, voffA); PG8_STAGE(PG8_SB(1, 1), cB + hstep + kstep, voffB);
        PG8_WAIT_V(6); PG8_BAR;
    } else {
        PG8_STAGE(PG8_SB(0, 0), cB, voffB); PG8_STAGE(PG8_SA(0, 0), cA, voffA); PG8_STAGE(PG8_SB(0, 1), cB + hstep, voffB); PG8_STAGE(PG8_SA(0, 1), cA + hstep, voffA);
        if (wr == 1) PG8_BAR;
        PG8_WAIT_V(4); PG8_BAR;
        PG8_STAGE(PG8_SB(1, 0), cB + kstep, voffB); PG8_STAGE(PG8_SA(1, 0), cA + kstep, voffA); PG8_STAGE(PG8_SB(1, 1), cB + hstep + kstep, voffB);
        PG8_WAIT_V(6); PG8_BAR;
    }
    for (;;) {
        const bool has_next = S.next(ui + 1, nxt);
        const char* nA = has_next ? (const char*)g.A + (size_t)nxt.pm * tstep + (size_t)nxt.ko * 2 : cA; const char* nB = has_next ? (const char*)g.Bt + (size_t)nxt.pn * tstep + (size_t)nxt.ko * 2 : cB;
        for (int t = 0; t < nt; t += 2) {
            const bool last = (t == nt - 2);
            const char* a1 = cA + (size_t)(t + 1) * kstep;
            const char* a2 = last ? nA : cA + (size_t)(t + 2) * kstep; const char* b2 = last ? nB : cB + (size_t)(t + 2) * kstep;
            const char* a3 = a2 + kstep; const char* b3 = b2 + kstep;
            if (last && has_next) S.a_ready(nxt);
            if constexpr (SP2) {
            PG8_LDB(B0, 0, 0); PG8_LDB(B1, 0, 1); PG8_SCHED; PG8_LDA(At, 0, 0); PG8_STAGE(PG8_SA(1, 1), a1 + hstep, voffA);
            PG8_WAIT_V(8); PG8_WAIT_L(0); PG8_BAR; PG8_MMA(0, 0, At, B0); PG8_MMA(0, 1, At, B1); PG8_BAR; PG8_SCHED;
            PG8_LDA(At, 0, 1); PG8_STAGE(PG8_SB(0, 0), b2, voffB); PG8_STAGE(PG8_SB(0, 1), b2 + hstep, voffB); PG8_STAGE(PG8_SA(0, 0), a2, voffA);
            PG8_WAIT_V(8); PG8_WAIT_L(0); PG8_BAR; PG8_MMA(1, 0, At, B0); PG8_MMA(1, 1, At, B1); PG8_BAR; PG8_SCHED;
            PG8_LDB(B0, 1, 0); PG8_LDB(B1, 1, 1); PG8_SCHED; PG8_LDA(At, 1, 0); PG8_STAGE(PG8_SA(0, 1), a2 + hstep, voffA);
            PG8_WAIT_V(8); PG8_WAIT_L(0); PG8_BAR; PG8_MMA(0, 0, At, B0); PG8_MMA(0, 1, At, B1); PG8_BAR; PG8_SCHED;
            PG8_LDA(At, 1, 1); PG8_STAGE(PG8_SB(1, 0), b3, voffB); PG8_STAGE(PG8_SB(1, 1), b3 + hstep, voffB); PG8_STAGE(PG8_SA(1, 0), a3, voffA);
            PG8_WAIT_V(8); PG8_WAIT_L(0); PG8_BAR; PG8_MMA(1, 0, At, B0); PG8_MMA(1, 1, At, B1); PG8_BAR; PG8_SCHED;
            } else {
            PG8_LDB(B0, 0, 0); PG8_SCHED; PG8_LDA(At, 0, 0); PG8_STAGE(PG8_SA(1, 1), a1 + hstep, voffA);
            PG8_WAIT_L(8); PG8_BAR; PG8_WAIT_L(0); PG8_MMA(0, 0, At, B0); PG8_BAR; PG8_SCHED;
            PG8_LDB(B1, 0, 1); PG8_STAGE(PG8_SB(0, 0), b2, voffB);
            PG8_BAR; PG8_WAIT_L(0); PG8_MMA(0, 1, At, B1); PG8_BAR;
            PG8_LDA(At, 0, 1); PG8_STAGE(PG8_SA(0, 0), a2, voffA);
            PG8_BAR; PG8_WAIT_L(0); PG8_MMA(1, 0, At, B0); PG8_BAR; PG8_SCHED;
            PG8_STAGE(PG8_SB(0, 1), b2 + hstep, voffB);
            PG8_WAIT_V(6); PG8_BAR; PG8_MMA(1, 1, At, B1); PG8_BAR;
            PG8_LDB(B0, 1, 0); PG8_SCHED; PG8_LDA(At, 1, 0); PG8_STAGE(PG8_SA(0, 1), a2 + hstep, voffA);
            PG8_WAIT_L(8); PG8_BAR; PG8_WAIT_L(0); PG8_MMA(0, 0, At, B0); PG8_BAR; PG8_SCHED;
            PG8_LDB(B1, 1, 1); PG8_STAGE(PG8_SB(1, 0), b3, voffB);
            PG8_BAR; PG8_WAIT_L(0); PG8_MMA(0, 1, At, B1); PG8_BAR;
            PG8_LDA(At, 1, 1); PG8_STAGE(PG8_SA(1, 0), a3, voffA);
            PG8_BAR; PG8_WAIT_L(0); PG8_MMA(1, 0, At, B0); PG8_BAR; PG8_SCHED;
            PG8_STAGE(PG8_SB(1, 1), b3 + hstep, voffB);
            PG8_WAIT_V(6); PG8_BAR; PG8_MMA(1, 1, At, B1); PG8_BAR;
            }
        }
        if constexpr (ALIGN_EPI) { if (wr == 0) PG8_BAR; }
        if constexpr (!Epi::AFTER_DRAIN) { E(acc, cur, wr, wc, fr, fq); S.done(cur); }
        if (!has_next) break;
#pragma unroll
        for (int a = 0; a < 2; ++a)
#pragma unroll
            for (int b = 0; b < 2; ++b)
#pragma unroll
                for (int m = 0; m < 4; ++m)
#pragma unroll
                    for (int n = 0; n < 2; ++n) acc[a][b][m][n] = (f32x4){0.f, 0.f, 0.f, 0.f};
        cur = nxt; cA = nA; cB = nB; ++ui;
        if constexpr (ALIGN_EPI) { if (wr == 1) PG8_BAR; }
    }
    PG8_WAIT_V(0);
    if constexpr (!ALIGN_EPI) { if (wr == 0) PG8_BAR; }
    PG8_BAR;
    if constexpr (Epi::AFTER_DRAIN) { E.fused(acc, cur, wr, wc, fr, fq, lds, wid, lane); S.done(cur); }
#undef PG8_SA
#undef PG8_SB
#undef PG8_STAGE
#undef PG8_LDA
#undef PG8_LDB
#undef PG8_MMA
#undef PG8_WAIT_V
#undef PG8_WAIT_L
#undef PG8_BAR
#undef PG8_SCHED
}
}
constexpr int DM = 1024, TP = 16384, TS = 1024, TT = TP + TS, SEQ = 2048, DSEQ = 8, DBATCH = 128;
constexpr int IC = 3328, RWC = 1792, PRW = 1536, FFD = 4096;
constexpr size_t MiB = 1u << 20;
constexpr size_t WS_WIN = 0, WS_WOUT = 7 * MiB, WS_WFF1 = 9 * MiB, WS_WFF2 = 17 * MiB, WS_W2T = 25 * MiB, WS_A2T = WS_W2T + 65536, WS_G2T = WS_A2T + 65536;
constexpr size_t WS_SS1 = 26 * MiB, WS_SS2 = 28 * MiB, WS_XN = 30 * MiB, WS_XG = 64 * MiB, WS_PROJ = 98 * MiB, WS_H = 98 * MiB, WS_END = 234 * MiB;
constexpr size_t O_Y = 0, O_CONVP = (size_t)TT * 1024, O_SHIFTP = O_CONVP + 8192, O_WKVP = O_SHIFTP + 14336, O_CONVS = O_WKVP + 262144, O_SHIFTS = O_CONVS + 131072, O_WKVS = O_SHIFTS + 229376;
constexpr size_t OS_YRAW = 0, OS_G = (size_t)TT * 512, OS_V = OS_G + (size_t)TT * 256;
constexpr size_t WS_WD = 30 * MiB, WS_KK = 64 * MiB, WS_BB = 81 * MiB, WS_KM = 209 * MiB, WS_RR = 226 * MiB, WS_RK = 27 * MiB + 262144;
constexpr int LDS_BYTES = 147456;
constexpr size_t WS_BAR = 29 * MiB + 524288, BAR_ZERO_BYTES = 131072;
constexpr size_t WS_PART = 30 * MiB;
constexpr size_t WS_XSTAT = 29 * MiB + 131072;
constexpr int LDS_BARST = 131072 + 64;

#define GAS __attribute__((address_space(1)))
#define LAS __attribute__((address_space(3)))
typedef unsigned short bf16;
typedef unsigned u32x4 __attribute__((ext_vector_type(4)));
typedef unsigned u32x2 __attribute__((ext_vector_type(2)));
typedef float f32x4 __attribute__((ext_vector_type(4)));
typedef short bf16x8 __attribute__((ext_vector_type(8)));
#define LDS_WAIT() asm volatile("s_waitcnt lgkmcnt(0)" ::: "memory")

__device__ __forceinline__ unsigned pk2(float lo, float hi) { return pg8::cvt_pk_bf16(lo, hi); }
__device__ __forceinline__ bf16 f2bf_sw(float f) { const unsigned u = __builtin_bit_cast(unsigned, f); return (bf16)((u + 0x7fffu + ((u >> 16) & 1u)) >> 16); }
__device__ __forceinline__ float bflo(unsigned u) { return __builtin_bit_cast(float, u << 16); }
__device__ __forceinline__ float bfhi(unsigned u) { return __builtin_bit_cast(float, u & 0xffff0000u); }
__device__ __forceinline__ u32x4 gld16(const void* p) { return *(const GAS u32x4*)p; }
__device__ __forceinline__ f32x4 gldf4(const float* p) { return *(const GAS f32x4*)p; }
__device__ __forceinline__ void unpack8(const u32x4 u, float (&o)[8]) { o[0] = bflo(u.x); o[1] = bfhi(u.x); o[2] = bflo(u.y); o[3] = bfhi(u.y); o[4] = bflo(u.z); o[5] = bfhi(u.z); o[6] = bflo(u.w); o[7] = bfhi(u.w); }
__device__ __forceinline__ u32x4 pack8(const float (&v)[8]) { u32x4 w; w.x = pk2(v[0], v[1]); w.y = pk2(v[2], v[3]); w.z = pk2(v[4], v[5]); w.w = pk2(v[6], v[7]); return w; }
__device__ __forceinline__ float wave_sum(float v) {
#pragma unroll
    for (int o = 1; o < 64; o <<= 1) v += __shfl_xor(v, o);
    return v;
}
template <int CTRL> __device__ __forceinline__ float dppf(float x) { return __builtin_bit_cast(float, __builtin_amdgcn_update_dpp(0, __builtin_bit_cast(int, x), CTRL, 0xF, 0xF, true)); }
__device__ __forceinline__ float row16_sum(float x) {
    x += dppf<0xB1>(x); x += dppf<0x4E>(x); x += dppf<0x124>(x); x += dppf<0x128>(x); return x;
}
__device__ __forceinline__ float sigmoidf_(float x) { return __builtin_amdgcn_rcpf(1.0f + __expf(-x)); }
__device__ __forceinline__ float tanhf_(float x) { const float e = __expf(2.0f * x); return 1.0f - 2.0f * __builtin_amdgcn_rcpf(e + 1.0f); }

struct Args { const float* in[24]; float* out; unsigned char* ws; int ph_lo, ph_hi, li, pad; };

__device__ __forceinline__ void p0_transpose_item(const float* W, int K, int N, bf16* WT, LAS float* scr, int item, int lane) {
    const int nblk = N / 32, kb = item / nblk, nb = item % nblk, k0 = 64 * kb, n0 = 32 * nb;
#pragma unroll 8
    for (int i = 0; i < 32; ++i) { const int kk = 2 * i + (lane >> 5); scr[kk * 33 + (lane & 31)] = W[(size_t)(k0 + kk) * N + n0 + (lane & 31)]; }
    LDS_WAIT(); asm volatile("" ::: "memory");
    const int c = lane & 7;
#pragma unroll
    for (int j = 0; j < 4; ++j) { const int n = (lane >> 3) + 8 * j; const LAS float* s = scr + (8 * c) * 33 + n;
        u32x4 o; o.x = pk2(s[0 * 33], s[1 * 33]); o.y = pk2(s[2 * 33], s[3 * 33]); o.z = pk2(s[4 * 33], s[5 * 33]); o.w = pk2(s[6 * 33], s[7 * 33]);
        *(GAS u32x4*)(WT + (size_t)(n0 + n) * K + k0 + 8 * c) = o; }
    LDS_WAIT(); asm volatile("" ::: "memory");
}
__device__ __forceinline__ void rms_row_to_bf16(const float* xrow, const float* g, bf16* orow, int lane) {
    const GAS f32x4* xr = (const GAS f32x4*)xrow + lane; const GAS f32x4* gr = (const GAS f32x4*)g + lane;
    f32x4 v[4]; float s2 = 0.f;
#pragma unroll
    for (int j = 0; j < 4; ++j) { v[j] = xr[64 * j]; s2 += (v[j].x * v[j].x + v[j].y * v[j].y) + (v[j].z * v[j].z + v[j].w * v[j].w); }
    const float rstd = 1.0f / sqrtf(wave_sum(s2) * (1.f / DM) + 1e-6f);
    GAS u32x2* o8 = (GAS u32x2*)orow + lane;
#pragma unroll
    for (int j = 0; j < 4; ++j) { const f32x4 gg = gr[64 * j]; u32x2 w; w.x = pk2(v[j].x * rstd * gg.x, v[j].y * rstd * gg.y); w.y = pk2(v[j].z * rstd * gg.z, v[j].w * rstd * gg.w); o8[64 * j] = w; }
}

constexpr int SB_W = 0, SB_B = 2048, SB_K = 4096, SB_KK = 6144, SB_R = 8192, SB_V = 10240, SB_BETA = 12288, SB_BYTES = 49280, STG_OFF = 2 * SB_BYTES, STG_BYTES = 4608;

__device__ __forceinline__ void load_xm8(const bf16* prow, int c, bool first, const float* shift0, const float* mu, float (&o)[8]) {
    float cur[8], prv[8];
    unpack8(gld16(prow + c), cur);
    if (!first) { unpack8(gld16(prow - IC + c), prv); }
    else if (shift0) { const f32x4 a = gldf4(shift0 + c), b = gldf4(shift0 + c + 4); prv[0] = a.x; prv[1] = a.y; prv[2] = a.z; prv[3] = a.w; prv[4] = b.x; prv[5] = b.y; prv[6] = b.z; prv[7] = b.w; }
    else {
#pragma unroll
        for (int i = 0; i < 8; ++i) prv[i] = 0.f;
    }
    const f32x4 m0 = gldf4(mu + c), m1 = gldf4(mu + c + 4);
    const float mm[8] = {m0.x, m0.y, m0.z, m0.w, m1.x, m1.y, m1.z, m1.w};
#pragma unroll
    for (int i = 0; i < 8; ++i) o[i] = cur[i] + (prv[i] - cur[i]) * mm[i];
}

constexpr int PREP_MU = 10752, PREP_SCR = 12544;
__device__ __forceinline__ void prep_cols(int h, int cgp, int (&col)[7]) {
    col[0] = h * 64 + 8 * cgp; col[1] = 512 + h * 64 + 8 * cgp; col[2] = 1024 + h * 64 + 8 * cgp; col[3] = 1536 + 8 * cgp; col[4] = 1600 + 8 * cgp; col[5] = 1664 + 16 * cgp; col[6] = 1664 + 16 * cgp + 8;
}
struct PrepRaw { u32x4 c[7]; u32x4 p[7]; };
__device__ __forceinline__ void prep_load(const Args& a, PrepRaw& R, int lane, int row0, int h) {
    const bool smp = row0 >= TP;
    const int tok = lane >> 3, cgp = lane & 7, row = row0 + tok;
    const int t = smp ? tok : (row & 2047);
    const bf16* prow = (const bf16*)(a.ws + WS_PROJ) + (size_t)row * IC + PRW;
    int col[7]; prep_cols(h, cgp, col);
#pragma unroll
    for (int i = 0; i < 7; ++i) { R.c[i] = gld16(prow + col[i]); R.p[i] = (u32x4){0u, 0u, 0u, 0u}; }
    if (t != 0) {
#pragma unroll
        for (int i = 0; i < 7; ++i) R.p[i] = gld16(prow - IC + col[i]);
    }
}
__device__ __forceinline__ void xm8_raw(const u32x4 cu, const u32x4 pu, int c, bool fs, const float* shift0, const float* mu, float (&o)[8]) {
    float cur[8], prv[8];
    unpack8(cu, cur); unpack8(pu, prv);
    if (fs) { const f32x4 a = gldf4(shift0 + c), b = gldf4(shift0 + c + 4); prv[0] = a.x; prv[1] = a.y; prv[2] = a.z; prv[3] = a.w; prv[4] = b.x; prv[5] = b.y; prv[6] = b.z; prv[7] = b.w; }
    const f32x4 m0 = gldf4(mu + c), m1 = gldf4(mu + c + 4);
    const float mm[8] = {m0.x, m0.y, m0.z, m0.w, m1.x, m1.y, m1.z, m1.w};
#pragma unroll
    for (int i = 0; i < 8; ++i) o[i] = cur[i] + (prv[i] - cur[i]) * mm[i];
}
__device__ __forceinline__ void xm8_pre(const u32x4 cu, const u32x4 pu, int c, bool fs, const float* shift0, const f32x4 m0, const f32x4 m1, float (&o)[8]) {
    float cur[8], prv[8];
    unpack8(cu, cur); unpack8(pu, prv);
    if (fs) { const f32x4 a = gldf4(shift0 + c), b = gldf4(shift0 + c + 4); prv[0] = a.x; prv[1] = a.y; prv[2] = a.z; prv[3] = a.w; prv[4] = b.x; prv[5] = b.y; prv[6] = b.z; prv[7] = b.w; }
    const float mm[8] = {m0.x, m0.y, m0.z, m0.w, m1.x, m1.y, m1.z, m1.w};
#pragma unroll
    for (int i = 0; i < 8; ++i) o[i] = cur[i] + (prv[i] - cur[i]) * mm[i];
}
struct PrepConst { int unused; };
__device__ __forceinline__ void prep_item(const Args& a, const PrepConst& C, const PrepRaw& R, LAS unsigned char* scr, int lane, int row0, int h) {
    const bool smp = row0 >= TP;
    const int b = smp ? ((row0 - TP) >> 3) : (row0 >> 11);
    const int tok = lane >> 3, cgp = lane & 7;
    const int row = row0 + tok;
    const int t = smp ? tok : (row & 2047);
    const bool fs = (t == 0) && smp;
    const float* shift0 = a.in[3] + (size_t)b * RWC;
    int col[7]; prep_cols(h, cgp, col);
    const LAS float* MUs = (const LAS float*)(scr + PREP_MU);
    LAS float* KKs = (LAS float*)scr; LAS float* KRs = KKs + 512; LAS float* Rs = KRs + 512;
    LAS bf16* Lw = (LAS bf16*)(scr + 6144); LAS bf16* La = Lw + 8 * 72; LAS bf16* Lg = La + 8 * 72;
    const size_t go = (size_t)row * 512 + h * 64 + 8 * cgp;
    u32x4 pk_r, pk_v, pk_kk;
    {
        float xr[8], xk[8], xv[8];
        xm8_pre(R.c[0], R.p[0], col[0], fs, shift0, *(const LAS f32x4*)(MUs + (0 * 8 + cgp) * 8), *(const LAS f32x4*)(MUs + (0 * 8 + cgp) * 8 + 4), xr);
        xm8_pre(R.c[1], R.p[1], col[1], fs, shift0, *(const LAS f32x4*)(MUs + (1 * 8 + cgp) * 8), *(const LAS f32x4*)(MUs + (1 * 8 + cgp) * 8 + 4), xk);
        xm8_pre(R.c[2], R.p[2], col[2], fs, shift0, *(const LAS f32x4*)(MUs + (2 * 8 + cgp) * 8), *(const LAS f32x4*)(MUs + (2 * 8 + cgp) * 8 + 4), xv);
        pk_r = pack8(xr); pk_v = pack8(xv);
        *(LAS f32x4*)(Rs + tok * 64 + 8 * cgp) = (f32x4){xr[0], xr[1], xr[2], xr[3]}; *(LAS f32x4*)(Rs + tok * 64 + 8 * cgp + 4) = (f32x4){xr[4], xr[5], xr[6], xr[7]};
        *(LAS f32x4*)(KRs + tok * 64 + 8 * cgp) = (f32x4){xk[0], xk[1], xk[2], xk[3]}; *(LAS f32x4*)(KRs + tok * 64 + 8 * cgp + 4) = (f32x4){xk[4], xk[5], xk[6], xk[7]};
        const f32x4 c0 = gldf4(a.in[14] + h * 64 + 8 * cgp), c1 = gldf4(a.in[14] + h * 64 + 8 * cgp + 4);
        float kkv[8] = {xk[0] * c0.x, xk[1] * c0.y, xk[2] * c0.z, xk[3] * c0.w, xk[4] * c1.x, xk[5] * c1.y, xk[6] * c1.z, xk[7] * c1.w};
        float n2 = 0.f;
#pragma unroll
        for (int i = 0; i < 8; ++i) n2 += kkv[i] * kkv[i];
        n2 += __shfl_xor(n2, 1); n2 += __shfl_xor(n2, 2); n2 += __shfl_xor(n2, 4);
        const float inv = __builtin_amdgcn_rsqf(fmaxf(n2, 1e-24f));
#pragma unroll
        for (int i = 0; i < 8; ++i) kkv[i] *= inv;
        pk_kk = pack8(kkv);
        *(LAS f32x4*)(KKs + tok * 64 + 8 * cgp) = (f32x4){kkv[0], kkv[1], kkv[2], kkv[3]}; *(LAS f32x4*)(KKs + tok * 64 + 8 * cgp + 4) = (f32x4){kkv[4], kkv[5], kkv[6], kkv[7]};
    }
    {
        float xw[8], xa[8], xg[8];
        xm8_pre(R.c[3], R.p[3], col[3], fs, shift0, *(const LAS f32x4*)(MUs + (3 * 8 + cgp) * 8), *(const LAS f32x4*)(MUs + (3 * 8 + cgp) * 8 + 4), xw);
#pragma unroll
        for (int i = 0; i < 8; ++i) xw[i] = tanhf_(xw[i]);
        *(LAS u32x4*)(Lw + tok * 72 + 8 * cgp) = pack8(xw);
        xm8_pre(R.c[4], R.p[4], col[4], fs, shift0, *(const LAS f32x4*)(MUs + (4 * 8 + cgp) * 8), *(const LAS f32x4*)(MUs + (4 * 8 + cgp) * 8 + 4), xa);
        *(LAS u32x4*)(La + tok * 72 + 8 * cgp) = pack8(xa);
        xm8_pre(R.c[5], R.p[5], col[5], fs, shift0, *(const LAS f32x4*)(MUs + (5 * 8 + cgp) * 8), *(const LAS f32x4*)(MUs + (5 * 8 + cgp) * 8 + 4), xg);
#pragma unroll
        for (int i = 0; i < 8; ++i) xg[i] = sigmoidf_(xg[i]);
        *(LAS u32x4*)(Lg + tok * 136 + 16 * cgp) = pack8(xg);
        xm8_pre(R.c[6], R.p[6], col[6], fs, shift0, *(const LAS f32x4*)(MUs + (6 * 8 + cgp) * 8), *(const LAS f32x4*)(MUs + (6 * 8 + cgp) * 8 + 4), xg);
#pragma unroll
        for (int i = 0; i < 8; ++i) xg[i] = sigmoidf_(xg[i]);
        *(LAS u32x4*)(Lg + tok * 136 + 16 * cgp + 8) = pack8(xg);
    }
    LDS_WAIT();
    const int fr = lane & 15, fq = lane >> 4, arow = fr & 7;
    const bf16* W2T = (const bf16*)(a.ws + WS_W2T); const bf16* A2T = (const bf16*)(a.ws + WS_A2T); const bf16* G2T = (const bf16*)(a.ws + WS_G2T);
    const bf16x8 Aw0 = *(const LAS bf16x8*)(Lw + arow * 72 + 8 * fq), Aw1 = *(const LAS bf16x8*)(Lw + arow * 72 + 32 + 8 * fq);
    const bf16x8 Aa0 = *(const LAS bf16x8*)(La + arow * 72 + 8 * fq), Aa1 = *(const LAS bf16x8*)(La + arow * 72 + 32 + 8 * fq);
    f32x4 accw[4], acca[4];
#pragma unroll
    for (int nt = 0; nt < 4; ++nt) {
        const size_t bo = (size_t)(h * 64 + 16 * nt + fr) * 64 + 8 * fq;
        const bf16x8 bw0 = __builtin_bit_cast(bf16x8, gld16(W2T + bo)), bw1 = __builtin_bit_cast(bf16x8, gld16(W2T + bo + 32));
        const bf16x8 ba0 = __builtin_bit_cast(bf16x8, gld16(A2T + bo)), ba1 = __builtin_bit_cast(bf16x8, gld16(A2T + bo + 32));
        f32x4 z = {0.f, 0.f, 0.f, 0.f};
        accw[nt] = __builtin_amdgcn_mfma_f32_16x16x32_bf16(Aw0, bw0, z, 0, 0, 0); accw[nt] = __builtin_amdgcn_mfma_f32_16x16x32_bf16(Aw1, bw1, accw[nt], 0, 0, 0);
        acca[nt] = __builtin_amdgcn_mfma_f32_16x16x32_bf16(Aa0, ba0, z, 0, 0, 0); acca[nt] = __builtin_amdgcn_mfma_f32_16x16x32_bf16(Aa1, ba1, acca[nt], 0, 0, 0);
    }
    const bool lowh = fq < 2;
    const int ntb = lowh ? 0 : 2, tokb = 4 * (fq & 1);
    f32x4 Wsel[2], Asel[2];
    Wsel[0] = lowh ? accw[0] : accw[2]; Wsel[1] = lowh ? accw[1] : accw[3];
    Asel[0] = lowh ? acca[0] : acca[2]; Asel[1] = lowh ? acca[1] : acca[3];
    float rkp[4] = {0.f, 0.f, 0.f, 0.f};
    float* WD = (float*)(a.ws + WS_WD); bf16* BBp = (bf16*)(a.ws + WS_BB); bf16* KMp = (bf16*)(a.ws + WS_KM);
#pragma unroll
    for (int u = 0; u < 2; ++u) {
        const int c = 16 * (ntb + u) + fr, hc = h * 64 + c;
        const float w0c = a.in[9][hc], a0c = a.in[11][hc], kac = a.in[15][hc], rkc = a.in[16][hc];
#pragma unroll
        for (int e = 0; e < 4; ++e) {
            const int o = (tokb + e) * 64 + c;
            const float sg = sigmoidf_(Wsel[u][e] + w0c);
            const float decay = __expf(-0.6065306597126334f * sg);
            const float av = sigmoidf_(Asel[u][e] + a0c);
            const float kkv = KKs[o], kr = KRs[o], rv = Rs[o];
            const float kmod = kr * (1.0f + (av - 1.0f) * kac);
            Rs[o] = decay; KKs[o] = kkv * av; KRs[o] = kmod;
            rkp[e] += rv * kmod * rkc;
        }
    }
    float* RK = (float*)(a.ws + WS_RK);
#pragma unroll
    for (int e = 0; e < 4; ++e) { rkp[e] = row16_sum(rkp[e]); rkp[e] += __shfl_xor(rkp[e], 32); }
    bf16x8 Ag[4];
#pragma unroll
    for (int ks = 0; ks < 4; ++ks) Ag[ks] = *(const LAS bf16x8*)(Lg + arow * 136 + 32 * ks + 8 * fq);
    bf16* Gb = (bf16*)(a.out + OS_G);
    LDS_WAIT();
    LAS float* Gs = (LAS float*)Lw;
    for (int nt = 0; nt < 4; ++nt) {
        const size_t bo = (size_t)(h * 64 + 16 * nt + fr) * 128 + 8 * fq;
        f32x4 acc = {0.f, 0.f, 0.f, 0.f};
#pragma unroll
        for (int ks = 0; ks < 4; ++ks) acc = __builtin_amdgcn_mfma_f32_16x16x32_bf16(Ag[ks], __builtin_bit_cast(bf16x8, gld16(G2T + bo + 32 * ks)), acc, 0, 0, 0);
        if (lowh) {
#pragma unroll
            for (int e = 0; e < 4; ++e) Gs[(4 * fq + e) * 64 + 16 * nt + fr] = acc[e];
        }
    }
    LDS_WAIT();
    {
        const LAS float* pg = Gs + tok * 64 + 8 * cgp; const f32x4 g0 = *(const LAS f32x4*)pg, g1 = *(const LAS f32x4*)(pg + 4);
        const float gv[8] = {g0.x, g0.y, g0.z, g0.w, g1.x, g1.y, g1.z, g1.w};
        const LAS float* ps = Rs + tok * 64 + 8 * cgp; const f32x4 d0 = *(const LAS f32x4*)ps, d1 = *(const LAS f32x4*)(ps + 4);
        const LAS float* pb = KKs + tok * 64 + 8 * cgp; const f32x4 b0 = *(const LAS f32x4*)pb, b1 = *(const LAS f32x4*)(pb + 4);
        const float bv[8] = {b0.x, b0.y, b0.z, b0.w, b1.x, b1.y, b1.z, b1.w};
        const LAS float* pk = KRs + tok * 64 + 8 * cgp; const f32x4 k0 = *(const LAS f32x4*)pk, k1 = *(const LAS f32x4*)(pk + 4);
        const float kv[8] = {k0.x, k0.y, k0.z, k0.w, k1.x, k1.y, k1.z, k1.w};
        *(GAS u32x4*)((bf16*)(a.ws + WS_RR) + go) = pk_r;
        *(GAS u32x4*)((bf16*)(a.out + OS_V) + go) = pk_v;
        *(GAS u32x4*)((bf16*)(a.ws + WS_KK) + go) = pk_kk;
        *(GAS f32x4*)(WD + go) = d0; *(GAS f32x4*)(WD + go + 4) = d1;
        *(GAS u32x4*)(BBp + go) = pack8(bv);
        *(GAS u32x4*)(KMp + go) = pack8(kv);
        *(GAS u32x4*)(Gb + go) = pack8(gv);
        if (fr == 0 && lowh) {
#pragma unroll
            for (int e = 0; e < 4; ++e) RK[(size_t)(row0 + tokb + e) * 8 + h] = rkp[e];
        }
    }
    LDS_WAIT();
}

struct LdRaw { f32x4 w0, w1; u32x4 kk, b, k, r, v, kkn; };
__device__ __forceinline__ void loader_load(const Args& a, LdRaw& R, int pw, int lane, bool is_sample, int chain, int t0) {
    const int b = chain >> 3, h = chain & 7, tok = lane >> 3, cgp = lane & 7;
    const int row = (is_sample ? TP + b * DSEQ : b * SEQ + t0 + 8 * pw) + tok;
    const size_t go = (size_t)row * 512 + h * 64 + 8 * cgp;
    R.w0 = gldf4((const float*)(a.ws + WS_WD) + go); R.w1 = gldf4((const float*)(a.ws + WS_WD) + go + 4);
    R.kk = gld16((const bf16*)(a.ws + WS_KK) + go); R.b = gld16((const bf16*)(a.ws + WS_BB) + go); R.k = gld16((const bf16*)(a.ws + WS_KM) + go);
    R.r = gld16((const bf16*)(a.ws + WS_RR) + go); R.v = gld16((const bf16*)(a.out + OS_V) + go);
    R.kkn = gld16((const bf16*)(a.ws + WS_KK) + go + 512);
}
__device__ __forceinline__ void st8(LAS float* p, const u32x4 u) {
    float f[8]; unpack8(u, f);
    *(LAS f32x4*)p = (f32x4){f[0], f[1], f[2], f[3]}; *(LAS f32x4*)(p + 4) = (f32x4){f[4], f[5], f[6], f[7]};
}
__device__ __forceinline__ void loader_store(const LdRaw& R, LAS unsigned char* lds, int buf, int pw, int lane) {
    LAS float* B = (LAS float*)(lds + buf * SB_BYTES);
    const int o = (8 * pw + (lane >> 3)) * 64 + 8 * (lane & 7);
    *(LAS f32x4*)(B + SB_W + o) = R.w0; *(LAS f32x4*)(B + SB_W + o + 4) = R.w1;
    st8(B + SB_KK + o, R.kk); st8(B + SB_B + o, R.b); st8(B + SB_K + o, R.k); st8(B + SB_R + o, R.r); st8(B + SB_V + o, R.v);
    float bb[8], kn[8]; unpack8(R.b, bb); unpack8(R.kkn, kn);
    float part = 0.f;
#pragma unroll
    for (int i = 0; i < 8; ++i) part += bb[i] * kn[i];
    part += __shfl_xor(part, 1); part += __shfl_xor(part, 2); part += __shfl_xor(part, 4);
    if ((lane & 7) == 0) B[SB_BETA + 8 * pw + (lane >> 3)] = part;
}

typedef float f32x2 __attribute__((ext_vector_type(2)));
struct StepOps { f32x4 kk, w, b, k, r; float v; };
__device__ __forceinline__ void ld_step(StepOps& o, const LAS float* B, int off, int voff) {
    o.kk = *(const LAS f32x4*)(B + SB_KK + off); o.w = *(const LAS f32x4*)(B + SB_W + off); o.b = *(const LAS f32x4*)(B + SB_B + off);
    o.k = *(const LAS f32x4*)(B + SB_K + off); o.r = *(const LAS f32x4*)(B + SB_R + off); o.v = B[SB_V + voff];
}
__device__ __forceinline__ float wkv_step2(f32x2& Sa, f32x2& Sb, const f32x4 kk, const f32x4 w, const f32x4 b, const f32x4 k, const f32x4 r, const float vv) {
    f32x2 t = Sa * (f32x2){kk.x, kk.y}; t = Sb * (f32x2){kk.z, kk.w} + t;
    const float p = row16_sum(t.x + t.y);
    const float nu = -p;
    Sa = Sa * (f32x2){w.x, w.y} + (f32x2){b.x, b.y} * nu + (f32x2){k.x, k.y} * vv;
    Sb = Sb * (f32x2){w.z, w.w} + (f32x2){b.z, b.w} * nu + (f32x2){k.z, k.w} * vv;
    f32x2 u = Sa * (f32x2){r.x, r.y}; u = Sb * (f32x2){r.z, r.w} + u;
    return row16_sum(u.x + u.y);
}
__device__ __forceinline__ float wkv_step(f32x4& S, const f32x4 kk, const f32x4 w, const f32x4 b, const f32x4 k, const f32x4 r, const float vv) {
    f32x2 Sa = {S.x, S.y}, Sb = {S.z, S.w};
    const float y = wkv_step2(Sa, Sb, kk, w, b, k, r, vv);
    S = (f32x4){Sa.x, Sa.y, Sb.x, Sb.y};
    return y;
}

__device__ __forceinline__ void p2_scan(const Args& a, LAS unsigned char* lds, int G, int vcu, int wave, int lane) {
    const int nPI = (vcu < 256) ? (256 - vcu + G - 1) / G : 0;
    const int nSG = nPI;
    const int NT = nPI * 64 + nSG;
    const bool scanw = wave < 4;
    const int sw = wave & 3;
    const int jj = lane & 15, lr = 4 * sw + (lane >> 4);
    float* Yraw = a.out + OS_YRAW;
    f32x4 S = {0.f, 0.f, 0.f, 0.f};
#define TASK_DECODE(j, is_sample, item, chunk) const bool is_sample = (j) >= nPI * 64; const int item = is_sample ? vcu + ((j) - nPI * 64) * G : vcu + ((j) >> 6) * G; const int chunk = (j) & 63;
    LdRaw R;
    R.w0 = R.w1 = (f32x4){0.f, 0.f, 0.f, 0.f}; R.kk = R.b = R.k = R.r = R.v = R.kkn = (u32x4){0u, 0u, 0u, 0u};
    if (!scanw && NT > 0) {
        { TASK_DECODE(0, smp, item, chunk); loader_load(a, R, sw, lane, smp, smp ? 4 * item + sw : (item >> 2), chunk * 32); loader_store(R, lds, 0, sw, lane); }
        if (NT > 1) { TASK_DECODE(1, smp, item, chunk); loader_load(a, R, sw, lane, smp, smp ? 4 * item + sw : (item >> 2), chunk * 32); }
    }
    LDS_WAIT(); __builtin_amdgcn_s_barrier(); asm volatile("" ::: "memory");
    for (int j = 0; j < NT; ++j) {
        const bool smp_task = j >= nPI * 64;
        if (scanw || smp_task) {
            TASK_DECODE(j, smp, item, chunk);
            const LAS float* B = (const LAS float*)(lds + (j & 1) * SB_BYTES);
            if (!smp) {
                const int chain = item >> 2, q = item & 3, b = chain >> 3, h = chain & 7;
                if (chunk == 0) S = (f32x4){0.f, 0.f, 0.f, 0.f};
                const int rowb = b * SEQ + chunk * 32;
                const int vrow = 16 * q + lr;
                f32x2 Sa = {S.x, S.y}, Sb = {S.z, S.w};
                StepOps c0, c1, c2;
                ld_step(c0, B, 4 * jj, vrow); ld_step(c1, B, 64 + 4 * jj, 64 + vrow);
                float p;
                { f32x2 t = Sa * (f32x2){c0.kk.x, c0.kk.y}; t = Sb * (f32x2){c0.kk.z, c0.kk.w} + t; p = row16_sum(t.x + t.y); }
                for (int blk = 0; blk < 2; ++blk) {
                    float ykeep = 0.f;
#pragma unroll
                    for (int s2 = 0; s2 < 16; ++s2) {
                        const int sc_ = blk * 16 + s2;
                        const int sn = (sc_ + 2) & 31;
                        ld_step(c2, B, sn * 64 + 4 * jj, sn * 64 + vrow);
                        const float beta = B[SB_BETA + sc_];
                        const f32x2 Aa = Sa * (f32x2){c0.w.x, c0.w.y} + (f32x2){c0.k.x, c0.k.y} * c0.v;
                        const f32x2 Ab = Sb * (f32x2){c0.w.z, c0.w.w} + (f32x2){c0.k.z, c0.k.w} * c0.v;
                        f32x2 tq = Aa * (f32x2){c1.kk.x, c1.kk.y}; tq = Ab * (f32x2){c1.kk.z, c1.kk.w} + tq;
                        const float q = row16_sum(tq.x + tq.y);
                        const float np = -p;
                        Sa = Aa + (f32x2){c0.b.x, c0.b.y} * np; Sb = Ab + (f32x2){c0.b.z, c0.b.w} * np;
                        f32x2 u = Sa * (f32x2){c0.r.x, c0.r.y}; u = Sb * (f32x2){c0.r.z, c0.r.w} + u;
                        const float y = row16_sum(u.x + u.y);
                        ykeep = (s2 == jj) ? y : ykeep;
                        p = q + np * beta;
                        c0 = c1; c1 = c2;
                    }
                    Yraw[(size_t)(rowb + blk * 16 + jj) * 512 + h * 64 + vrow] = ykeep;
                }
                S = (f32x4){Sa.x, Sa.y, Sb.x, Sb.y};
                if (chunk == 63) *(GAS f32x4*)(a.out + O_WKVP + ((size_t)(chain * 64 + vrow)) * 64 + 4 * jj) = S;
            } else {
                for (int cs = scanw ? 0 : 2; cs < (scanw ? 2 : 4); ++cs) {
                    const int chain = 4 * item + cs, b = chain >> 3, h = chain & 7;
                    const float* st = a.in[4] + (size_t)chain * 4096;
                    f32x4 Sq[4]; float yk[4] = {0.f, 0.f, 0.f, 0.f};
#pragma unroll
                    for (int qq = 0; qq < 4; ++qq) Sq[qq] = gldf4(st + (16 * qq + lr) * 64 + 4 * jj);
#pragma unroll
                    for (int t = 0; t < 8; ++t) {
                        const int s = 8 * cs + t;
                        const f32x4 kk = *(const LAS f32x4*)(B + SB_KK + s * 64 + 4 * jj), w = *(const LAS f32x4*)(B + SB_W + s * 64 + 4 * jj), bb = *(const LAS f32x4*)(B + SB_B + s * 64 + 4 * jj);
                        const f32x4 k = *(const LAS f32x4*)(B + SB_K + s * 64 + 4 * jj), r = *(const LAS f32x4*)(B + SB_R + s * 64 + 4 * jj);
#pragma unroll
                        for (int qq = 0; qq < 4; ++qq) {
                            const float vv = B[SB_V + s * 64 + 16 * qq + lr];
                            const float y = wkv_step(Sq[qq], kk, w, bb, k, r, vv);
                            yk[qq] = (t == jj) ? y : yk[qq];
                        }
                    }
#pragma unroll
                    for (int qq = 0; qq < 4; ++qq) {
                        if (jj < 8) Yraw[(size_t)(TP + b * DSEQ + jj) * 512 + h * 64 + 16 * qq + lr] = yk[qq];
                        *(GAS f32x4*)(a.out + O_WKVS + ((size_t)(chain * 64 + 16 * qq + lr)) * 64 + 4 * jj) = Sq[qq];
                    }
                }
            }
        }
        if (!scanw && j + 1 < NT) {
            loader_store(R, lds, (j + 1) & 1, sw, lane);
            if (j + 2 < NT) { TASK_DECODE(j + 2, smp, item, chunk); loader_load(a, R, sw, lane, smp, smp ? 4 * item + sw : (item >> 2), chunk * 32); }
        }
        LDS_WAIT(); __builtin_amdgcn_s_barrier(); asm volatile("" ::: "memory");
    }
#undef TASK_DECODE
}

struct MixConst { f32x4 w[6]; f32x4 l[4]; };
struct MixRaw { u32x4 cb, cc0, cx0, cc1, cx1, cc2, cx2, g, v; f32x4 y0, y1; float rk; };
__device__ __forceinline__ void p3_load(const Args& a, MixRaw& R, int row, int lane) {
    const bool smp = row >= TP;
    const int t = smp ? ((row - TP) & 7) : (row & 2047);
    const bf16* pr = (const bf16*)(a.ws + WS_PROJ) + (size_t)row * IC;
    const int c8 = 8 * lane;
    const u32x4 z = {0u, 0u, 0u, 0u};
    R.cb = gld16(pr + c8); R.cc0 = gld16(pr + 512 + c8); R.cx0 = gld16(pr + 1024 + c8);
    R.cc1 = z; R.cx1 = z; R.cc2 = z; R.cx2 = z;
    if (t >= 1) { R.cc1 = gld16(pr - IC + 512 + c8); R.cx1 = gld16(pr - IC + 1024 + c8); }
    if (t >= 2) { R.cc2 = gld16(pr - 2 * IC + 512 + c8); R.cx2 = gld16(pr - 2 * IC + 1024 + c8); }
    const float* yr = a.out + OS_YRAW + (size_t)row * 512 + c8;
    R.y0 = gldf4(yr); R.y1 = gldf4(yr + 4);
    R.v = gld16((const bf16*)(a.out + OS_V) + (size_t)row * 512 + c8);
    R.g = gld16((const bf16*)(a.out + OS_G) + (size_t)row * 512 + c8);
    R.rk = ((const float*)(a.ws + WS_RK))[(size_t)row * 8 + (lane >> 3)];
}
__device__ __forceinline__ void p3_token(const Args& a, const MixConst& K, const MixRaw& R, int row, int lane) {
    const bool smp = row >= TP;
    const int rr = row - TP;
    const int b = smp ? (rr >> 3) : (row >> 11), t = smp ? (rr & 7) : (row & 2047), L = smp ? DSEQ : SEQ;
    const bf16* pr = (const bf16*)(a.ws + WS_PROJ) + (size_t)row * IC;
    const int c8 = 8 * lane;
    float yconv[8], yrw[8];
    {
        float cb[8], cc[8], cx[8], u0[8], f1[8], f2[8];
        unpack8(R.cb, cb); unpack8(R.cc0, cc); unpack8(R.cx0, cx);
#pragma unroll
        for (int i = 0; i < 8; ++i) u0[i] = cc[i] * cx[i];
        unpack8(R.cc1, cc); unpack8(R.cx1, cx);
#pragma unroll
        for (int i = 0; i < 8; ++i) f1[i] = cc[i] * cx[i];
        unpack8(R.cc2, cc); unpack8(R.cx2, cx);
#pragma unroll
        for (int i = 0; i < 8; ++i) f2[i] = cc[i] * cx[i];
        if (smp && t < 2) {
            const float* sc = a.in[2] + (size_t)b * 1024;
            if (t == 0) { const f32x4 s0 = gldf4(sc + 512 + c8), s1 = gldf4(sc + 512 + c8 + 4); f1[0] = s0.x; f1[1] = s0.y; f1[2] = s0.z; f1[3] = s0.w; f1[4] = s1.x; f1[5] = s1.y; f1[6] = s1.z; f1[7] = s1.w; }
            const float* sp = sc + (t == 1 ? 512 : 0) + c8; const f32x4 s0 = gldf4(sp), s1 = gldf4(sp + 4);
            f2[0] = s0.x; f2[1] = s0.y; f2[2] = s0.z; f2[3] = s0.w; f2[4] = s1.x; f2[5] = s1.y; f2[6] = s1.z; f2[7] = s1.w;
        }
        const f32x4 w00 = K.w[0], w01 = K.w[1], w10 = K.w[2], w11 = K.w[3], w20 = K.w[4], w21 = K.w[5];
        const float W0[8] = {w00.x, w00.y, w00.z, w00.w, w01.x, w01.y, w01.z, w01.w}, W1[8] = {w10.x, w10.y, w10.z, w10.w, w11.x, w11.y, w11.z, w11.w}, W2[8] = {w20.x, w20.y, w20.z, w20.w, w21.x, w21.y, w21.z, w21.w};
#pragma unroll
        for (int i = 0; i < 8; ++i) yconv[i] = cb[i] * (f2[i] * W0[i] + f1[i] * W1[i] + u0[i] * W2[i]);
        if (t >= L - 2) {
            float* oc = a.out + (smp ? O_CONVS : O_CONVP) + (size_t)b * 1024 + (t == L - 1 ? 512 : 0) + c8;
            *(GAS f32x4*)oc = (f32x4){u0[0], u0[1], u0[2], u0[3]}; *(GAS f32x4*)(oc + 4) = (f32x4){u0[4], u0[5], u0[6], u0[7]};
        }
    }
    {
        const f32x4 y0 = R.y0, y1 = R.y1;
        float y[8] = {y0.x, y0.y, y0.z, y0.w, y1.x, y1.y, y1.z, y1.w};
        float s = 0.f;
#pragma unroll
        for (int i = 0; i < 8; ++i) s += y[i];
        s += __shfl_xor(s, 1); s += __shfl_xor(s, 2); s += __shfl_xor(s, 4);
        const float mean = s * (1.f / 64.f);
        float qv = 0.f;
#pragma unroll
        for (int i = 0; i < 8; ++i) { y[i] -= mean; qv += y[i] * y[i]; }
        qv += __shfl_xor(qv, 1); qv += __shfl_xor(qv, 2); qv += __shfl_xor(qv, 4);
        const float rs = 1.0f / sqrtf(qv * (1.f / 64.f) + 64e-5f);
        float xv[8], g[8];
        unpack8(R.v, xv); unpack8(R.g, g);
        const float rk = R.rk;
        const f32x4 l0 = K.l[0], l1 = K.l[1], b0 = K.l[2], b1 = K.l[3];
        const float lg[8] = {l0.x, l0.y, l0.z, l0.w, l1.x, l1.y, l1.z, l1.w}, lb[8] = {b0.x, b0.y, b0.z, b0.w, b1.x, b1.y, b1.z, b1.w};
#pragma unroll
        for (int i = 0; i < 8; ++i) yrw[i] = (y[i] * rs * lg[i] + lb[i] + rk * xv[i]) * g[i];
    }
    bf16* ym = (bf16*)(a.ws + WS_XN) + (size_t)row * 1024;
    *(GAS u32x4*)(ym + c8) = pack8(yconv);
    *(GAS u32x4*)(ym + 512 + c8) = pack8(yrw);
    if (t == L - 1) {
        float* os = a.out + (smp ? O_SHIFTS : O_SHIFTP) + (size_t)b * RWC;
#pragma unroll
        for (int i = 0; i < 7; ++i) { const int c = i * 256 + 4 * lane; const u32x2 u = *(const GAS u32x2*)(pr + PRW + c);
            *(GAS f32x4*)(os + c) = (f32x4){bflo(u.x), bfhi(u.x), bflo(u.y), bfhi(u.y)}; }
    }
}

#define XB_TMO      128
#define XB_XCNT(j)  (256  + 64 * (j))
#define XB_XSUB(j)  (1280 + 64 * (j))
#define XB_XGEN(j)  (2304 + 64 * (j))
#define XB_TOP      3328
#define XB_TOPGEN   3392
#define XCD_BAR_WORDS 3456
#define XB_SPIN_CAP (1u << 18)

__device__ __forceinline__ unsigned xb_ld(unsigned* p)              { return __hip_atomic_load(p, __ATOMIC_RELAXED, __HIP_MEMORY_SCOPE_AGENT); }
__device__ __forceinline__ unsigned xb_add(unsigned* p, unsigned v) { return __hip_atomic_fetch_add(p, v, __ATOMIC_RELAXED, __HIP_MEMORY_SCOPE_AGENT); }
__device__ __forceinline__ unsigned xb_xcc_id() { return (unsigned)__builtin_amdgcn_s_getreg((3 << 11) | 20) & 0xFu; }
#define XB_SPIN(cond, bar) do { unsigned _sp = 0; while (cond) { __builtin_amdgcn_s_sleep(1); \
    if ((++_sp & 255u) == 0u) { if (xb_ld(&(bar)[XB_TMO])) break; if (_sp > XB_SPIN_CAP) { atomicAdd(&(bar)[XB_TMO], 1u); break; } } } } while (0)

struct XcdBarrier {
    unsigned* bar; unsigned x;
    volatile LAS unsigned* st;
};

__device__ __forceinline__ XcdBarrier xcd_barrier_post(unsigned* bar, volatile LAS unsigned* st) {
    XcdBarrier b; b.bar = bar; b.x = xb_xcc_id(); b.st = st;
    if (threadIdx.x == 0) (void)xb_add(&bar[XB_XCNT(b.x)], 1u);
    return b;
}
__device__ __forceinline__ void xcd_barrier_complete(unsigned* bar, unsigned x, unsigned& nloc, unsigned& nx) {
    const unsigned G = gridDim.x * gridDim.y * gridDim.z;
    unsigned sum, cnt, mine, sp = 0u;
    for (;;) {
        sum = 0u; cnt = 0u; mine = 0u;
#pragma unroll
        for (unsigned j = 0; j < 16; ++j) { const unsigned c = xb_ld(&bar[XB_XCNT(j)]); sum += c; cnt += (c > 0u) ? 1u : 0u; mine = (j == x) ? c : mine; }
        if (sum == G) break;
        __builtin_amdgcn_s_sleep(1);
        if ((++sp & 255u) == 0u) { if (xb_ld(&bar[XB_TMO])) break; if (sp > XB_SPIN_CAP) { atomicAdd(&bar[XB_TMO], 1u); break; } }
    }
    nloc = mine > 0u ? mine : 1u; nx = cnt > 0u ? cnt : 1u;
}

__device__ __forceinline__ void xcd_barrier(const XcdBarrier& b) {
    asm volatile("s_waitcnt vmcnt(0)" ::: "memory");
    __syncthreads();
    if (threadIdx.x == 0) {
        unsigned* bar = b.bar;
        __builtin_amdgcn_s_waitcnt(0);
        unsigned nloc = b.st[0], nx = b.st[1];
        if (nloc == 0u) { xcd_barrier_complete(bar, b.x, nloc, nx); b.st[0] = nloc; b.st[1] = nx; }
        const unsigned old = xb_add(&bar[XB_XSUB(b.x)], 1u);
        const unsigned gen = old / nloc;
        if (old + 1u == (gen + 1u) * nloc) {
            __builtin_amdgcn_fence(__ATOMIC_RELEASE, "agent");
            asm volatile("s_waitcnt vmcnt(0)" ::: "memory");
            const unsigned og = xb_add(&bar[XB_TOP], 1u);
            const unsigned tg = og / nx;
            if (og + 1u == (tg + 1u) * nx) xb_add(&bar[XB_TOPGEN], 1u);
            else XB_SPIN(xb_ld(&bar[XB_TOPGEN]) == tg, bar);
            __builtin_amdgcn_fence(__ATOMIC_ACQUIRE, "agent");
            xb_add(&bar[XB_XGEN(b.x)], 1u);
            asm volatile("s_waitcnt vmcnt(0)" ::: "memory");
        } else {
            XB_SPIN(xb_ld(&bar[XB_XGEN(b.x)]) == gen, bar);
            __builtin_amdgcn_fence(__ATOMIC_ACQUIRE, "agent");
            asm volatile("s_waitcnt vmcnt(0)" ::: "memory");
        }
    }
    __syncthreads();
}

__global__ void __launch_bounds__(512, 2) fwd_kernel(Args a) {
    extern __shared__ __attribute__((aligned(16))) unsigned char lds_raw[];
    LAS unsigned char* lds = (LAS unsigned char*)lds_raw;
    cg::grid_group grid = cg::this_grid();
    const int tid = threadIdx.x, lane = tid & 63, wave = __builtin_amdgcn_readfirstlane(tid >> 6);
    const int G = gridDim.x, bx = blockIdx.x;
    const int vcu = (G % 8 == 0) ? (bx % 8) * (G / 8) + bx / 8 : bx;
    const int gw = vcu * 8 + wave, NGW = G * 8;
    const int lo = a.ph_lo, hi = a.ph_hi;
#define IN(k) (lo <= (k) && (k) < hi)
    volatile LAS unsigned* barst = (volatile LAS unsigned*)(lds + LDS_BARST);
    if (tid == 0) { barst[0] = 0u; barst[1] = 0u; }
    __syncthreads();
    const XcdBarrier bar = xcd_barrier_post((unsigned*)(a.ws + WS_BAR) + a.li * XCD_BAR_WORDS, barst);
    if (a.ph_lo < 0) grid.sync();
#define SEAM(k) do { if (IN(k) && IN((k) + 1)) xcd_barrier(bar); } while (0)
    unsigned char* ws = a.ws;
    bf16* WT_IN = (bf16*)(ws + WS_WIN); bf16* WT_OUT = (bf16*)(ws + WS_WOUT); bf16* WT_FF1 = (bf16*)(ws + WS_WFF1); bf16* WT_FF2 = (bf16*)(ws + WS_WFF2);
    bf16* XN = (bf16*)(ws + WS_XN); bf16* XG = (bf16*)(ws + WS_XG); bf16* PROJ = (bf16*)(ws + WS_PROJ); bf16* HB = (bf16*)(ws + WS_H);
    float* SS1 = (float*)(ws + WS_SS1); float* SS2 = (float*)(ws + WS_SS2);

    if (IN(0)) {
        LAS float* scr = (LAS float*)(lds + wave * 16384);
        constexpr int I_IN = 16 * (IC / 32), I_OUT = 16 * 32, I_F1 = 16 * (FFD / 32), I_F2 = 64 * 32, I_W2 = 16, I_A2 = 16, I_G2 = 2 * 16;
        constexpr int NITEMS = I_IN + I_W2 + I_A2 + I_G2;
        for (int it = gw; it < NITEMS; it += NGW) {
            int r = it;
            if (r < I_IN) { p0_transpose_item(a.in[6], DM, IC, WT_IN, scr, r, lane); continue; } r -= I_IN;
            if (r < I_W2) { p0_transpose_item(a.in[10], 64, 512, (bf16*)(ws + WS_W2T), scr, r, lane); continue; } r -= I_W2;
            if (r < I_A2) { p0_transpose_item(a.in[12], 64, 512, (bf16*)(ws + WS_A2T), scr, r, lane); continue; } r -= I_A2;
            p0_transpose_item(a.in[13], 128, 512, (bf16*)(ws + WS_G2T), scr, r, lane);
        }
        {
            const GAS f32x4* gr = (const GAS f32x4*)a.in[5] + lane;
            const f32x4 g0 = gr[0], g1 = gr[64], g2 = gr[128], g3 = gr[192];
            for (int m0 = gw; m0 < TT; m0 += 4 * NGW) {
                f32x4 v[4][4];
#pragma unroll
                for (int k = 0; k < 4; ++k) { const int m = m0 + k * NGW;
                    if (m < TT) { const float* xrow = (m < TP) ? a.in[0] + (size_t)m * DM : a.in[1] + (size_t)(m - TP) * DM; const GAS f32x4* xr = (const GAS f32x4*)xrow + lane;
                        v[k][0] = xr[0]; v[k][1] = xr[64]; v[k][2] = xr[128]; v[k][3] = xr[192]; }
                    else { v[k][0] = v[k][1] = v[k][2] = v[k][3] = (f32x4){0.f, 0.f, 0.f, 0.f}; } }
#pragma unroll
                for (int k = 0; k < 4; ++k) { const int m = m0 + k * NGW;
                    float s2 = 0.f;
#pragma unroll
                    for (int j = 0; j < 4; ++j) s2 += (v[k][j].x * v[k][j].x + v[k][j].y * v[k][j].y) + (v[k][j].z * v[k][j].z + v[k][j].w * v[k][j].w);
                    const float rstd = 1.0f / sqrtf(wave_sum(s2) * (1.f / DM) + 1e-6f);
                    if (m < TT) { GAS u32x2* o8 = (GAS u32x2*)(XN + (size_t)m * DM) + lane;
                        u32x2 w; w.x = pk2(v[k][0].x * rstd * g0.x, v[k][0].y * rstd * g0.y); w.y = pk2(v[k][0].z * rstd * g0.z, v[k][0].w * rstd * g0.w); o8[0] = w;
                        w.x = pk2(v[k][1].x * rstd * g1.x, v[k][1].y * rstd * g1.y); w.y = pk2(v[k][1].z * rstd * g1.z, v[k][1].w * rstd * g1.w); o8[64] = w;
                        w.x = pk2(v[k][2].x * rstd * g2.x, v[k][2].y * rstd * g2.y); w.y = pk2(v[k][2].z * rstd * g2.z, v[k][2].w * rstd * g2.w); o8[128] = w;
                        w.x = pk2(v[k][3].x * rstd * g3.x, v[k][3].y * rstd * g3.y); w.y = pk2(v[k][3].z * rstd * g3.z, v[k][3].w * rstd * g3.w); o8[192] = w; }
                }
            }
        }
    }
    SEAM(0);
    if (IN(1)) {
        pg8::Gemm g{XN, WT_IN, TT, IC, DM}; pg8::StaticOrder S; S.init(TT, IC, G, bx);
        pg8::EpiStore<0> E{PROJ, IC};
        pg8::gemm_phase<pg8::EpiStore<0>, pg8::StaticOrder, true, true>(lds, g, S, E);
        {
            const int ntile = (TT / 256) * (IC / 256), full = ntile / G, nbusy = ntile - full * G;
            if (bx >= nbusy) {
                constexpr int I_OUT = 16 * 32, I_F1 = 16 * (FFD / 32), I_F2 = 64 * 32;
                LAS float* scr = (LAS float*)(lds + wave * 16384);
                for (int it = (bx - nbusy) * 8 + wave; it < I_OUT + I_F1 + I_F2; it += (G - nbusy) * 8) {
                    int r = it;
                    if (r < I_OUT) { p0_transpose_item(a.in[19], DM, DM, WT_OUT, scr, r, lane); continue; } r -= I_OUT;
                    if (r < I_F1) { p0_transpose_item(a.in[21], DM, FFD, WT_FF1, scr, r, lane); continue; } r -= I_F1;
                    p0_transpose_item(a.in[22], FFD, DM, WT_FF2, scr, r, lane);
                }
            }
        }
    }
    SEAM(1);
    if (IN(2)) {
        LAS unsigned char* scr = lds + wave * PREP_SCR;
        PrepConst C; C.unused = 0;
        {
            const int h = gw & 7, cgp = lane & 7;
            int col[7]; prep_cols(h, cgp, col);
            LAS float* MUw = (LAS float*)(scr + PREP_MU);
#pragma unroll
            for (int i = 0; i < 7; ++i) { *(LAS f32x4*)(MUw + (i * 8 + cgp) * 8) = gldf4(a.in[8] + col[i]); *(LAS f32x4*)(MUw + (i * 8 + cgp) * 8 + 4) = gldf4(a.in[8] + col[i] + 4); }
            LDS_WAIT();
        }
        PrepRaw R, Rn;
        int it = gw;
        if (it < TT) prep_load(a, R, lane, (it >> 3) * 8, it & 7);
        while (it < TT) {
            const int nit = it + NGW;
            if (nit < TT) prep_load(a, Rn, lane, (nit >> 3) * 8, nit & 7);
            prep_item(a, C, R, scr, lane, (it >> 3) * 8, it & 7);
            R = Rn; it = nit;
        }
    }
    SEAM(2);
    if (IN(3)) p2_scan(a, lds, G, vcu, wave, lane);
    SEAM(3);
    if (IN(4)) {
        MixConst K; { const int c8 = 8 * lane; const float* cw = a.in[7];
            K.w[0] = gldf4(cw + c8); K.w[1] = gldf4(cw + c8 + 4); K.w[2] = gldf4(cw + 512 + c8); K.w[3] = gldf4(cw + 512 + c8 + 4); K.w[4] = gldf4(cw + 1024 + c8); K.w[5] = gldf4(cw + 1024 + c8 + 4);
            K.l[0] = gldf4(a.in[17] + c8); K.l[1] = gldf4(a.in[17] + c8 + 4); K.l[2] = gldf4(a.in[18] + c8); K.l[3] = gldf4(a.in[18] + c8 + 4); }
        MixRaw R, Rn;
        int m = gw;
        if (m < TT) p3_load(a, R, m, lane);
        while (m < TT) {
            const int mn = m + NGW;
            if (mn < TT) p3_load(a, Rn, mn, lane);
            p3_token(a, K, R, m, lane);
            R = Rn; m = mn;
        }
    }
    SEAM(4);
    if (IN(5)) {
        unsigned* ocnt = (unsigned*)(ws + WS_BAR) + 30000;
        if (G == 256) {
            { pg8::Gemm g{XN, WT_OUT, TT, DM, DM}; pg8::OutOrder S{G, bx, ocnt};
              pg8::EpiRes<0> E{a.in[0], a.in[1], a.out, XG, a.in[20], nullptr, SS1};
              pg8::gemm_phase<pg8::EpiRes<0>, pg8::OutOrder, true, true>(lds, g, S, E); }
            {
              pg8::Gemm g{XG, WT_FF1, TT, FFD, DM}; pg8::SampleFF1Order S{G, bx, ocnt, 16u * 8u};
              pg8::EpiStore<1> E{HB, FFD};
              pg8::gemm_phase<pg8::EpiStore<1>, pg8::SampleFF1Order, true, true>(lds, g, S, E); }
        } else {
            pg8::Gemm g{XN, WT_OUT, TT, DM, DM}; pg8::StaticOrder S; S.init(TT, DM, G, bx);
            pg8::EpiRes<0> E{a.in[0], a.in[1], a.out, XG, a.in[20], nullptr, SS1};
            pg8::gemm_phase<pg8::EpiRes<0>, pg8::StaticOrder, true, true>(lds, g, S, E);
        }
    }
    SEAM(5);
    if (IN(6)) {
        const int mrows = (G == 256) ? TP : TT;
        pg8::Gemm g{XG, WT_FF1, mrows, FFD, DM}; pg8::StaticOrder S; S.init(mrows, FFD, G, bx);
        pg8::EpiStore<1> E{HB, FFD};
        pg8::gemm_phase<pg8::EpiStore<1>, pg8::StaticOrder, true, true>(lds, g, S, E);
    }
    SEAM(6);
    if (IN(7)) {
        {
            pg8::Gemm g{HB, WT_FF2, TP, DM, FFD, 0}; pg8::StaticOrder S; S.init(TP, DM, G, bx);
            if (G == 256) {
                pg8::EpiResNorm E{a.out, SS1, a.in[23], (float*)(ws + WS_XSTAT), (unsigned*)(ws + WS_BAR) + 20000};
                pg8::gemm_phase<pg8::EpiResNorm, pg8::StaticOrder, false, true>(lds, g, S, E);
            } else {
                pg8::EpiRes<1> E{nullptr, nullptr, a.out, nullptr, nullptr, SS1, SS2};
                pg8::gemm_phase<pg8::EpiRes<1>, pg8::StaticOrder, true, true>(lds, g, S, E);
            }
        }
        {
            pg8::Gemm g{HB, WT_FF2, TT, DM, 512, FFD}; pg8::SplitOrder S{G, bx};
            pg8::EpiPart E{(float*)(ws + WS_PART)};
            pg8::gemm_phase<pg8::EpiPart, pg8::SplitOrder, true, true>(lds, g, S, E);
        }
    }
    SEAM(7);
    if (IN(8)) {
        for (int m = gw; m < TT; m += NGW) {
            GAS f32x4* xr = (GAS f32x4*)(a.out + (size_t)m * DM) + lane; const GAS f32x4* gr = (const GAS f32x4*)a.in[23] + lane;
            if (m < TP) {
                if (G == 256) continue;
                float s = (lane < 16) ? SS2[(size_t)m * 16 + lane] : 0.f;
                const float rstd = 1.0f / sqrtf(wave_sum(s) * (1.f / DM) + 1e-6f);
#pragma unroll
                for (int j = 0; j < 4; ++j) { const f32x4 v = xr[64 * j], gg = gr[64 * j]; xr[64 * j] = v * rstd * gg; }
            } else {
                float s1 = (lane < 16) ? SS1[(size_t)m * 16 + lane] : 0.f;
                const float sc = 1.0f / (wave_sum(s1) * (1.f / DM) + 1e-6f);
                const GAS f32x4* pr = (const GAS f32x4*)((const float*)(ws + WS_PART) + (size_t)(m - TP) * 1024) + lane;
                f32x4 x2[4]; float s2 = 0.f;
#pragma unroll
                for (int j = 0; j < 4; ++j) {
                    f32x4 acc = pr[64 * j];
#pragma unroll
                    for (int kc = 1; kc < 8; ++kc) acc = acc + pr[(size_t)kc * (1024 * 1024 / 4) + 64 * j];
                    x2[j] = xr[64 * j] + acc * sc;
                    s2 += (x2[j].x * x2[j].x + x2[j].y * x2[j].y) + (x2[j].z * x2[j].z + x2[j].w * x2[j].w);
                }
                const float rstd = 1.0f / sqrtf(wave_sum(s2) * (1.f / DM) + 1e-6f);
#pragma unroll
                for (int j = 0; j < 4; ++j) xr[64 * j] = x2[j] * rstd * gr[64 * j];
            }
        }
    }
#undef IN
#undef SEAM
}

extern "C" void kernel_launch(void* const* d_in, const int* in_sizes, int n_in, void* d_out, int out_size, void* d_ws, size_t ws_size, hipStream_t stream) {
    static int grid = 0;
    if (grid == 0) {
        int dev = 0, cus = 0, per_cu = 0;
        (void)hipGetDevice(&dev);
        (void)hipDeviceGetAttribute(&cus, hipDeviceAttributeMultiprocessorCount, dev);
        if (hipFuncSetAttribute((const void*)fwd_kernel, hipFuncAttributeMaxDynamicSharedMemorySize, LDS_BYTES) != hipSuccess) fprintf(stderr, "hipFuncSetAttribute failed\n");
        if (hipOccupancyMaxActiveBlocksPerMultiprocessor(&per_cu, (const void*)fwd_kernel, 512, LDS_BYTES) != hipSuccess || per_cu < 1) { fprintf(stderr, "occupancy query: %d\n", per_cu); per_cu = 1; }
        (void)hipGetLastError();
        grid = cus * 1;
        if (n_in != 24 || ws_size < WS_END) fprintf(stderr, "unexpected n_in %d ws %zu\n", n_in, ws_size);
    }
    Args a{};
    for (int i = 0; i < 24; ++i) a.in[i] = (const float*)d_in[i];
    a.out = (float*)d_out; a.ws = (unsigned char*)d_ws;
#ifndef PROBE_SEQ
#define PROBE_SEQ {0, 9}
#endif
    static const int seq[] = PROBE_SEQ;
    (void)hipMemsetAsync((unsigned char*)d_ws + WS_BAR, 0, BAR_ZERO_BYTES, stream);
    for (unsigned i = 0; i + 1 < sizeof(seq) / sizeof(seq[0]); i += 2) {
        a.ph_lo = seq[i]; a.ph_hi = seq[i + 1]; a.li = (int)(i / 2);
        void* args[] = {&a};
        hipError_t e = hipLaunchCooperativeKernel((const void*)fwd_kernel, dim3(grid), dim3(512), args, LDS_BYTES, stream);
        if (e != hipSuccess) fprintf(stderr, "cooperative launch failed: %s (grid %d)\n", hipGetErrorString(e), grid);
    }
}
```

```cpp
#include <hip/hip_runtime.h>
#include <hip/hip_cooperative_groups.h>
#include <cstdio>
#include <cstdint>
namespace cg = cooperative_groups;
namespace pg8 {
#define PG8_LAS __attribute__((address_space(3)))
typedef unsigned short bf16_t;
typedef short bf16x8 __attribute__((ext_vector_type(8)));
typedef float f32x4 __attribute__((ext_vector_type(4)));
typedef unsigned u32x4 __attribute__((ext_vector_type(4)));
constexpr int BM = 256, BK = 64, HALF = 128, HTB = HALF * BK * 2  , STAGE_BYTES = 8 * HTB, NXCD = 8, WGM = 8;

__host__ __device__ __forceinline__ int lds_byte(int r, int c) { const int st = (r >> 4) * 2 + (c >> 5), rr = r & 15, cc = c & 31, ob = rr * 64 + cc * 2; return st * 1024 + (ob ^ (((ob >> 9) & 1) << 5)); }
__host__ __device__ __forceinline__ void stage_rc(int b, int& R, int& C) { const int st = b / 1024, sb = b % 1024, swz = sb ^ (((sb >> 9) & 1) << 5); R = (st >> 1) * 16 + swz / 64; C = (st & 1) * 32 + (swz % 64) / 2; }
__host__ __device__ __forceinline__ int perm32(int rho) { const int n = rho >> 4, i = rho & 15; return 8 * (i >> 2) + 4 * n + (i & 3); }

struct Unit { int pm, pn, ko; };
struct Gemm { const bf16_t* A; const bf16_t* Bt; int M, N, K, ld; };

struct StaticOrder {
    int nM, nN, nwg, G, c;
    __host__ __device__ void init(int M, int N, int G_, int c_) { nM = M / BM; nN = N / BM; nwg = nM * nN; G = G_; c = c_; }
    __host__ __device__ bool next(int i, Unit& u) const {
        const long L = (long)i * G + c; if (L >= nwg) return false;
        int wgid = (int)L; { const int q = nwg / NXCD, r = nwg % NXCD, xcd = wgid % NXCD, off = wgid / NXCD; wgid = (xcd < r ? xcd * (q + 1) : r * (q + 1) + (xcd - r) * q) + off; }
        const int nig = WGM * nN, gid = wgid / nig, fm = gid * WGM, gsz = (nM - fm) < WGM ? (nM - fm) : WGM;
        u.pm = fm + ((wgid % nig) % gsz); u.pn = (wgid % nig) / gsz; u.ko = 0; return true;
    }
    __device__ __forceinline__ void a_ready(const Unit&) const {}
    __device__ __forceinline__ void done(const Unit&) const {}
};

__device__ __forceinline__ unsigned cvt_pk_bf16(float lo, float hi) { unsigned r; asm volatile("v_cvt_pk_bf16_f32 %0, %1, %2" : "=v"(r) : "v"(lo), "v"(hi)); return r; }
#define PG8_GAS __attribute__((address_space(1)))
template <int ACT  > struct EpiStore {
    static constexpr bool PERM = true, AFTER_DRAIN = false;
    bf16_t* O; int ldc;
    __device__ __forceinline__ void operator()(const f32x4 (&acc)[2][2][4][2], const Unit& u, int wr, int wc, int fr, int fq) const {
        const int row0 = u.pm * BM + wr * 64 + fr, col0 = u.pn * BM + wc * 32 + 8 * fq;
#pragma unroll
        for (int ai = 0; ai < 2; ++ai)
#pragma unroll
            for (int m = 0; m < 4; ++m) { bf16_t* rowp = O + (size_t)(row0 + ai * HALF + m * 16) * ldc + col0;
#pragma unroll
                for (int bj = 0; bj < 2; ++bj) { f32x4 v0 = acc[ai][bj][m][0], v1 = acc[ai][bj][m][1];
                    if (ACT == 1) { v0 = __builtin_elementwise_max(v0, (f32x4){0.f, 0.f, 0.f, 0.f}); v1 = __builtin_elementwise_max(v1, (f32x4){0.f, 0.f, 0.f, 0.f}); v0 = v0 * v0; v1 = v1 * v1; }
                    u32x4 w; w.x = cvt_pk_bf16(v0[0], v0[1]); w.y = cvt_pk_bf16(v0[2], v0[3]); w.z = cvt_pk_bf16(v1[0], v1[1]); w.w = cvt_pk_bf16(v1[2], v1[3]);
                    if (ACT == 0) asm volatile("global_store_dwordx4 %0, %1, off sc1\n\ts_nop 1" :: "v"(rowp + bj * HALF), "v"(w) : "memory"); else *(PG8_GAS u32x4*)(rowp + bj * HALF) = w; } }
    }
};
template <int MODE> struct EpiRes {
    static constexpr bool PERM = true, AFTER_DRAIN = false;
    const float* xp; const float* xs; float* out; bf16_t* XG; const float* gam; const float* ss_in; float* ssq;
    __device__ __forceinline__ void operator()(const f32x4 (&acc)[2][2][4][2], const Unit& u, int wr, int wc, int fr, int fq) const {
        const int row0 = u.pm * BM + wr * 64 + fr, col0 = u.pn * BM + wc * 32 + 8 * fq;
        f32x4 gv[2][2];
        if (MODE == 0) {
#pragma unroll
            for (int bj = 0; bj < 2; ++bj)
#pragma unroll
                for (int n = 0; n < 2; ++n) gv[bj][n] = *(const PG8_GAS f32x4*)(gam + col0 + bj * HALF + 4 * n);
        }
#pragma unroll
        for (int ai = 0; ai < 2; ++ai)
#pragma unroll
            for (int m = 0; m < 4; ++m) {
                const int row = row0 + ai * HALF + m * 16;
                const float* xin; float sc = 1.f;
                if (MODE == 0) { xin = (row < 16384) ? xp + (size_t)row * 1024 : xs + (size_t)(row - 16384) * 1024; }
                else { xin = out + (size_t)row * 1024;
                    const PG8_GAS f32x4* sp = (const PG8_GAS f32x4*)(ss_in + (size_t)row * 16);
                    const f32x4 s0 = sp[0], s1 = sp[1], s2 = sp[2], s3 = sp[3];
                    const f32x4 st = (s0 + s1) + (s2 + s3);
                    const float tot = (st[0] + st[1]) + (st[2] + st[3]);
                    sc = 1.0f / (tot * (1.0f / 1024.0f) + 1e-6f); }
                float* op = out + (size_t)row * 1024 + col0;
                float ss = 0.f;
#pragma unroll
                for (int bj = 0; bj < 2; ++bj) {
                    const f32x4 a0 = *(const PG8_GAS f32x4*)(xin + col0 + bj * HALF), a1 = *(const PG8_GAS f32x4*)(xin + col0 + bj * HALF + 4);
                    const f32x4 v0 = a0 + acc[ai][bj][m][0] * sc, v1 = a1 + acc[ai][bj][m][1] * sc;
                    *(PG8_GAS f32x4*)(op + bj * HALF) = v0; *(PG8_GAS f32x4*)(op + bj * HALF + 4) = v1;
                    ss += (v0[0] * v0[0] + v0[1] * v0[1]) + (v0[2] * v0[2] + v0[3] * v0[3]);
                    ss += (v1[0] * v1[0] + v1[1] * v1[1]) + (v1[2] * v1[2] + v1[3] * v1[3]);
                    if (MODE == 0) { const f32x4 g0 = v0 * gv[bj][0], g1 = v1 * gv[bj][1];
                        u32x4 w; w.x = cvt_pk_bf16(g0[0], g0[1]); w.y = cvt_pk_bf16(g0[2], g0[3]); w.z = cvt_pk_bf16(g1[0], g1[1]); w.w = cvt_pk_bf16(g1[2], g1[3]);
                        *(PG8_GAS u32x4*)(XG + (size_t)row * 1024 + col0 + bj * HALF) = w; }
                }
                ss += __shfl_xor(ss, 16); ss += __shfl_xor(ss, 32);
                if (fq == 0) ssq[(size_t)row * 16 + u.pn * 4 + wc] = ss;
            }
    }
};
struct SplitOrder {
    int G, c;
    __device__ bool next(int i, Unit& u) const { const int L = i * G + c; if (L >= 128) return false; const int tile = L >> 3, kc = L & 7; u.pm = 64 + (tile >> 2); u.pn = tile & 3; u.ko = kc * 512; return true; }
    __device__ __forceinline__ void a_ready(const Unit&) const {}
    __device__ __forceinline__ void done(const Unit&) const {}
};
struct EpiPart {
    static constexpr bool PERM = true, AFTER_DRAIN = false;
    float* P;
    __device__ __forceinline__ void operator()(const f32x4 (&acc)[2][2][4][2], const Unit& u, int wr, int wc, int fr, int fq) const {
        const int row0 = (u.pm - 64) * BM + wr * 64 + fr, col0 = u.pn * BM + wc * 32 + 8 * fq;
        float* base = P + (size_t)(u.ko >> 9) * (1024 * 1024);
#pragma unroll
        for (int ai = 0; ai < 2; ++ai)
#pragma unroll
            for (int m = 0; m < 4; ++m) { float* rowp = base + (size_t)(row0 + ai * HALF + m * 16) * 1024 + col0;
#pragma unroll
                for (int bj = 0; bj < 2; ++bj) { *(PG8_GAS f32x4*)(rowp + bj * HALF) = acc[ai][bj][m][0]; *(PG8_GAS f32x4*)(rowp + bj * HALF + 4) = acc[ai][bj][m][1]; } }
    }
};
struct OutOrder {
    int G, c; unsigned* cnt;
    __device__ bool next(int i, Unit& u) const { const int t = i * G + c; if (t >= 272) return false; if (t < 16) { u.pm = 64 + (t >> 2); u.pn = t & 3; } else { const int p = t - 16; u.pm = p >> 2; u.pn = p & 3; } u.ko = 0; return true; }
    __device__ __forceinline__ void a_ready(const Unit&) const {}
    __device__ __forceinline__ void done(const Unit& u) const {
        if (u.pm >= 64) {
            asm volatile("s_waitcnt vmcnt(0)" ::: "memory");
            __builtin_amdgcn_fence(__ATOMIC_RELEASE, "agent");
            if ((threadIdx.x & 63) == 0) __hip_atomic_fetch_add(cnt, 1u, __ATOMIC_RELAXED, __HIP_MEMORY_SCOPE_AGENT);
        }
    }
};
struct SampleFF1Order {
    int G, c; const unsigned* cnt; unsigned need;
    __device__ bool next(int i, Unit& u) const { const int t = c - 16; if (i != 0 || t < 0 || t >= 64) return false; u.pm = 64 + (t >> 4); u.pn = t & 15; u.ko = 0; return true; }
    __device__ __forceinline__ void a_ready(const Unit&) const {
        if (threadIdx.x < 64) {
            unsigned polls = 0;
            while ((unsigned)__builtin_amdgcn_readfirstlane(__hip_atomic_load(cnt, __ATOMIC_RELAXED, __HIP_MEMORY_SCOPE_AGENT)) < need) { if (++polls > (1u << 22)) break; __builtin_amdgcn_s_sleep(2); }
            __builtin_amdgcn_fence(__ATOMIC_ACQUIRE, "agent");
            asm volatile("s_waitcnt vmcnt(0)" ::: "memory");
        }
        asm volatile("" ::: "memory"); __builtin_amdgcn_s_barrier(); asm volatile("" ::: "memory");
    }
    __device__ __forceinline__ void done(const Unit&) const {}
};
struct EpiResNorm {
    static constexpr bool PERM = true, AFTER_DRAIN = true;
    float* out; const float* ss_in; const float* gam; float* xbuf; unsigned* cnt;
    __device__ __forceinline__ void fused(f32x4 (&acc)[2][2][4][2], const Unit& u, int wr, int wc, int fr, int fq, PG8_LAS unsigned char* lds, int wid, int lane) const {
        PG8_LAS float* P = (PG8_LAS float*)lds;
        PG8_LAS float* S = (PG8_LAS float*)(lds + 4096);
        const int row0 = u.pm * BM + wr * 64 + fr, col0 = u.pn * BM + wc * 32 + 8 * fq;
#pragma unroll
        for (int ai = 0; ai < 2; ++ai)
#pragma unroll
            for (int m = 0; m < 4; ++m) {
                const int row = row0 + ai * HALF + m * 16;
                const PG8_GAS f32x4* sp = (const PG8_GAS f32x4*)(ss_in + (size_t)row * 16);
                const f32x4 s0 = sp[0], s1 = sp[1], s2 = sp[2], s3 = sp[3];
                const f32x4 st = (s0 + s1) + (s2 + s3);
                const float sc = 1.0f / (((st[0] + st[1]) + (st[2] + st[3])) * (1.0f / 1024.0f) + 1e-6f);
                const float* xin = out + (size_t)row * 1024 + col0;
                float ss = 0.f;
#pragma unroll
                for (int bj = 0; bj < 2; ++bj) {
                    const f32x4 a0 = *(const PG8_GAS f32x4*)(xin + bj * HALF), a1 = *(const PG8_GAS f32x4*)(xin + bj * HALF + 4);
                    const f32x4 v0 = a0 + acc[ai][bj][m][0] * sc, v1 = a1 + acc[ai][bj][m][1] * sc;
                    acc[ai][bj][m][0] = v0; acc[ai][bj][m][1] = v1;
                    ss += (v0[0] * v0[0] + v0[1] * v0[1]) + (v0[2] * v0[2] + v0[3] * v0[3]);
                    ss += (v1[0] * v1[0] + v1[1] * v1[1]) + (v1[2] * v1[2] + v1[3] * v1[3]);
                }
                ss += __shfl_xor(ss, 16); ss += __shfl_xor(ss, 32);
                if (fq == 0) P[(ai * HALF + wr * 64 + m * 16 + fr) * 4 + wc] = ss;
            }
        asm volatile("s_waitcnt lgkmcnt(0)" ::: "memory"); __builtin_amdgcn_s_barrier(); asm volatile("" ::: "memory");
        const int rowl = wid * 32 + (lane & 31);
        if (lane < 32) {
            const float t = (P[rowl * 4 + 0] + P[rowl * 4 + 1]) + (P[rowl * 4 + 2] + P[rowl * 4 + 3]);
            __hip_atomic_store(xbuf + ((size_t)(u.pm * BM + rowl) * 4 + u.pn), t, __ATOMIC_RELAXED, __HIP_MEMORY_SCOPE_AGENT);
        }
        asm volatile("s_waitcnt vmcnt(0)" ::: "memory");
        if (lane == 0) __hip_atomic_fetch_add(cnt + 64 * u.pm, 1u, __ATOMIC_RELAXED, __HIP_MEMORY_SCOPE_AGENT);
        if (wid == 0) {
            unsigned polls = 0;
            while ((unsigned)__builtin_amdgcn_readfirstlane(__hip_atomic_load(cnt + 64 * u.pm, __ATOMIC_RELAXED, __HIP_MEMORY_SCOPE_AGENT)) < 32u) { if (++polls > (1u << 22)) break; __builtin_amdgcn_s_sleep(2); }
            __builtin_amdgcn_fence(__ATOMIC_ACQUIRE, "agent");
        }
        asm volatile("s_waitcnt vmcnt(0) lgkmcnt(0)" ::: "memory"); __builtin_amdgcn_s_barrier(); asm volatile("" ::: "memory");
        if (lane < 32) {
            const float* slot = xbuf + (size_t)(u.pm * BM + rowl) * 4; float tot = 0.f;
#pragma unroll
            for (int t = 0; t < 4; ++t) tot += __hip_atomic_load(slot + t, __ATOMIC_RELAXED, __HIP_MEMORY_SCOPE_AGENT);
            S[rowl] = 1.0f / sqrtf(tot * (1.0f / 1024.0f) + 1e-6f);
        }
        asm volatile("s_waitcnt lgkmcnt(0)" ::: "memory"); __builtin_amdgcn_s_barrier(); asm volatile("" ::: "memory");
        f32x4 gv[2][2];
#pragma unroll
        for (int bj = 0; bj < 2; ++bj)
#pragma unroll
            for (int n = 0; n < 2; ++n) gv[bj][n] = *(const PG8_GAS f32x4*)(gam + col0 + bj * HALF + 4 * n);
#pragma unroll
        for (int ai = 0; ai < 2; ++ai)
#pragma unroll
            for (int m = 0; m < 4; ++m) {
                const int rl = ai * HALF + wr * 64 + m * 16 + fr; const float rs = S[rl];
                float* op = out + (size_t)(u.pm * BM + rl) * 1024 + col0;
#pragma unroll
                for (int bj = 0; bj < 2; ++bj) { *(PG8_GAS f32x4*)(op + bj * HALF) = acc[ai][bj][m][0] * rs * gv[bj][0]; *(PG8_GAS f32x4*)(op + bj * HALF + 4) = acc[ai][bj][m][1] * rs * gv[bj][1]; }
            }
    }
};
template <class Epi, class Sched, bool ALIGN_EPI = false, bool SP2 = false>
__device__ __forceinline__ void gemm_phase(PG8_LAS unsigned char* lds, const Gemm g, const Sched& S, const Epi& E) {
    const int tid = threadIdx.x, wid = __builtin_amdgcn_readfirstlane(tid >> 6), lane = tid & 63, wr = wid >> 2, wc = wid & 3, fr = lane & 15, fq = lane >> 4;
    const int K = g.K, nt = K / BK, LD = g.ld ? g.ld : g.K;
    unsigned voffA[2], voffB[2];
#pragma unroll
    for (int i = 0; i < 2; ++i) { int R, C; stage_rc(tid * 16 + i * 8192, R, C); const int Rb = Epi::PERM ? ((R & ~31) + perm32(R & 31)) : R;
        voffA[i] = (unsigned)(R * LD + C) * 2u; voffB[i] = (unsigned)(Rb * LD + C) * 2u; }
    const size_t kstep = (size_t)(BK * 2);
    const size_t hstep = (size_t)HALF * LD * 2;
    const size_t tstep = 2 * hstep;
    const unsigned ldsw = (unsigned)wid * 1024u;
    const int aoff = lds_byte(wr * 64 + fr, fq * 8), boff = lds_byte(wc * 32 + fr, fq * 8);
#define PG8_SA(b, h) (((b) * 2 + (h)) * HTB)
#define PG8_SB(b, h) ((4 + (b) * 2 + (h)) * HTB)
#define PG8_STAGE(bufoff, gbase, voff) do { _Pragma("unroll") for (int _i = 0; _i < 2; ++_i) \
        __builtin_amdgcn_global_load_lds((const unsigned*)((const char*)(gbase) + (voff)[_i]), (PG8_LAS unsigned*)(lds + (bufoff) + ldsw + _i * 8192), 16, 0, 0); } while (0)
#define PG8_LDA(dst, b, h) do { _Pragma("unroll") for (int m = 0; m < 4; ++m) _Pragma("unroll") for (int k = 0; k < 2; ++k) dst[m][k] = *(const PG8_LAS bf16x8*)(lds + PG8_SA(b, h) + aoff + m * 2048 + k * 1024); } while (0)
#define PG8_LDB(dst, b, h) do { _Pragma("unroll") for (int n = 0; n < 2; ++n) _Pragma("unroll") for (int k = 0; k < 2; ++k) dst[n][k] = *(const PG8_LAS bf16x8*)(lds + PG8_SB(b, h) + boff + n * 2048 + k * 1024); } while (0)
#define PG8_MMA(ai, bj, At, Bt) do { __builtin_amdgcn_s_setprio(1); _Pragma("unroll") for (int m = 0; m < 4; ++m) _Pragma("unroll") for (int n = 0; n < 2; ++n) _Pragma("unroll") for (int k = 0; k < 2; ++k) \
        acc[ai][bj][m][n] = __builtin_amdgcn_mfma_f32_16x16x32_bf16(Bt[n][k], At[m][k], acc[ai][bj][m][n], 0, 0, 0); __builtin_amdgcn_s_setprio(0); } while (0)
#define PG8_WAIT_V(n) asm volatile("s_waitcnt vmcnt(" #n ")" ::: "memory")
#define PG8_WAIT_L(n) asm volatile("s_waitcnt lgkmcnt(" #n ")" ::: "memory")
#define PG8_BAR __builtin_amdgcn_s_barrier()
#define PG8_SCHED __builtin_amdgcn_sched_barrier(0)
    Unit cur, nxt; int ui = 0;
    if (!S.next(0, cur)) return;
    f32x4 acc[2][2][4][2];
#pragma unroll
    for (int a = 0; a < 2; ++a)
#pragma unroll
        for (int b = 0; b < 2; ++b)
#pragma unroll
            for (int m = 0; m < 4; ++m)
#pragma unroll
                for (int n = 0; n < 2; ++n) acc[a][b][m][n] = (f32x4){0.f, 0.f, 0.f, 0.f};
    bf16x8 At[4][2], B0[2][2], B1[2][2];
    const char* cA = (const char*)g.A + (size_t)cur.pm * tstep + (size_t)cur.ko * 2; const char* cB = (const char*)g.Bt + (size_t)cur.pn * tstep + (size_t)cur.ko * 2;
    S.a_ready(cur);
    if constexpr (SP2) {
        PG8_STAGE(PG8_SB(0, 0), cB, voffB); PG8_STAGE(PG8_SB(0, 1), cB + hstep, voffB); PG8_STAGE(PG8_SA(0, 0), cA, voffA); PG8_STAGE(PG8_SA(0, 1), cA + hstep, voffA);
        if (wr == 1) PG8_BAR;
        PG8_WAIT_V(2); PG8_BAR;
        PG8_STAGE(PG8_SB(1, 0), cB + kstep, voffB); PG8_STAGE(PG8_SA(1, 0), cA + kstep, voffA); PG8_STAGE(PG8_SB(1, 1), cB + hstep + kstep, voffB);
        PG8_WAIT_V(6); PG8_BAR;
    } else {
        PG8_STAGE(PG8_SB(0, 0), cB, voffB); PG8_STAGE(PG8_SA(0, 0), cA, voffA); PG8_STAGE(PG8_SB(0, 1), cB + hstep, voffB); PG8_STAGE(PG8_SA(0, 1), cA + hstep, voffA);
        if (wr == 1) PG8_BAR;
        PG8_WAIT_V(4); PG8_BAR;
        PG8_STAGE(PG8_SB(1, 0), cB + kstep, voffB); PG8_STAGE(PG8_SA(1, 0), cA + kstep, voffA); PG8_STAGE(PG8_SB(1, 1), cB + hstep + kstep, voffB);
        PG8_WAIT_V(6); PG8_BAR;
    }
    for (;;) {
        const bool has_next = S.next(ui + 1, nxt);
        const char* nA = has_next ? (const char*)g.A + (size_t)nxt.pm * tstep + (size_t)nxt.ko * 2 : cA; const char* nB = has_next ? (const char*)g.Bt + (size_t)nxt.pn * tstep + (size_t)nxt.ko * 2 : cB;
        for (int t = 0; t < nt; t += 2) {
            const bool last = (t == nt - 2);
            const char* a1 = cA + (size_t)(t + 1) * kstep;
            const char* a2 = last ? nA : cA + (size_t)(t + 2) * kstep; const char* b2 = last ? nB : cB + (size_t)(t + 2) * kstep;
            const char* a3 = a2 + kstep; const char* b3 = b2 + kstep;
            if (last && has_next) S.a_ready(nxt);
            if constexpr (SP2) {
            PG8_LDB(B0, 0, 0); PG8_LDB(B1, 0, 1); PG8_SCHED; PG8_LDA(At, 0, 0); PG8_STAGE(PG8_SA(1, 1), a1 + hstep, voffA);
            PG8_WAIT_V(8); PG8_WAIT_L(0); PG8_BAR; PG8_MMA(0, 0, At, B0); PG8_MMA(0, 1, At, B1); PG8_BAR; PG8_SCHED;
            PG8_LDA(At, 0, 1); PG8_STAGE(PG8_SB(0, 0), b2, voffB); PG8_STAGE(PG8_SB(0, 1), b2 + hstep, voffB); PG8_STAGE(PG8_SA(0, 0), a2, voffA);
            PG8_WAIT_V(8); PG8_WAIT_L(0); PG8_BAR; PG8_MMA(1, 0, At, B0); PG8_MMA(1, 1, At, B1); PG8_BAR; PG8_SCHED;
            PG8_LDB(B0, 1, 0); PG8_LDB(B1, 1, 1); PG8_SCHED; PG8_LDA(At, 1, 0); PG8_STAGE(PG8_SA(0, 1), a2 + hstep, voffA);
            PG8_WAIT_V(8); PG8_WAIT_L(0); PG8_BAR; PG8_MMA(0, 0, At, B0); PG8_MMA(0, 1, At, B1); PG8_BAR; PG8_SCHED;
            PG8_LDA(At, 1, 1); PG8_STAGE(PG8_SB(1, 0), b3, voffB); PG8_STAGE(PG8_SB(1, 1), b3 + hstep, voffB); PG8_STAGE(PG8_SA(1, 0), a3, voffA);
            PG8_WAIT_V(8); PG8_WAIT_L(0); PG8_BAR; PG8_MMA(1, 0, At, B0); PG8_MMA(1, 1, At, B1); PG8_BAR; PG8_SCHED;
            } else {
            PG8_LDB(B0, 0, 0); PG8_SCHED; PG8_LDA(At, 0, 0); PG8_STAGE(PG8_SA(1, 1), a1 + hstep, voffA);
            PG8_WAIT_L(8); PG8_BAR; PG8_WAIT_L(0); PG8_MMA(0, 0, At, B0); PG8_BAR; PG8_SCHED;
            PG8_LDB(B1, 0, 1); PG8_STAGE(PG8_SB(0, 0), b2, voffB);
            PG8_BAR; PG8_WAIT_L(0); PG8_MMA(0, 1, At, B1); PG8_BAR;
            PG8_LDA(At, 0, 1); PG8_STAGE(PG8_SA(0, 0), a2, voffA);
            PG8_BAR; PG8_WAIT_L(0); PG8_MMA(1, 0, At, B0); PG8_BAR; PG8_SCHED;
            PG8_STAGE(PG8_SB(0, 1), b2 + hstep, voffB);
            PG8_WAIT_V(6); PG8_BAR; PG8_MMA(1, 1, At, B1); PG8_BAR;
            PG8_LDB(B0, 1, 0); PG8_SCHED; PG8_LDA(At, 1, 0); PG8_STAGE(PG8_SA(0, 1), a2 + hstep, voffA);
            PG8_WAIT_L(8); PG8_BAR; PG8_WAIT_L(0); PG8_MMA(0, 0, At, B0); PG8_BAR; PG8_SCHED;
            PG8_LDB(B1, 1, 1); PG8_STAGE(PG8_SB(1, 0), b3, voffB);
            PG8_BAR; PG8_WAIT_L(0); PG8_MMA(0, 1, At, B1); PG8_BAR;
            PG8_LDA(At, 1, 1); PG8_STAGE(PG8_SA(1, 0), a3, voffA);
            PG8_BAR; PG8_WAIT_L(0); PG8_MMA(1, 0, At, B0); PG8_BAR; PG8_SCHED;
            PG8_STAGE(PG8_SB(1, 1), b3 + hstep, voffB);
            PG8_WAIT_V(6); PG8_BAR; PG8_MMA(1, 1, At, B1); PG8_BAR;
            }
        }
        if constexpr (ALIGN_EPI) { if (wr == 0) PG8_BAR; }
        if constexpr (!Epi::AFTER_DRAIN) { E(acc, cur, wr, wc, fr, fq); S.done(cur); }
        if (!has_next) break;
#pragma unroll
        for (int a = 0; a < 2; ++a)
#pragma unroll
            for (int b = 0; b < 2; ++b)
#pragma unroll
                for (int m = 0; m < 4; ++m)
#pragma unroll
                    for (int n = 0; n < 2; ++n) acc[a][b][m][n] = (f32x4){0.f, 0.f, 0.f, 0.f};
        cur = nxt; cA = nA; cB = nB; ++ui;
        if constexpr (ALIGN_EPI) { if (wr == 1) PG8_BAR; }
    }
    PG8_WAIT_V(0);
    if constexpr (!ALIGN_EPI) { if (wr == 0) PG8_BAR; }
    PG8_BAR;
    if constexpr (Epi::AFTER_DRAIN) { E.fused(acc, cur, wr, wc, fr, fq, lds, wid, lane); S.done(cur); }
#undef PG8_SA
#undef PG8_SB
#undef PG8_STAGE
#undef PG8_LDA
#undef PG8_LDB
#undef PG8_MMA
#undef PG8_WAIT_V
#undef PG8_WAIT_L
#undef PG8_BAR
#undef PG8_SCHED
}
}
constexpr int DM = 1024, TP = 16384, TS = 1024, TT = TP + TS, SEQ = 2048, DSEQ = 8, DBATCH = 128;
constexpr int IC = 3328, RWC = 1792, PRW = 1536, FFD = 4096;
constexpr size_t MiB = 1u << 20;
constexpr size_t WS_WIN = 0, WS_WOUT = 7 * MiB, WS_WFF1 = 9 * MiB, WS_WFF2 = 17 * MiB, WS_W2T = 25 * MiB, WS_A2T = WS_W2T + 65536, WS_G2T = WS_A2T + 65536;
constexpr size_t WS_SS1 = 26 * MiB, WS_SS2 = 28 * MiB, WS_XN = 30 * MiB, WS_XG = 64 * MiB, WS_PROJ = 98 * MiB, WS_H = 98 * MiB, WS_END = 234 * MiB;
constexpr size_t O_Y = 0, O_CONVP = (size_t)TT * 1024, O_SHIFTP = O_CONVP + 8192, O_WKVP = O_SHIFTP + 14336, O_CONVS = O_WKVP + 262144, O_SHIFTS = O_CONVS + 131072, O_WKVS = O_SHIFTS + 229376;
constexpr size_t OS_YRAW = 0, OS_G = (size_t)TT * 512, OS_V = OS_G + (size_t)TT * 256;
constexpr size_t WS_WD = 30 * MiB, WS_KK = 64 * MiB, WS_BB = 81 * MiB, WS_KM = 209 * MiB, WS_RR = 226 * MiB, WS_RK = 27 * MiB + 262144;
constexpr int LDS_BYTES = 147456;
constexpr size_t WS_BAR = 29 * MiB + 524288, BAR_ZERO_BYTES = 131072;
constexpr size_t WS_PART = 30 * MiB;
constexpr size_t WS_XSTAT = 29 * MiB + 131072;
constexpr int LDS_BARST = 131072 + 64;

#define GAS __attribute__((address_space(1)))
#define LAS __attribute__((address_space(3)))
typedef unsigned short bf16;
typedef unsigned u32x4 __attribute__((ext_vector_type(4)));
typedef unsigned u32x2 __attribute__((ext_vector_type(2)));
typedef float f32x4 __attribute__((ext_vector_type(4)));
typedef short bf16x8 __attribute__((ext_vector_type(8)));
#define LDS_WAIT() asm volatile("s_waitcnt lgkmcnt(0)" ::: "memory")

__device__ __forceinline__ unsigned pk2(float lo, float hi) { return pg8::cvt_pk_bf16(lo, hi); }
__device__ __forceinline__ bf16 f2bf_sw(float f) { const unsigned u = __builtin_bit_cast(unsigned, f); return (bf16)((u + 0x7fffu + ((u >> 16) & 1u)) >> 16); }
__device__ __forceinline__ float bflo(unsigned u) { return __builtin_bit_cast(float, u << 16); }
__device__ __forceinline__ float bfhi(unsigned u) { return __builtin_bit_cast(float, u & 0xffff0000u); }
__device__ __forceinline__ u32x4 gld16(const void* p) { return *(const GAS u32x4*)p; }
__device__ __forceinline__ f32x4 gldf4(const float* p) { return *(const GAS f32x4*)p; }
__device__ __forceinline__ void unpack8(const u32x4 u, float (&o)[8]) { o[0] = bflo(u.x); o[1] = bfhi(u.x); o[2] = bflo(u.y); o[3] = bfhi(u.y); o[4] = bflo(u.z); o[5] = bfhi(u.z); o[6] = bflo(u.w); o[7] = bfhi(u.w); }
__device__ __forceinline__ u32x4 pack8(const float (&v)[8]) { u32x4 w; w.x = pk2(v[0], v[1]); w.y = pk2(v[2], v[3]); w.z = pk2(v[4], v[5]); w.w = pk2(v[6], v[7]); return w; }
__device__ __forceinline__ float wave_sum(float v) {
#pragma unroll
    for (int o = 1; o < 64; o <<= 1) v += __shfl_xor(v, o);
    return v;
}
template <int CTRL> __device__ __forceinline__ float dppf(float x) { return __builtin_bit_cast(float, __builtin_amdgcn_update_dpp(0, __builtin_bit_cast(int, x), CTRL, 0xF, 0xF, true)); }
__device__ __forceinline__ float row16_sum(float x) {
    x += dppf<0xB1>(x); x += dppf<0x4E>(x); x += dppf<0x124>(x); x += dppf<0x128>(x); return x;
}
__device__ __forceinline__ float sigmoidf_(float x) { return __builtin_amdgcn_rcpf(1.0f + __expf(-x)); }
__device__ __forceinline__ float tanhf_(float x) { const float e = __expf(2.0f * x); return 1.0f - 2.0f * __builtin_amdgcn_rcpf(e + 1.0f); }

struct Args { const float* in[24]; float* out; unsigned char* ws; int ph_lo, ph_hi, li, pad; };

__device__ __forceinline__ void p0_transpose_item(const float* W, int K, int N, bf16* WT, LAS float* scr, int item, int lane) {
    const int nblk = N / 32, kb = item / nblk, nb = item % nblk, k0 = 64 * kb, n0 = 32 * nb;
#pragma unroll 8
    for (int i = 0; i < 32; ++i) { const int kk = 2 * i + (lane >> 5); scr[kk * 33 + (lane & 31)] = W[(size_t)(k0 + kk) * N + n0 + (lane & 31)]; }
    LDS_WAIT(); asm volatile("" ::: "memory");
    const int c = lane & 7;
#pragma unroll
    for (int j = 0; j < 4; ++j) { const int n = (lane >> 3) + 8 * j; const LAS float* s = scr + (8 * c) * 33 + n;
        u32x4 o; o.x = pk2(s[0 * 33], s[1 * 33]); o.y = pk2(s[2 * 33], s[3 * 33]); o.z = pk2(s[4 * 33], s[5 * 33]); o.w = pk2(s[6 * 33], s[7 * 33]);
        *(GAS u32x4*)(WT + (size_t)(n0 + n) * K + k0 + 8 * c) = o; }
    LDS_WAIT(); asm volatile("" ::: "memory");
}
__device__ __forceinline__ void rms_row_to_bf16(const float* xrow, const float* g, bf16* orow, int lane) {
    const GAS f32x4* xr = (const GAS f32x4*)xrow + lane; const GAS f32x4* gr = (const GAS f32x4*)g + lane;
    f32x4 v[4]; float s2 = 0.f;
#pragma unroll
    for (int j = 0; j < 4; ++j) { v[j] = xr[64 * j]; s2 += (v[j].x * v[j].x + v[j].y * v[j].y) + (v[j].z * v[j].z + v[j].w * v[j].w); }
    const float rstd = 1.0f / sqrtf(wave_sum(s2) * (1.f / DM) + 1e-6f);
    GAS u32x2* o8 = (GAS u32x2*)orow + lane;
#pragma unroll
    for (int j = 0; j < 4; ++j) { const f32x4 gg = gr[64 * j]; u32x2 w; w.x = pk2(v[j].x * rstd * gg.x, v[j].y * rstd * gg.y); w.y = pk2(v[j].z * rstd * gg.z, v[j].w * rstd * gg.w); o8[64 * j] = w; }
}

constexpr int SB_W = 0, SB_B = 2048, SB_K = 4096, SB_KK = 6144, SB_R = 8192, SB_V = 10240, SB_BETA = 12288, SB_BYTES = 49280, STG_OFF = 2 * SB_BYTES, STG_BYTES = 4608;

__device__ __forceinline__ void load_xm8(const bf16* prow, int c, bool first, const float* shift0, const float* mu, float (&o)[8]) {
    float cur[8], prv[8];
    unpack8(gld16(prow + c), cur);
    if (!first) { unpack8(gld16(prow - IC + c), prv); }
    else if (shift0) { const f32x4 a = gldf4(shift0 + c), b = gldf4(shift0 + c + 4); prv[0] = a.x; prv[1] = a.y; prv[2] = a.z; prv[3] = a.w; prv[4] = b.x; prv[5] = b.y; prv[6] = b.z; prv[7] = b.w; }
    else {
#pragma unroll
        for (int i = 0; i < 8; ++i) prv[i] = 0.f;
    }
    const f32x4 m0 = gldf4(mu + c), m1 = gldf4(mu + c + 4);
    const float mm[8] = {m0.x, m0.y, m0.z, m0.w, m1.x, m1.y, m1.z, m1.w};
#pragma unroll
    for (int i = 0; i < 8; ++i) o[i] = cur[i] + (prv[i] - cur[i]) * mm[i];
}

constexpr int PREP_MU = 10752, PREP_SCR = 12544;
__device__ __forceinline__ void prep_cols(int h, int cgp, int (&col)[7]) {
    col[0] = h * 64 + 8 * cgp; col[1] = 512 + h * 64 + 8 * cgp; col[2] = 1024 + h * 64 + 8 * cgp; col[3] = 1536 + 8 * cgp; col[4] = 1600 + 8 * cgp; col[5] = 1664 + 16 * cgp; col[6] = 1664 + 16 * cgp + 8;
}
struct PrepRaw { u32x4 c[7]; u32x4 p[7]; };
__device__ __forceinline__ void prep_load(const Args& a, PrepRaw& R, int lane, int row0, int h) {
    const bool smp = row0 >= TP;
    const int tok = lane >> 3, cgp = lane & 7, row = row0 + tok;
    const int t = smp ? tok : (row & 2047);
    const bf16* prow = (const bf16*)(a.ws + WS_PROJ) + (size_t)row * IC + PRW;
    int col[7]; prep_cols(h, cgp, col);
#pragma unroll
    for (int i = 0; i < 7; ++i) { R.c[i] = gld16(prow + col[i]); R.p[i] = (u32x4){0u, 0u, 0u, 0u}; }
    if (t != 0) {
#pragma unroll
        for (int i = 0; i < 7; ++i) R.p[i] = gld16(prow - IC + col[i]);
    }
}
__device__ __forceinline__ void xm8_raw(const u32x4 cu, const u32x4 pu, int c, bool fs, const float* shift0, const float* mu, float (&o)[8]) {
    float cur[8], prv[8];
    unpack8(cu, cur); unpack8(pu, prv);
    if (fs) { const f32x4 a = gldf4(shift0 + c), b = gldf4(shift0 + c + 4); prv[0] = a.x; prv[1] = a.y; prv[2] = a.z; prv[3] = a.w; prv[4] = b.x; prv[5] = b.y; prv[6] = b.z; prv[7] = b.w; }
    const f32x4 m0 = gldf4(mu + c), m1 = gldf4(mu + c + 4);
    const float mm[8] = {m0.x, m0.y, m0.z, m0.w, m1.x, m1.y, m1.z, m1.w};
#pragma unroll
    for (int i = 0; i < 8; ++i) o[i] = cur[i] + (prv[i] - cur[i]) * mm[i];
}
__device__ __forceinline__ void xm8_pre(const u32x4 cu, const u32x4 pu, int c, bool fs, const float* shift0, const f32x4 m0, const f32x4 m1, float (&o)[8]) {
    float cur[8], prv[8];
    unpack8(cu, cur); unpack8(pu, prv);
    if (fs) { const f32x4 a = gldf4(shift0 + c), b = gldf4(shift0 + c + 4); prv[0] = a.x; prv[1] = a.y; prv[2] = a.z; prv[3] = a.w; prv[4] = b.x; prv[5] = b.y; prv[6] = b.z; prv[7] = b.w; }
    const float mm[8] = {m0.x, m0.y, m0.z, m0.w, m1.x, m1.y, m1.z, m1.w};
#pragma unroll
    for (int i = 0; i < 8; ++i) o[i] = cur[i] + (prv[i] - cur[i]) * mm[i];
}
struct PrepConst { int unused; };
__device__ __forceinline__ void prep_item(const Args& a, const PrepConst& C, const PrepRaw& R, LAS unsigned char* scr, int lane, int row0, int h) {
    const bool smp = row0 >= TP;
    const int b = smp ? ((row0 - TP) >> 3) : (row0 >> 11);
    const int tok = lane >> 3, cgp = lane & 7;
    const int row = row0 + tok;
    const int t = smp ? tok : (row & 2047);
    const bool fs = (t == 0) && smp;
    const float* shift0 = a.in[3] + (size_t)b * RWC;
    int col[7]; prep_cols(h, cgp, col);
    const LAS float* MUs = (const LAS float*)(scr + PREP_MU);
    LAS float* KKs = (LAS float*)scr; LAS float* KRs = KKs + 512; LAS float* Rs = KRs + 512;
    LAS bf16* Lw = (LAS bf16*)(scr + 6144); LAS bf16* La = Lw + 8 * 72; LAS bf16* Lg = La + 8 * 72;
    const size_t go = (size_t)row * 512 + h * 64 + 8 * cgp;
    u32x4 pk_r, pk_v, pk_kk;
    {
        float xr[8], xk[8], xv[8];
        xm8_pre(R.c[0], R.p[0], col[0], fs, shift0, *(const LAS f32x4*)(MUs + (0 * 8 + cgp) * 8), *(const LAS f32x4*)(MUs + (0 * 8 + cgp) * 8 + 4), xr);
        xm8_pre(R.c[1], R.p[1], col[1], fs, shift0, *(const LAS f32x4*)(MUs + (1 * 8 + cgp) * 8), *(const LAS f32x4*)(MUs + (1 * 8 + cgp) * 8 + 4), xk);
        xm8_pre(R.c[2], R.p[2], col[2], fs, shift0, *(const LAS f32x4*)(MUs + (2 * 8 + cgp) * 8), *(const LAS f32x4*)(MUs + (2 * 8 + cgp) * 8 + 4), xv);
        pk_r = pack8(xr); pk_v = pack8(xv);
        *(LAS f32x4*)(Rs + tok * 64 + 8 * cgp) = (f32x4){xr[0], xr[1], xr[2], xr[3]}; *(LAS f32x4*)(Rs + tok * 64 + 8 * cgp + 4) = (f32x4){xr[4], xr[5], xr[6], xr[7]};
        *(LAS f32x4*)(KRs + tok * 64 + 8 * cgp) = (f32x4){xk[0], xk[1], xk[2], xk[3]}; *(LAS f32x4*)(KRs + tok * 64 + 8 * cgp + 4) = (f32x4){xk[4], xk[5], xk[6], xk[7]};
        const f32x4 c0 = gldf4(a.in[14] + h * 64 + 8 * cgp), c1 = gldf4(a.in[14] + h * 64 + 8 * cgp + 4);
        float kkv[8] = {xk[0] * c0.x, xk[1] * c0.y, xk[2] * c0.z, xk[3] * c0.w, xk[4] * c1.x, xk[5] * c1.y, xk[6] * c1.z, xk[7] * c1.w};
        float n2 = 0.f;
#pragma unroll
        for (int i = 0; i < 8; ++i) n2 += kkv[i] * kkv[i];
        n2 += __shfl_xor(n2, 1); n2 += __shfl_xor(n2, 2); n2 += __shfl_xor(n2, 4);
        const float inv = __builtin_amdgcn_rsqf(fmaxf(n2, 1e-24f));
#pragma unroll
        for (int i = 0; i < 8; ++i) kkv[i] *= inv;
        pk_kk = pack8(kkv);
        *(LAS f32x4*)(KKs + tok * 64 + 8 * cgp) = (f32x4){kkv[0], kkv[1], kkv[2], kkv[3]}; *(LAS f32x4*)(KKs + tok * 64 + 8 * cgp + 4) = (f32x4){kkv[4], kkv[5], kkv[6], kkv[7]};
    }
    {
        float xw[8], xa[8], xg[8];
        xm8_pre(R.c[3], R.p[3], col[3], fs, shift0, *(const LAS f32x4*)(MUs + (3 * 8 + cgp) * 8), *(const LAS f32x4*)(MUs + (3 * 8 + cgp) * 8 + 4), xw);
#pragma unroll
        for (int i = 0; i < 8; ++i) xw[i] = tanhf_(xw[i]);
        *(LAS u32x4*)(Lw + tok * 72 + 8 * cgp) = pack8(xw);
        xm8_pre(R.c[4], R.p[4], col[4], fs, shift0, *(const LAS f32x4*)(MUs + (4 * 8 + cgp) * 8), *(const LAS f32x4*)(MUs + (4 * 8 + cgp) * 8 + 4), xa);
        *(LAS u32x4*)(La + tok * 72 + 8 * cgp) = pack8(xa);
        xm8_pre(R.c[5], R.p[5], col[5], fs, shift0, *(const LAS f32x4*)(MUs + (5 * 8 + cgp) * 8), *(const LAS f32x4*)(MUs + (5 * 8 + cgp) * 8 + 4), xg);
#pragma unroll
        for (int i = 0; i < 8; ++i) xg[i] = sigmoidf_(xg[i]);
        *(LAS u32x4*)(Lg + tok * 136 + 16 * cgp) = pack8(xg);
        xm8_pre(R.c[6], R.p[6], col[6], fs, shift0, *(const LAS f32x4*)(MUs + (6 * 8 + cgp) * 8), *(const LAS f32x4*)(MUs + (6 * 8 + cgp) * 8 + 4), xg);
#pragma unroll
        for (int i = 0; i < 8; ++i) xg[i] = sigmoidf_(xg[i]);
        *(LAS u32x4*)(Lg + tok * 136 + 16 * cgp + 8) = pack8(xg);
    }
    LDS_WAIT();
    const int fr = lane & 15, fq = lane >> 4, arow = fr & 7;
    const bf16* W2T = (const bf16*)(a.ws + WS_W2T); const bf16* A2T = (const bf16*)(a.ws + WS_A2T); const bf16* G2T = (const bf16*)(a.ws + WS_G2T);
    const bf16x8 Aw0 = *(const LAS bf16x8*)(Lw + arow * 72 + 8 * fq), Aw1 = *(const LAS bf16x8*)(Lw + arow * 72 + 32 + 8 * fq);
    const bf16x8 Aa0 = *(const LAS bf16x8*)(La + arow * 72 + 8 * fq), Aa1 = *(const LAS bf16x8*)(La + arow * 72 + 32 + 8 * fq);
    f32x4 accw[4], acca[4];
#pragma unroll
    for (int nt = 0; nt < 4; ++nt) {
        const size_t bo = (size_t)(h * 64 + 16 * nt + fr) * 64 + 8 * fq;
        const bf16x8 bw0 = __builtin_bit_cast(bf16x8, gld16(W2T + bo)), bw1 = __builtin_bit_cast(bf16x8, gld16(W2T + bo + 32));
        const bf16x8 ba0 = __builtin_bit_cast(bf16x8, gld16(A2T + bo)), ba1 = __builtin_bit_cast(bf16x8, gld16(A2T + bo + 32));
        f32x4 z = {0.f, 0.f, 0.f, 0.f};
        accw[nt] = __builtin_amdgcn_mfma_f32_16x16x32_bf16(Aw0, bw0, z, 0, 0, 0); accw[nt] = __builtin_amdgcn_mfma_f32_16x16x32_bf16(Aw1, bw1, accw[nt], 0, 0, 0);
        acca[nt] = __builtin_amdgcn_mfma_f32_16x16x32_bf16(Aa0, ba0, z, 0, 0, 0); acca[nt] = __builtin_amdgcn_mfma_f32_16x16x32_bf16(Aa1, ba1, acca[nt], 0, 0, 0);
    }
    const bool lowh = fq < 2;
    const int ntb = lowh ? 0 : 2, tokb = 4 * (fq & 1);
    f32x4 Wsel[2], Asel[2];
    Wsel[0] = lowh ? accw[0] : accw[2]; Wsel[1] = lowh ? accw[1] : accw[3];
    Asel[0] = lowh ? acca[0] : acca[2]; Asel[1] = lowh ? acca[1] : acca[3];
    float rkp[4] = {0.f, 0.f, 0.f, 0.f};
    float* WD = (float*)(a.ws + WS_WD); bf16* BBp = (bf16*)(a.ws + WS_BB); bf16* KMp = (bf16*)(a.ws + WS_KM);
#pragma unroll
    for (int u = 0; u < 2; ++u) {
        const int c = 16 * (ntb + u) + fr, hc = h * 64 + c;
        const float w0c = a.in[9][hc], a0c = a.in[11][hc], kac = a.in[15][hc], rkc = a.in[16][hc];
#pragma unroll
        for (int e = 0; e < 4; ++e) {
            const int o = (tokb + e) * 64 + c;
            const float sg = sigmoidf_(Wsel[u][e] + w0c);
            const float decay = __expf(-0.6065306597126334f * sg);
            const float av = sigmoidf_(Asel[u][e] + a0c);
            const float kkv = KKs[o], kr = KRs[o], rv = Rs[o];
            const float kmod = kr * (1.0f + (av - 1.0f) * kac);
            Rs[o] = decay; KKs[o] = kkv * av; KRs[o] = kmod;
            rkp[e] += rv * kmod * rkc;
        }
    }
    float* RK = (float*)(a.ws + WS_RK);
#pragma unroll
    for (int e = 0; e < 4; ++e) { rkp[e] = row16_sum(rkp[e]); rkp[e] += __shfl_xor(rkp[e], 32); }
    bf16x8 Ag[4];
#pragma unroll
    for (int ks = 0; ks < 4; ++ks) Ag[ks] = *(const LAS bf16x8*)(Lg + arow * 136 + 32 * ks + 8 * fq);
    bf16* Gb = (bf16*)(a.out + OS_G);
    LDS_WAIT();
    LAS float* Gs = (LAS float*)Lw;
    for (int nt = 0; nt < 4; ++nt) {
        const size_t bo = (size_t)(h * 64 + 16 * nt + fr) * 128 + 8 * fq;
        f32x4 acc = {0.f, 0.f, 0.f, 0.f};
#pragma unroll
        for (int ks = 0; ks < 4; ++ks) acc = __builtin_amdgcn_mfma_f32_16x16x32_bf16(Ag[ks], __builtin_bit_cast(bf16x8, gld16(G2T + bo + 32 * ks)), acc, 0, 0, 0);
        if (lowh) {
#pragma unroll
            for (int e = 0; e < 4; ++e) Gs[(4 * fq + e) * 64 + 16 * nt + fr] = acc[e];
        }
    }
    LDS_WAIT();
    {
        const LAS float* pg = Gs + tok * 64 + 8 * cgp; const f32x4 g0 = *(const LAS f32x4*)pg, g1 = *(const LAS f32x4*)(pg + 4);
        const float gv[8] = {g0.x, g0.y, g0.z, g0.w, g1.x, g1.y, g1.z, g1.w};
        const LAS float* ps = Rs + tok * 64 + 8 * cgp; const f32x4 d0 = *(const LAS f32x4*)ps, d1 = *(const LAS f32x4*)(ps + 4);
        const LAS float* pb = KKs + tok * 64 + 8 * cgp; const f32x4 b0 = *(const LAS f32x4*)pb, b1 = *(const LAS f32x4*)(pb + 4);
        const float bv[8] = {b0.x, b0.y, b0.z, b0.w, b1.x, b1.y, b1.z, b1.w};
        const LAS float* pk = KRs + tok * 64 + 8 * cgp; const f32x4 k0 = *(const LAS f32x4*)pk, k1 = *(const LAS f32x4*)(pk + 4);
        const float kv[8] = {k0.x, k0.y, k0.z, k0.w, k1.x, k1.y, k1.z, k1.w};
        *(GAS u32x4*)((bf16*)(a.ws + WS_RR) + go) = pk_r;
        *(GAS u32x4*)((bf16*)(a.out + OS_V) + go) = pk_v;
        *(GAS u32x4*)((bf16*)(a.ws + WS_KK) + go) = pk_kk;
        *(GAS f32x4*)(WD + go) = d0; *(GAS f32x4*)(WD + go + 4) = d1;
        *(GAS u32x4*)(BBp + go) = pack8(bv);
        *(GAS u32x4*)(KMp + go) = pack8(kv);
        *(GAS u32x4*)(Gb + go) = pack8(gv);
        if (fr == 0 && lowh) {
#pragma unroll
            for (int e = 0; e < 4; ++e) RK[(size_t)(row0 + tokb + e) * 8 + h] = rkp[e];
        }
    }
    LDS_WAIT();
}

struct LdRaw { f32x4 w0, w1; u32x4 kk, b, k, r, v, kkn; };
__device__ __forceinline__ void loader_load(const Args& a, LdRaw& R, int pw, int lane, bool is_sample, int chain, int t0) {
    const int b = chain >> 3, h = chain & 7, tok = lane >> 3, cgp = lane & 7;
    const int row = (is_sample ? TP + b * DSEQ : b * SEQ + t0 + 8 * pw) + tok;
    const size_t go = (size_t)row * 512 + h * 64 + 8 * cgp;
    R.w0 = gldf4((const float*)(a.ws + WS_WD) + go); R.w1 = gldf4((const float*)(a.ws + WS_WD) + go + 4);
    R.kk = gld16((const bf16*)(a.ws + WS_KK) + go); R.b = gld16((const bf16*)(a.ws + WS_BB) + go); R.k = gld16((const bf16*)(a.ws + WS_KM) + go);
    R.r = gld16((const bf16*)(a.ws + WS_RR) + go); R.v = gld16((const bf16*)(a.out + OS_V) + go);
    R.kkn = gld16((const bf16*)(a.ws + WS_KK) + go + 512);
}
__device__ __forceinline__ void st8(LAS float* p, const u32x4 u) {
    float f[8]; unpack8(u, f);
    *(LAS f32x4*)p = (f32x4){f[0], f[1], f[2], f[3]}; *(LAS f32x4*)(p + 4) = (f32x4){f[4], f[5], f[6], f[7]};
}
__device__ __forceinline__ void loader_store(const LdRaw& R, LAS unsigned char* lds, int buf, int pw, int lane) {
    LAS float* B = (LAS float*)(lds + buf * SB_BYTES);
    const int o = (8 * pw + (lane >> 3)) * 64 + 8 * (lane & 7);
    *(LAS f32x4*)(B + SB_W + o) = R.w0; *(LAS f32x4*)(B + SB_W + o + 4) = R.w1;
    st8(B + SB_KK + o, R.kk); st8(B + SB_B + o, R.b); st8(B + SB_K + o, R.k); st8(B + SB_R + o, R.r); st8(B + SB_V + o, R.v);
    float bb[8], kn[8]; unpack8(R.b, bb); unpack8(R.kkn, kn);
    float part = 0.f;
#pragma unroll
    for (int i = 0; i < 8; ++i) part += bb[i] * kn[i];
    part += __shfl_xor(part, 1); part += __shfl_xor(part, 2); part += __shfl_xor(part, 4);
    if ((lane & 7) == 0) B[SB_BETA + 8 * pw + (lane >> 3)] = part;
}

typedef float f32x2 __attribute__((ext_vector_type(2)));
struct StepOps { f32x4 kk, w, b, k, r; float v; };
__device__ __forceinline__ void ld_step(StepOps& o, const LAS float* B, int off, int voff) {
    o.kk = *(const LAS f32x4*)(B + SB_KK + off); o.w = *(const LAS f32x4*)(B + SB_W + off); o.b = *(const LAS f32x4*)(B + SB_B + off);
    o.k = *(const LAS f32x4*)(B + SB_K + off); o.r = *(const LAS f32x4*)(B + SB_R + off); o.v = B[SB_V + voff];
}
__device__ __forceinline__ float wkv_step2(f32x2& Sa, f32x2& Sb, const f32x4 kk, const f32x4 w, const f32x4 b, const f32x4 k, const f32x4 r, const float vv) {
    f32x2 t = Sa * (f32x2){kk.x, kk.y}; t = Sb * (f32x2){kk.z, kk.w} + t;
    const float p = row16_sum(t.x + t.y);
    const float nu = -p;
    Sa = Sa * (f32x2){w.x, w.y} + (f32x2){b.x, b.y} * nu + (f32x2){k.x, k.y} * vv;
    Sb = Sb * (f32x2){w.z, w.w} + (f32x2){b.z, b.w} * nu + (f32x2){k.z, k.w} * vv;
    f32x2 u = Sa * (f32x2){r.x, r.y}; u = Sb * (f32x2){r.z, r.w} + u;
    return row16_sum(u.x + u.y);
}
__device__ __forceinline__ float wkv_step(f32x4& S, const f32x4 kk, const f32x4 w, const f32x4 b, const f32x4 k, const f32x4 r, const float vv) {
    f32x2 Sa = {S.x, S.y}, Sb = {S.z, S.w};
    const float y = wkv_step2(Sa, Sb, kk, w, b, k, r, vv);
    S = (f32x4){Sa.x, Sa.y, Sb.x, Sb.y};
    return y;
}

__device__ __forceinline__ void p2_scan(const Args& a, LAS unsigned char* lds, int G, int vcu, int wave, int lane) {
    const int nPI = (vcu < 256) ? (256 - vcu + G - 1) / G : 0;
    const int nSG = nPI;
    const int NT = nPI * 64 + nSG;
    const bool scanw = wave < 4;
    const int sw = wave & 3;
    const int jj = lane & 15, lr = 4 * sw + (lane >> 4);
    float* Yraw = a.out + OS_YRAW;
    f32x4 S = {0.f, 0.f, 0.f, 0.f};
#define TASK_DECODE(j, is_sample, item, chunk) const bool is_sample = (j) >= nPI * 64; const int item = is_sample ? vcu + ((j) - nPI * 64) * G : vcu + ((j) >> 6) * G; const int chunk = (j) & 63;
    LdRaw R;
    R.w0 = R.w1 = (f32x4){0.f, 0.f, 0.f, 0.f}; R.kk = R.b = R.k = R.r = R.v = R.kkn = (u32x4){0u, 0u, 0u, 0u};
    if (!scanw && NT > 0) {
        { TASK_DECODE(0, smp, item, chunk); loader_load(a, R, sw, lane, smp, smp ? 4 * item + sw : (item >> 2), chunk * 32); loader_store(R, lds, 0, sw, lane); }
        if (NT > 1) { TASK_DECODE(1, smp, item, chunk); loader_load(a, R, sw, lane, smp, smp ? 4 * item + sw : (item >> 2), chunk * 32); }
    }
    LDS_WAIT(); __builtin_amdgcn_s_barrier(); asm volatile("" ::: "memory");
    for (int j = 0; j < NT; ++j) {
        const bool smp_task = j >= nPI * 64;
        if (scanw || smp_task) {
            TASK_DECODE(j, smp, item, chunk);
            const LAS float* B = (const LAS float*)(lds + (j & 1) * SB_BYTES);
            if (!smp) {
                const int chain = item >> 2, q = item & 3, b = chain >> 3, h = chain & 7;
                if (chunk == 0) S = (f32x4){0.f, 0.f, 0.f, 0.f};
                const int rowb = b * SEQ + chunk * 32;
                const int vrow = 16 * q + lr;
                f32x2 Sa = {S.x, S.y}, Sb = {S.z, S.w};
                StepOps c0, c1, c2;
                ld_step(c0, B, 4 * jj, vrow); ld_step(c1, B, 64 + 4 * jj, 64 + vrow);
                float p;
                { f32x2 t = Sa * (f32x2){c0.kk.x, c0.kk.y}; t = Sb * (f32x2){c0.kk.z, c0.kk.w} + t; p = row16_sum(t.x + t.y); }
                for (int blk = 0; blk < 2; ++blk) {
                    float ykeep = 0.f;
#pragma unroll
                    for (int s2 = 0; s2 < 16; ++s2) {
                        const int sc_ = blk * 16 + s2;
                        const int sn = (sc_ + 2) & 31;
                        ld_step(c2, B, sn * 64 + 4 * jj, sn * 64 + vrow);
                        const float beta = B[SB_BETA + sc_];
                        const f32x2 Aa = Sa * (f32x2){c0.w.x, c0.w.y} + (f32x2){c0.k.x, c0.k.y} * c0.v;
                        const f32x2 Ab = Sb * (f32x2){c0.w.z, c0.w.w} + (f32x2){c0.k.z, c0.k.w} * c0.v;
                        f32x2 tq = Aa * (f32x2){c1.kk.x, c1.kk.y}; tq = Ab * (f32x2){c1.kk.z, c1.kk.w} + tq;
                        const float q = row16_sum(tq.x + tq.y);
                        const float np = -p;
                        Sa = Aa + (f32x2){c0.b.x, c0.b.y} * np; Sb = Ab + (f32x2){c0.b.z, c0.b.w} * np;
                        f32x2 u = Sa * (f32x2){c0.r.x, c0.r.y}; u = Sb * (f32x2){c0.r.z, c0.r.w} + u;
                        const float y = row16_sum(u.x + u.y);
                        ykeep = (s2 == jj) ? y : ykeep;
                        p = q + np * beta;
                        c0 = c1; c1 = c2;
                    }
                    Yraw[(size_t)(rowb + blk * 16 + jj) * 512 + h * 64 + vrow] = ykeep;
                }
                S = (f32x4){Sa.x, Sa.y, Sb.x, Sb.y};
                if (chunk == 63) *(GAS f32x4*)(a.out + O_WKVP + ((size_t)(chain * 64 + vrow)) * 64 + 4 * jj) = S;
            } else {
                for (int cs = scanw ? 0 : 2; cs < (scanw ? 2 : 4); ++cs) {
                    const int chain = 4 * item + cs, b = chain >> 3, h = chain & 7;
                    const float* st = a.in[4] + (size_t)chain * 4096;
                    f32x4 Sq[4]; float yk[4] = {0.f, 0.f, 0.f, 0.f};
#pragma unroll
                    for (int qq = 0; qq < 4; ++qq) Sq[qq] = gldf4(st + (16 * qq + lr) * 64 + 4 * jj);
#pragma unroll
                    for (int t = 0; t < 8; ++t) {
                        const int s = 8 * cs + t;
                        const f32x4 kk = *(const LAS f32x4*)(B + SB_KK + s * 64 + 4 * jj), w = *(const LAS f32x4*)(B + SB_W + s * 64 + 4 * jj), bb = *(const LAS f32x4*)(B + SB_B + s * 64 + 4 * jj);
                        const f32x4 k = *(const LAS f32x4*)(B + SB_K + s * 64 + 4 * jj), r = *(const LAS f32x4*)(B + SB_R + s * 64 + 4 * jj);
#pragma unroll
                        for (int qq = 0; qq < 4; ++qq) {
                            const float vv = B[SB_V + s * 64 + 16 * qq + lr];
                            const float y = wkv_step(Sq[qq], kk, w, bb, k, r, vv);
                            yk[qq] = (t == jj) ? y : yk[qq];
                        }
                    }
#pragma unroll
                    for (int qq = 0; qq < 4; ++qq) {
                        if (jj < 8) Yraw[(size_t)(TP + b * DSEQ + jj) * 512 + h * 64 + 16 * qq + lr] = yk[qq];
                        *(GAS f32x4*)(a.out + O_WKVS + ((size_t)(chain * 64 + 16 * qq + lr)) * 64 + 4 * jj) = Sq[qq];
                    }
                }
            }
        }
        if (!scanw && j + 1 < NT) {
            loader_store(R, lds, (j + 1) & 1, sw, lane);
            if (j + 2 < NT) { TASK_DECODE(j + 2, smp, item, chunk); loader_load(a, R, sw, lane, smp, smp ? 4 * item + sw : (item >> 2), chunk * 32); }
        }
        LDS_WAIT(); __builtin_amdgcn_s_barrier(); asm volatile("" ::: "memory");
    }
#undef TASK_DECODE
}

struct MixConst { f32x4 w[6]; f32x4 l[4]; };
struct MixRaw { u32x4 cb, cc0, cx0, cc1, cx1, cc2, cx2, g, v; f32x4 y0, y1; float rk; };
__device__ __forceinline__ void p3_load(const Args& a, MixRaw& R, int row, int lane) {
    const bool smp = row >= TP;
    const int t = smp ? ((row - TP) & 7) : (row & 2047);
    const bf16* pr = (const bf16*)(a.ws + WS_PROJ) + (size_t)row * IC;
    const int c8 = 8 * lane;
    const u32x4 z = {0u, 0u, 0u, 0u};
    R.cb = gld16(pr + c8); R.cc0 = gld16(pr + 512 + c8); R.cx0 = gld16(pr + 1024 + c8);
    R.cc1 = z; R.cx1 = z; R.cc2 = z; R.cx2 = z;
    if (t >= 1) { R.cc1 = gld16(pr - IC + 512 + c8); R.cx1 = gld16(pr - IC + 1024 + c8); }
    if (t >= 2) { R.cc2 = gld16(pr - 2 * IC + 512 + c8); R.cx2 = gld16(pr - 2 * IC + 1024 + c8); }
    const float* yr = a.out + OS_YRAW + (size_t)row * 512 + c8;
    R.y0 = gldf4(yr); R.y1 = gldf4(yr + 4);
    R.v = gld16((const bf16*)(a.out + OS_V) + (size_t)row * 512 + c8);
    R.g = gld16((const bf16*)(a.out + OS_G) + (size_t)row * 512 + c8);
    R.rk = ((const float*)(a.ws + WS_RK))[(size_t)row * 8 + (lane >> 3)];
}
__device__ __forceinline__ void p3_token(const Args& a, const MixConst& K, const MixRaw& R, int row, int lane) {
    const bool smp = row >= TP;
    const int rr = row - TP;
    const int b = smp ? (rr >> 3) : (row >> 11), t = smp ? (rr & 7) : (row & 2047), L = smp ? DSEQ : SEQ;
    const bf16* pr = (const bf16*)(a.ws + WS_PROJ) + (size_t)row * IC;
    const int c8 = 8 * lane;
    float yconv[8], yrw[8];
    {
        float cb[8], cc[8], cx[8], u0[8], f1[8], f2[8];
        unpack8(R.cb, cb); unpack8(R.cc0, cc); unpack8(R.cx0, cx);
#pragma unroll
        for (int i = 0; i < 8; ++i) u0[i] = cc[i] * cx[i];
        unpack8(R.cc1, cc); unpack8(R.cx1, cx);
#pragma unroll
        for (int i = 0; i < 8; ++i) f1[i] = cc[i] * cx[i];
        unpack8(R.cc2, cc); unpack8(R.cx2, cx);
#pragma unroll
        for (int i = 0; i < 8; ++i) f2[i] = cc[i] * cx[i];
        if (smp && t < 2) {
            const float* sc = a.in[2] + (size_t)b * 1024;
            if (t == 0) { const f32x4 s0 = gldf4(sc + 512 + c8), s1 = gldf4(sc + 512 + c8 + 4); f1[0] = s0.x; f1[1] = s0.y; f1[2] = s0.z; f1[3] = s0.w; f1[4] = s1.x; f1[5] = s1.y; f1[6] = s1.z; f1[7] = s1.w; }
            const float* sp = sc + (t == 1 ? 512 : 0) + c8; const f32x4 s0 = gldf4(sp), s1 = gldf4(sp + 4);
            f2[0] = s0.x; f2[1] = s0.y; f2[2] = s0.z; f2[3] = s0.w; f2[4] = s1.x; f2[5] = s1.y; f2[6] = s1.z; f2[7] = s1.w;
        }
        const f32x4 w00 = K.w[0], w01 = K.w[1], w10 = K.w[2], w11 = K.w[3], w20 = K.w[4], w21 = K.w[5];
        const float W0[8] = {w00.x, w00.y, w00.z, w00.w, w01.x, w01.y, w01.z, w01.w}, W1[8] = {w10.x, w10.y, w10.z, w10.w, w11.x, w11.y, w11.z, w11.w}, W2[8] = {w20.x, w20.y, w20.z, w20.w, w21.x, w21.y, w21.z, w21.w};
#pragma unroll
        for (int i = 0; i < 8; ++i) yconv[i] = cb[i] * (f2[i] * W0[i] + f1[i] * W1[i] + u0[i] * W2[i]);
        if (t >= L - 2) {
            float* oc = a.out + (smp ? O_CONVS : O_CONVP) + (size_t)b * 1024 + (t == L - 1 ? 512 : 0) + c8;
            *(GAS f32x4*)oc = (f32x4){u0[0], u0[1], u0[2], u0[3]}; *(GAS f32x4*)(oc + 4) = (f32x4){u0[4], u0[5], u0[6], u0[7]};
        }
    }
    {
        const f32x4 y0 = R.y0, y1 = R.y1;
        float y[8] = {y0.x, y0.y, y0.z, y0.w, y1.x, y1.y, y1.z, y1.w};
        float s = 0.f;
#pragma unroll
        for (int i = 0; i < 8; ++i) s += y[i];
        s += __shfl_xor(s, 1); s += __shfl_xor(s, 2); s += __shfl_xor(s, 4);
        const float mean = s * (1.f / 64.f);
        float qv = 0.f;
#pragma unroll
        for (int i = 0; i < 8; ++i) { y[i] -= mean; qv += y[i] * y[i]; }
        qv += __shfl_xor(qv, 1); qv += __shfl_xor(qv, 2); qv += __shfl_xor(qv, 4);
        const float rs = 1.0f / sqrtf(qv * (1.f / 64.f) + 64e-5f);
        float xv[8], g[8];
        unpack8(R.v, xv); unpack8(R.g, g);
        const float rk = R.rk;
        const f32x4 l0 = K.l[0], l1 = K.l[1], b0 = K.l[2], b1 = K.l[3];
        const float lg[8] = {l0.x, l0.y, l0.z, l0.w, l1.x, l1.y, l1.z, l1.w}, lb[8] = {b0.x, b0.y, b0.z, b0.w, b1.x, b1.y, b1.z, b1.w};
#pragma unroll
        for (int i = 0; i < 8; ++i) yrw[i] = (y[i] * rs * lg[i] + lb[i] + rk * xv[i]) * g[i];
    }
    bf16* ym = (bf16*)(a.ws + WS_XN) + (size_t)row * 1024;
    *(GAS u32x4*)(ym + c8) = pack8(yconv);
    *(GAS u32x4*)(ym + 512 + c8) = pack8(yrw);
    if (t == L - 1) {
        float* os = a.out + (smp ? O_SHIFTS : O_SHIFTP) + (size_t)b * RWC;
#pragma unroll
        for (int i = 0; i < 7; ++i) { const int c = i * 256 + 4 * lane; const u32x2 u = *(const GAS u32x2*)(pr + PRW + c);
            *(GAS f32x4*)(os + c) = (f32x4){bflo(u.x), bfhi(u.x), bflo(u.y), bfhi(u.y)}; }
    }
}

#define XB_TMO      128
#define XB_XCNT(j)  (256  + 64 * (j))
#define XB_XSUB(j)  (1280 + 64 * (j))
#define XB_XGEN(j)  (2304 + 64 * (j))
#define XB_TOP      3328
#define XB_TOPGEN   3392
#define XCD_BAR_WORDS 3456
#define XB_SPIN_CAP (1u << 18)

__device__ __forceinline__ unsigned xb_ld(unsigned* p)              { return __hip_atomic_load(p, __ATOMIC_RELAXED, __HIP_MEMORY_SCOPE_AGENT); }
__device__ __forceinline__ unsigned xb_add(unsigned* p, unsigned v) { return __hip_atomic_fetch_add(p, v, __ATOMIC_RELAXED, __HIP_MEMORY_SCOPE_AGENT); }
__device__ __forceinline__ unsigned xb_xcc_id() { return (unsigned)__builtin_amdgcn_s_getreg((3 << 11) | 20) & 0xFu; }
#define XB_SPIN(cond, bar) do { unsigned _sp = 0; while (cond) { __builtin_amdgcn_s_sleep(1); \
    if ((++_sp & 255u) == 0u) { if (xb_ld(&(bar)[XB_TMO])) break; if (_sp > XB_SPIN_CAP) { atomicAdd(&(bar)[XB_TMO], 1u); break; } } } } while (0)

struct XcdBarrier {
    unsigned* bar; unsigned x;
    volatile LAS unsigned* st;
};

__device__ __forceinline__ XcdBarrier xcd_barrier_post(unsigned* bar, volatile LAS unsigned* st) {
    XcdBarrier b; b.bar = bar; b.x = xb_xcc_id(); b.st = st;
    if (threadIdx.x == 0) (void)xb_add(&bar[XB_XCNT(b.x)], 1u);
    return b;
}
__device__ __forceinline__ void xcd_barrier_complete(unsigned* bar, unsigned x, unsigned& nloc, unsigned& nx) {
    const unsigned G = gridDim.x * gridDim.y * gridDim.z;
    unsigned sum, cnt, mine, sp = 0u;
    for (;;) {
        sum = 0u; cnt = 0u; mine = 0u;
#pragma unroll
        for (unsigned j = 0; j < 16; ++j) { const unsigned c = xb_ld(&bar[XB_XCNT(j)]); sum += c; cnt += (c > 0u) ? 1u : 0u; mine = (j == x) ? c : mine; }
        if (sum == G) break;
        __builtin_amdgcn_s_sleep(1);
        if ((++sp & 255u) == 0u) { if (xb_ld(&bar[XB_TMO])) break; if (sp > XB_SPIN_CAP) { atomicAdd(&bar[XB_TMO], 1u); break; } }
    }
    nloc = mine > 0u ? mine : 1u; nx = cnt > 0u ? cnt : 1u;
}

__device__ __forceinline__ void xcd_barrier(const XcdBarrier& b) {
    asm volatile("s_waitcnt vmcnt(0)" ::: "memory");
    __syncthreads();
    if (threadIdx.x == 0) {
        unsigned* bar = b.bar;
        __builtin_amdgcn_s_waitcnt(0);
        unsigned nloc = b.st[0], nx = b.st[1];
        if (nloc == 0u) { xcd_barrier_complete(bar, b.x, nloc, nx); b.st[0] = nloc; b.st[1] = nx; }
        const unsigned old = xb_add(&bar[XB_XSUB(b.x)], 1u);
        const unsigned gen = old / nloc;
        if (old + 1u == (gen + 1u) * nloc) {
            __builtin_amdgcn_fence(__ATOMIC_RELEASE, "agent");
            asm volatile("s_waitcnt vmcnt(0)" ::: "memory");
            const unsigned og = xb_add(&bar[XB_TOP], 1u);
            const unsigned tg = og / nx;
            if (og + 1u == (tg + 1u) * nx) xb_add(&bar[XB_TOPGEN], 1u);
            else XB_SPIN(xb_ld(&bar[XB_TOPGEN]) == tg, bar);
            __builtin_amdgcn_fence(__ATOMIC_ACQUIRE, "agent");
            xb_add(&bar[XB_XGEN(b.x)], 1u);
            asm volatile("s_waitcnt vmcnt(0)" ::: "memory");
        } else {
            XB_SPIN(xb_ld(&bar[XB_XGEN(b.x)]) == gen, bar);
            __builtin_amdgcn_fence(__ATOMIC_ACQUIRE, "agent");
            asm volatile("s_waitcnt vmcnt(0)" ::: "memory");
        }
    }
    __syncthreads();
}

__global__ void __launch_bounds__(512, 2) fwd_kernel(Args a) {
    extern __shared__ __attribute__((aligned(16))) unsigned char lds_raw[];
    LAS unsigned char* lds = (LAS unsigned char*)lds_raw;
    cg::grid_group grid = cg::this_grid();
    const int tid = threadIdx.x, lane = tid & 63, wave = __builtin_amdgcn_readfirstlane(tid >> 6);
    const int G = gridDim.x, bx = blockIdx.x;
    const int vcu = (G % 8 == 0) ? (bx % 8) * (G / 8) + bx / 8 : bx;
    const int gw = vcu * 8 + wave, NGW = G * 8;
    const int lo = a.ph_lo, hi = a.ph_hi;
#define IN(k) (lo <= (k) && (k) < hi)
    volatile LAS unsigned* barst = (volatile LAS unsigned*)(lds + LDS_BARST);
    if (tid == 0) { barst[0] = 0u; barst[1] = 0u; }
    __syncthreads();
    const XcdBarrier bar = xcd_barrier_post((unsigned*)(a.ws + WS_BAR) + a.li * XCD_BAR_WORDS, barst);
    if (a.ph_lo < 0) grid.sync();
#define SEAM(k) do { if (IN(k) && IN((k) + 1)) xcd_barrier(bar); } while (0)
    unsigned char* ws = a.ws;
    bf16* WT_IN = (bf16*)(ws + WS_WIN); bf16* WT_OUT = (bf16*)(ws + WS_WOUT); bf16* WT_FF1 = (bf16*)(ws + WS_WFF1); bf16* WT_FF2 = (bf16*)(ws + WS_WFF2);
    bf16* XN = (bf16*)(ws + WS_XN); bf16* XG = (bf16*)(ws + WS_XG); bf16* PROJ = (bf16*)(ws + WS_PROJ); bf16* HB = (bf16*)(ws + WS_H);
    float* SS1 = (float*)(ws + WS_SS1); float* SS2 = (float*)(ws + WS_SS2);

    if (IN(0)) {
        LAS float* scr = (LAS float*)(lds + wave * 16384);
        constexpr int I_IN = 16 * (IC / 32), I_OUT = 16 * 32, I_F1 = 16 * (FFD / 32), I_F2 = 64 * 32, I_W2 = 16, I_A2 = 16, I_G2 = 2 * 16;
        constexpr int NITEMS = I_IN + I_W2 + I_A2 + I_G2;
        for (int it = gw; it < NITEMS; it += NGW) {
            int r = it;
            if (r < I_IN) { p0_transpose_item(a.in[6], DM, IC, WT_IN, scr, r, lane); continue; } r -= I_IN;
            if (r < I_W2) { p0_transpose_item(a.in[10], 64, 512, (bf16*)(ws + WS_W2T), scr, r, lane); continue; } r -= I_W2;
            if (r < I_A2) { p0_transpose_item(a.in[12], 64, 512, (bf16*)(ws + WS_A2T), scr, r, lane); continue; } r -= I_A2;
            p0_transpose_item(a.in[13], 128, 512, (bf16*)(ws + WS_G2T), scr, r, lane);
        }
        {
            const GAS f32x4* gr = (const GAS f32x4*)a.in[5] + lane;
            const f32x4 g0 = gr[0], g1 = gr[64], g2 = gr[128], g3 = gr[192];
            for (int m0 = gw; m0 < TT; m0 += 4 * NGW) {
                f32x4 v[4][4];
#pragma unroll
                for (int k = 0; k < 4; ++k) { const int m = m0 + k * NGW;
                    if (m < TT) { const float* xrow = (m < TP) ? a.in[0] + (size_t)m * DM : a.in[1] + (size_t)(m - TP) * DM; const GAS f32x4* xr = (const GAS f32x4*)xrow + lane;
                        v[k][0] = xr[0]; v[k][1] = xr[64]; v[k][2] = xr[128]; v[k][3] = xr[192]; }
                    else { v[k][0] = v[k][1] = v[k][2] = v[k][3] = (f32x4){0.f, 0.f, 0.f, 0.f}; } }
#pragma unroll
                for (int k = 0; k < 4; ++k) { const int m = m0 + k * NGW;
                    float s2 = 0.f;
#pragma unroll
                    for (int j = 0; j < 4; ++j) s2 += (v[k][j].x * v[k][j].x + v[k][j].y * v[k][j].y) + (v[k][j].z * v[k][j].z + v[k][j].w * v[k][j].w);
                    const float rstd = 1.0f / sqrtf(wave_sum(s2) * (1.f / DM) + 1e-6f);
                    if (m < TT) { GAS u32x2* o8 = (GAS u32x2*)(XN + (size_t)m * DM) + lane;
                        u32x2 w; w.x = pk2(v[k][0].x * rstd * g0.x, v[k][0].y * rstd * g0.y); w.y = pk2(v[k][0].z * rstd * g0.z, v[k][0].w * rstd * g0.w); o8[0] = w;
                        w.x = pk2(v[k][1].x * rstd * g1.x, v[k][1].y * rstd * g1.y); w.y = pk2(v[k][1].z * rstd * g1.z, v[k][1].w * rstd * g1.w); o8[64] = w;
                        w.x = pk2(v[k][2].x * rstd * g2.x, v[k][2].y * rstd * g2.y); w.y = pk2(v[k][2].z * rstd * g2.z, v[k][2].w * rstd * g2.w); o8[128] = w;
                        w.x = pk2(v[k][3].x * rstd * g3.x, v[k][3].y * rstd * g3.y); w.y = pk2(v[k][3].z * rstd * g3.z, v[k][3].w * rstd * g3.w); o8[192] = w; }
                }
            }
        }
    }
    SEAM(0);
    if (IN(1)) {
        pg8::Gemm g{XN, WT_IN, TT, IC, DM}; pg8::StaticOrder S; S.init(TT, IC, G, bx);
        pg8::EpiStore<0> E{PROJ, IC};
        pg8::gemm_phase<pg8::EpiStore<0>, pg8::StaticOrder, true, true>(lds, g, S, E);
        {
            const int ntile = (TT / 256) * (IC / 256), full = ntile / G, nbusy = ntile - full * G;
            if (bx >= nbusy) {
                constexpr int I_OUT = 16 * 32, I_F1 = 16 * (FFD / 32), I_F2 = 64 * 32;
                LAS float* scr = (LAS float*)(lds + wave * 16384);
                for (int it = (bx - nbusy) * 8 + wave; it < I_OUT + I_F1 + I_F2; it += (G - nbusy) * 8) {
                    int r = it;
                    if (r < I_OUT) { p0_transpose_item(a.in[19], DM, DM, WT_OUT, scr, r, lane); continue; } r -= I_OUT;
                    if (r < I_F1) { p0_transpose_item(a.in[21], DM, FFD, WT_FF1, scr, r, lane); continue; } r -= I_F1;
                    p0_transpose_item(a.in[22], FFD, DM, WT_FF2, scr, r, lane);
                }
            }
        }
    }
    SEAM(1);
    if (IN(2)) {
        LAS unsigned char* scr = lds + wave * PREP_SCR;
        PrepConst C; C.unused = 0;
        {
            const int h = gw & 7, cgp = lane & 7;
            int col[7]; prep_cols(h, cgp, col);
            LAS float* MUw = (LAS float*)(scr + PREP_MU);
#pragma unroll
            for (int i = 0; i < 7; ++i) { *(LAS f32x4*)(MUw + (i * 8 + cgp) * 8) = gldf4(a.in[8] + col[i]); *(LAS f32x4*)(MUw + (i * 8 + cgp) * 8 + 4) = gldf4(a.in[8] + col[i] + 4); }
            LDS_WAIT();
        }
        PrepRaw R, Rn;
        int it = gw;
        if (it < TT) prep_load(a, R, lane, (it >> 3) * 8, it & 7);
        while (it < TT) {
            const int nit = it + NGW;
            if (nit < TT) prep_load(a, Rn, lane, (nit >> 3) * 8, nit & 7);
            prep_item(a, C, R, scr, lane, (it >> 3) * 8, it & 7);
            R = Rn; it = nit;
        }
    }
    SEAM(2);
    if (IN(3)) p2_scan(a, lds, G, vcu, wave, lane);
    SEAM(3);
    if (IN(4)) {
        MixConst K; { const int c8 = 8 * lane; const float* cw = a.in[7];
            K.w[0] = gldf4(cw + c8); K.w[1] = gldf4(cw + c8 + 4); K.w[2] = gldf4(cw + 512 + c8); K.w[3] = gldf4(cw + 512 + c8 + 4); K.w[4] = gldf4(cw + 1024 + c8); K.w[5] = gldf4(cw + 1024 + c8 + 4);
            K.l[0] = gldf4(a.in[17] + c8); K.l[1] = gldf4(a.in[17] + c8 + 4); K.l[2] = gldf4(a.in[18] + c8); K.l[3] = gldf4(a.in[18] + c8 + 4); }
        MixRaw R, Rn;
        int m = gw;
        if (m < TT) p3_load(a, R, m, lane);
        while (m < TT) {
            const int mn = m + NGW;
            if (mn < TT) p3_load(a, Rn, mn, lane);
            p3_token(a, K, R, m, lane);
            R = Rn; m = mn;
        }
    }
    SEAM(4);
    if (IN(5)) {
        unsigned* ocnt = (unsigned*)(ws + WS_BAR) + 30000;
        if (G == 256) {
            { pg8::Gemm g{XN, WT_OUT, TT, DM, DM}; pg8::OutOrder S{G, bx, ocnt};
              pg8::EpiRes<0> E{a.in[0], a.in[1], a.out, XG, a.in[20], nullptr, SS1};
              pg8::gemm_phase<pg8::EpiRes<0>, pg8::OutOrder, true, true>(lds, g, S, E); }
            {
              pg8::Gemm g{XG, WT_FF1, TT, FFD, DM}; pg8::SampleFF1Order S{G, bx, ocnt, 16u * 8u};
              pg8::EpiStore<1> E{HB, FFD};
              pg8::gemm_phase<pg8::EpiStore<1>, pg8::SampleFF1Order, true, true>(lds, g, S, E); }
        } else {
            pg8::Gemm g{XN, WT_OUT, TT, DM, DM}; pg8::StaticOrder S; S.init(TT, DM, G, bx);
            pg8::EpiRes<0> E{a.in[0], a.in[1], a.out, XG, a.in[20], nullptr, SS1};
            pg8::gemm_phase<pg8::EpiRes<0>, pg8::StaticOrder, true, true>(lds, g, S, E);
        }
    }
    SEAM(5);
    if (IN(6)) {
        const int mrows = (G == 256) ? TP : TT;
        pg8::Gemm g{XG, WT_FF1, mrows, FFD, DM}; pg8::StaticOrder S; S.init(mrows, FFD, G, bx);
        pg8::EpiStore<1> E{HB, FFD};
        pg8::gemm_phase<pg8::EpiStore<1>, pg8::StaticOrder, true, true>(lds, g, S, E);
    }
    SEAM(6);
    if (IN(7)) {
        {
            pg8::Gemm g{HB, WT_FF2, TP, DM, FFD, 0}; pg8::StaticOrder S; S.init(TP, DM, G, bx);
            if (G == 256) {
                pg8::EpiResNorm E{a.out, SS1, a.in[23], (float*)(ws + WS_XSTAT), (unsigned*)(ws + WS_BAR) + 20000};
                pg8::gemm_phase<pg8::EpiResNorm, pg8::StaticOrder, false, true>(lds, g, S, E);
            } else {
                pg8::EpiRes<1> E{nullptr, nullptr, a.out, nullptr, nullptr, SS1, SS2};
                pg8::gemm_phase<pg8::EpiRes<1>, pg8::StaticOrder, true, true>(lds, g, S, E);
            }
        }
        {
            pg8::Gemm g{HB, WT_FF2, TT, DM, 512, FFD}; pg8::SplitOrder S{G, bx};
            pg8::EpiPart E{(float*)(ws + WS_PART)};
            pg8::gemm_phase<pg8::EpiPart, pg8::SplitOrder, true, true>(lds, g, S, E);
        }
    }
    SEAM(7);
    if (IN(8)) {
        for (int m = gw; m < TT; m += NGW) {
            GAS f32x4* xr = (GAS f32x4*)(a.out + (size_t)m * DM) + lane; const GAS f32x4* gr = (const GAS f32x4*)a.in[23] + lane;
            if (m < TP) {
                if (G == 256) continue;
                float s = (lane < 16) ? SS2[(size_t)m * 16 + lane] : 0.f;
                const float rstd = 1.0f / sqrtf(wave_sum(s) * (1.f / DM) + 1e-6f);
#pragma unroll
                for (int j = 0; j < 4; ++j) { const f32x4 v = xr[64 * j], gg = gr[64 * j]; xr[64 * j] = v * rstd * gg; }
            } else {
                float s1 = (lane < 16) ? SS1[(size_t)m * 16 + lane] : 0.f;
                const float sc = 1.0f / (wave_sum(s1) * (1.f / DM) + 1e-6f);
                const GAS f32x4* pr = (const GAS f32x4*)((const float*)(ws + WS_PART) + (size_t)(m - TP) * 1024) + lane;
                f32x4 x2[4]; float s2 = 0.f;
#pragma unroll
                for (int j = 0; j < 4; ++j) {
                    f32x4 acc = pr[64 * j];
#pragma unroll
                    for (int kc = 1; kc < 8; ++kc) acc = acc + pr[(size_t)kc * (1024 * 1024 / 4) + 64 * j];
                    x2[j] = xr[64 * j] + acc * sc;
                    s2 += (x2[j].x * x2[j].x + x2[j].y * x2[j].y) + (x2[j].z * x2[j].z + x2[j].w * x2[j].w);
                }
                const float rstd = 1.0f / sqrtf(wave_sum(s2) * (1.f / DM) + 1e-6f);
#pragma unroll
                for (int j = 0; j < 4; ++j) xr[64 * j] = x2[j] * rstd * gr[64 * j];
            }
        }
    }
#undef IN
#undef SEAM
}

extern "C" void kernel_launch(void* const* d_in, const int* in_sizes, int n_in, void* d_out, int out_size, void* d_ws, size_t ws_size, hipStream_t stream) {
    static int grid = 0;
    if (grid == 0) {
        int dev = 0, cus = 0, per_cu = 0;
        (void)hipGetDevice(&dev);
        (void)hipDeviceGetAttribute(&cus, hipDeviceAttributeMultiprocessorCount, dev);
        if (hipFuncSetAttribute((const void*)fwd_kernel, hipFuncAttributeMaxDynamicSharedMemorySize, LDS_BYTES) != hipSuccess) fprintf(stderr, "hipFuncSetAttribute failed\n");
        if (hipOccupancyMaxActiveBlocksPerMultiprocessor(&per_cu, (const void*)fwd_kernel, 512, LDS_BYTES) != hipSuccess || per_cu < 1) { fprintf(stderr, "occupancy query: %d\n", per_cu); per_cu = 1; }
        (void)hipGetLastError();
        grid = cus * 1;
        if (n_in != 24 || ws_size < WS_END) fprintf(stderr, "unexpected n_in %d ws %zu\n", n_in, ws_size);
    }
    Args a{};
    for (int i = 0; i < 24; ++i) a.in[i] = (const float*)d_in[i];
    a.out = (float*)d_out; a.ws = (unsigned char*)d_ws;
#ifndef PROBE_SEQ
#define PROBE_SEQ {0, 9}
#endif
    static const int seq[] = PROBE_SEQ;
    (void)hipMemsetAsync((unsigned char*)d_ws + WS_BAR, 0, BAR_ZERO_BYTES, stream);
    for (unsigned i = 0; i + 1 < sizeof(seq) / sizeof(seq[0]); i += 2) {
        a.ph_lo = seq[i]; a.ph_hi = seq[i + 1]; a.li = (int)(i / 2);
        void* args[] = {&a};
        hipError_t e = hipLaunchCooperativeKernel((const void*)fwd_kernel, dim3(grid), dim3(512), args, LDS_BYTES, stream);
        if (e != hipSuccess) fprintf(stderr, "cooperative launch failed: %s (grid %d)\n", hipGetErrorString(e), grid);
    }
}
```

```cpp
#include <hip/hip_runtime.h>
#include <hip/hip_cooperative_groups.h>
#include <cstdio>
#include <cstdint>
namespace cg = cooperative_groups;
namespace pg8 {
#define PG8_LAS __attribute__((address_space(3)))
typedef unsigned short bf16_t;
typedef short bf16x8 __attribute__((ext_vector_type(8)));
typedef float f32x4 __attribute__((ext_vector_type(4)));
typedef unsigned u32x4 __attribute__((ext_vector_type(4)));
constexpr int BM = 256, BK = 64, HALF = 128, HTB = HALF * BK * 2  , STAGE_BYTES = 8 * HTB, NXCD = 8, WGM = 8;

__host__ __device__ __forceinline__ int lds_byte(int r, int c) { const int st = (r >> 4) * 2 + (c >> 5), rr = r & 15, cc = c & 31, ob = rr * 64 + cc * 2; return st * 1024 + (ob ^ (((ob >> 9) & 1) << 5)); }
__host__ __device__ __forceinline__ void stage_rc(int b, int& R, int& C) { const int st = b / 1024, sb = b % 1024, swz = sb ^ (((sb >> 9) & 1) << 5); R = (st >> 1) * 16 + swz / 64; C = (st & 1) * 32 + (swz % 64) / 2; }
__host__ __device__ __forceinline__ int perm32(int rho) { const int n = rho >> 4, i = rho & 15; return 8 * (i >> 2) + 4 * n + (i & 3); }

struct Unit { int pm, pn, ko; };
struct Gemm { const bf16_t* A; const bf16_t* Bt; int M, N, K, ld; };

struct StaticOrder {
    int nM, nN, nwg, G, c;
    __host__ __device__ void init(int M, int N, int G_, int c_) { nM = M / BM; nN = N / BM; nwg = nM * nN; G = G_; c = c_; }
    __host__ __device__ bool next(int i, Unit& u) const {
        const long L = (long)i * G + c; if (L >= nwg) return false;
        int wgid = (int)L; { const int q = nwg / NXCD, r = nwg % NXCD, xcd = wgid % NXCD, off = wgid / NXCD; wgid = (xcd < r ? xcd * (q + 1) : r * (q + 1) + (xcd - r) * q) + off; }
        const int nig = WGM * nN, gid = wgid / nig, fm = gid * WGM, gsz = (nM - fm) < WGM ? (nM - fm) : WGM;
        u.pm = fm + ((wgid % nig) % gsz); u.pn = (wgid % nig) / gsz; u.ko = 0; return true;
    }
    __device__ __forceinline__ void a_ready(const Unit&) const {}
    __device__ __forceinline__ void done(const Unit&) const {}
};

__device__ __forceinline__ unsigned cvt_pk_bf16(float lo, float hi) { unsigned r; asm volatile("v_cvt_pk_bf16_f32 %0, %1, %2" : "=v"(r) : "v"(lo), "v"(hi)); return r; }
#define PG8_GAS __attribute__((address_space(1)))
template <int ACT  > struct EpiStore {
    static constexpr bool PERM = true, AFTER_DRAIN = false;
    bf16_t* O; int ldc;
    __device__ __forceinline__ void operator()(const f32x4 (&acc)[2][2][4][2], const Unit& u, int wr, int wc, int fr, int fq) const {
        const int row0 = u.pm * BM + wr * 64 + fr, col0 = u.pn * BM + wc * 32 + 8 * fq;
#pragma unroll
        for (int ai = 0; ai < 2; ++ai)
#pragma unroll
            for (int m = 0; m < 4; ++m) { bf16_t* rowp = O + (size_t)(row0 + ai * HALF + m * 16) * ldc + col0;
#pragma unroll
                for (int bj = 0; bj < 2; ++bj) { f32x4 v0 = acc[ai][bj][m][0], v1 = acc[ai][bj][m][1];
                    if (ACT == 1) { v0 = __builtin_elementwise_max(v0, (f32x4){0.f, 0.f, 0.f, 0.f}); v1 = __builtin_elementwise_max(v1, (f32x4){0.f, 0.f, 0.f, 0.f}); v0 = v0 * v0; v1 = v1 * v1; }
                    u32x4 w; w.x = cvt_pk_bf16(v0[0], v0[1]); w.y = cvt_pk_bf16(v0[2], v0[3]); w.z = cvt_pk_bf16(v1[0], v1[1]); w.w = cvt_pk_bf16(v1[2], v1[3]);
                    if (ACT == 0) asm volatile("global_store_dwordx4 %0, %1, off sc1\n\ts_nop 1" :: "v"(rowp + bj * HALF), "v"(w) : "memory"); else *(PG8_GAS u32x4*)(rowp + bj * HALF) = w; } }
    }
};
template <int MODE> struct EpiRes {
    static constexpr bool PERM = true, AFTER_DRAIN = false;
    const float* xp; const float* xs; float* out; bf16_t* XG; const float* gam; const float* ss_in; float* ssq;
    __device__ __forceinline__ void operator()(const f32x4 (&acc)[2][2][4][2], const Unit& u, int wr, int wc, int fr, int fq) const {
        const int row0 = u.pm * BM + wr * 64 + fr, col0 = u.pn * BM + wc * 32 + 8 * fq;
        f32x4 gv[2][2];
        if (MODE == 0) {
#pragma unroll
            for (int bj = 0; bj < 2; ++bj)
#pragma unroll
                for (int n = 0; n < 2; ++n) gv[bj][n] = *(const PG8_GAS f32x4*)(gam + col0 + bj * HALF + 4 * n);
        }
#pragma unroll
        for (int ai = 0; ai < 2; ++ai)
#pragma unroll
            for (int m = 0; m < 4; ++m) {
                const int row = row0 + ai * HALF + m * 16;
                const float* xin; float sc = 1.f;
                if (MODE == 0) { xin = (row < 16384) ? xp + (size_t)row * 1024 : xs + (size_t)(row - 16384) * 1024; }
                else { xin = out + (size_t)row * 1024;
                    const PG8_GAS f32x4* sp = (const PG8_GAS f32x4*)(ss_in + (size_t)row * 16);
                    const f32x4 s0 = sp[0], s1 = sp[1], s2 = sp[2], s3 = sp[3];
                    const f32x4 st = (s0 + s1) + (s2 + s3);
                    const float tot = (st[0] + st[1]) + (st[2] + st[3]);
                    sc = 1.0f / (tot * (1.0f / 1024.0f) + 1e-6f); }
                float* op = out + (size_t)row * 1024 + col0;
                float ss = 0.f;
#pragma unroll
                for (int bj = 0; bj < 2; ++bj) {
                    const f32x4 a0 = *(const PG8_GAS f32x4*)(xin + col0 + bj * HALF), a1 = *(const PG8_GAS f32x4*)(xin + col0 + bj * HALF + 4);
                    const f32x4 v0 = a0 + acc[ai][bj][m][0] * sc, v1 = a1 + acc[ai][bj][m][1] * sc;
                    *(PG8_GAS f32x4*)(op + bj * HALF) = v0; *(PG8_GAS f32x4*)(op + bj * HALF + 4) = v1;
                    ss += (v0[0] * v0[0] + v0[1] * v0[1]) + (v0[2] * v0[2] + v0[3] * v0[3]);
                    ss += (v1[0] * v1[0] + v1[1] * v1[1]) + (v1[2] * v1[2] + v1[3] * v1[3]);
                    if (MODE == 0) { const f32x4 g0 = v0 * gv[bj][0], g1 = v1 * gv[bj][1];
                        u32x4 w; w.x = cvt_pk_bf16(g0[0], g0[1]); w.y = cvt_pk_bf16(g0[2], g0[3]); w.z = cvt_pk_bf16(g1[0], g1[1]); w.w = cvt_pk_bf16(g1[2], g1[3]);
                        bf16_t* xp_ = XG + (size_t)row * 1024 + col0 + bj * HALF;
                        if (u.pm >= 64) asm volatile("global_store_dwordx4 %0, %1, off sc1\n\ts_nop 1" :: "v"(xp_), "v"(w) : "memory");
                        else *(PG8_GAS u32x4*)xp_ = w; }
                }
                ss += __shfl_xor(ss, 16); ss += __shfl_xor(ss, 32);
                if (fq == 0) ssq[(size_t)row * 16 + u.pn * 4 + wc] = ss;
            }
    }
};
struct SplitOrder {
    int G, c;
    __device__ bool next(int i, Unit& u) const { const int L = i * G + c; if (L >= 128) return false; const int tile = L >> 3, kc = L & 7; u.pm = 64 + (tile >> 2); u.pn = tile & 3; u.ko = kc * 512; return true; }
    __device__ __forceinline__ void a_ready(const Unit&) const {}
    __device__ __forceinline__ void done(const Unit&) const {}
};
struct EpiPart {
    static constexpr bool PERM = true, AFTER_DRAIN = false;
    float* P;
    __device__ __forceinline__ void operator()(const f32x4 (&acc)[2][2][4][2], const Unit& u, int wr, int wc, int fr, int fq) const {
        const int row0 = (u.pm - 64) * BM + wr * 64 + fr, col0 = u.pn * BM + wc * 32 + 8 * fq;
        float* base = P + (size_t)(u.ko >> 9) * (1024 * 1024);
#pragma unroll
        for (int ai = 0; ai < 2; ++ai)
#pragma unroll
            for (int m = 0; m < 4; ++m) { float* rowp = base + (size_t)(row0 + ai * HALF + m * 16) * 1024 + col0;
#pragma unroll
                for (int bj = 0; bj < 2; ++bj) { *(PG8_GAS f32x4*)(rowp + bj * HALF) = acc[ai][bj][m][0]; *(PG8_GAS f32x4*)(rowp + bj * HALF + 4) = acc[ai][bj][m][1]; } }
    }
};
struct OutOrder {
    int G, c; unsigned* cnt;
    __device__ bool next(int i, Unit& u) const { const int t = i * G + c; if (t >= 272) return false; if (t < 16) { u.pm = 64 + (t >> 2); u.pn = t & 3; } else { const int p = t - 16; u.pm = p >> 2; u.pn = p & 3; } u.ko = 0; return true; }
    __device__ __forceinline__ void a_ready(const Unit&) const {}
    __device__ __forceinline__ void done(const Unit& u) const {
        if (u.pm >= 64) {
            asm volatile("s_waitcnt vmcnt(0)" ::: "memory");
            if ((threadIdx.x & 63) == 0) __hip_atomic_fetch_add(cnt, 1u, __ATOMIC_RELAXED, __HIP_MEMORY_SCOPE_AGENT);
        }
    }
};
struct SampleFF1Order {
    int G, c; const unsigned* cnt; unsigned need;
    __device__ bool next(int i, Unit& u) const { const int t = c - 16; if (i != 0 || t < 0 || t >= 64) return false; u.pm = 64 + (t >> 4); u.pn = t & 15; u.ko = 0; return true; }
    __device__ __forceinline__ void a_ready(const Unit&) const {
        if (threadIdx.x < 64) {
            unsigned polls = 0;
            while ((unsigned)__builtin_amdgcn_readfirstlane(__hip_atomic_load(cnt, __ATOMIC_RELAXED, __HIP_MEMORY_SCOPE_AGENT)) < need) { if (++polls > (1u << 22)) break; __builtin_amdgcn_s_sleep(2); }
            __builtin_amdgcn_fence(__ATOMIC_ACQUIRE, "agent");
            asm volatile("s_waitcnt vmcnt(0)" ::: "memory");
        }
        asm volatile("" ::: "memory"); __builtin_amdgcn_s_barrier(); asm volatile("" ::: "memory");
    }
    __device__ __forceinline__ void done(const Unit&) const {}
};
struct EpiResNorm {
    static constexpr bool PERM = true, AFTER_DRAIN = true;
    float* out; const float* ss_in; const float* gam; float* xbuf; unsigned* cnt;
    __device__ __forceinline__ void fused(f32x4 (&acc)[2][2][4][2], const Unit& u, int wr, int wc, int fr, int fq, PG8_LAS unsigned char* lds, int wid, int lane) const {
        PG8_LAS float* P = (PG8_LAS float*)lds;
        PG8_LAS float* S = (PG8_LAS float*)(lds + 4096);
        const int row0 = u.pm * BM + wr * 64 + fr, col0 = u.pn * BM + wc * 32 + 8 * fq;
#pragma unroll
        for (int ai = 0; ai < 2; ++ai)
#pragma unroll
            for (int m = 0; m < 4; ++m) {
                const int row = row0 + ai * HALF + m * 16;
                const PG8_GAS f32x4* sp = (const PG8_GAS f32x4*)(ss_in + (size_t)row * 16);
                const f32x4 s0 = sp[0], s1 = sp[1], s2 = sp[2], s3 = sp[3];
                const f32x4 st = (s0 + s1) + (s2 + s3);
                const float sc = 1.0f / (((st[0] + st[1]) + (st[2] + st[3])) * (1.0f / 1024.0f) + 1e-6f);
                const float* xin = out + (size_t)row * 1024 + col0;
                float ss = 0.f;
#pragma unroll
                for (int bj = 0; bj < 2; ++bj) {
                    const f32x4 a0 = *(const PG8_GAS f32x4*)(xin + bj * HALF), a1 = *(const PG8_GAS f32x4*)(xin + bj * HALF + 4);
                    const f32x4 v0 = a0 + acc[ai][bj][m][0] * sc, v1 = a1 + acc[ai][bj][m][1] * sc;
                    acc[ai][bj][m][0] = v0; acc[ai][bj][m][1] = v1;
                    ss += (v0[0] * v0[0] + v0[1] * v0[1]) + (v0[2] * v0[2] + v0[3] * v0[3]);
                    ss += (v1[0] * v1[0] + v1[1] * v1[1]) + (v1[2] * v1[2] + v1[3] * v1[3]);
                }
                ss += __shfl_xor(ss, 16); ss += __shfl_xor(ss, 32);
                if (fq == 0) P[(ai * HALF + wr * 64 + m * 16 + fr) * 4 + wc] = ss;
            }
        asm volatile("s_waitcnt lgkmcnt(0)" ::: "memory"); __builtin_amdgcn_s_barrier(); asm volatile("" ::: "memory");
        const int rowl = wid * 32 + (lane & 31);
        if (lane < 32) {
            const float t = (P[rowl * 4 + 0] + P[rowl * 4 + 1]) + (P[rowl * 4 + 2] + P[rowl * 4 + 3]);
            __hip_atomic_store(xbuf + ((size_t)(u.pm * BM + rowl) * 4 + u.pn), t, __ATOMIC_RELAXED, __HIP_MEMORY_SCOPE_AGENT);
        }
        asm volatile("s_waitcnt vmcnt(0)" ::: "memory");
        if (lane == 0) __hip_atomic_fetch_add(cnt + 64 * u.pm, 1u, __ATOMIC_RELAXED, __HIP_MEMORY_SCOPE_AGENT);
        if (wid == 0) {
            unsigned polls = 0;
            while ((unsigned)__builtin_amdgcn_readfirstlane(__hip_atomic_load(cnt + 64 * u.pm, __ATOMIC_RELAXED, __HIP_MEMORY_SCOPE_AGENT)) < 32u) { if (++polls > (1u << 22)) break; __builtin_amdgcn_s_sleep(2); }
            __builtin_amdgcn_fence(__ATOMIC_ACQUIRE, "agent");
        }
        asm volatile("s_waitcnt vmcnt(0) lgkmcnt(0)" ::: "memory"); __builtin_amdgcn_s_barrier(); asm volatile("" ::: "memory");
        if (lane < 32) {
            const float* slot = xbuf + (size_t)(u.pm * BM + rowl) * 4; float tot = 0.f;
#pragma unroll
            for (int t = 0; t < 4; ++t) tot += __hip_atomic_load(slot + t, __ATOMIC_RELAXED, __HIP_MEMORY_SCOPE_AGENT);
            S[rowl] = 1.0f / sqrtf(tot * (1.0f / 1024.0f) + 1e-6f);
        }
        asm volatile("s_waitcnt lgkmcnt(0)" ::: "memory"); __builtin_amdgcn_s_barrier(); asm volatile("" ::: "memory");
        f32x4 gv[2][2];
#pragma unroll
        for (int bj = 0; bj < 2; ++bj)
#pragma unroll
            for (int n = 0; n < 2; ++n) gv[bj][n] = *(const PG8_GAS f32x4*)(gam + col0 + bj * HALF + 4 * n);
#pragma unroll
        for (int ai = 0; ai < 2; ++ai)
#pragma unroll
            for (int m = 0; m < 4; ++m) {
                const int rl = ai * HALF + wr * 64 + m * 16 + fr; const float rs = S[rl];
                float* op = out + (size_t)(u.pm * BM + rl) * 1024 + col0;
#pragma unroll
                for (int bj = 0; bj < 2; ++bj) { *(PG8_GAS f32x4*)(op + bj * HALF) = acc[ai][bj][m][0] * rs * gv[bj][0]; *(PG8_GAS f32x4*)(op + bj * HALF + 4) = acc[ai][bj][m][1] * rs * gv[bj][1]; }
            }
    }
};
template <class Epi, class Sched, bool ALIGN_EPI = false, bool SP2 = false>
__device__ __forceinline__ void gemm_phase(PG8_LAS unsigned char* lds, const Gemm g, const Sched& S, const Epi& E) {
    const int tid = threadIdx.x, wid = __builtin_amdgcn_readfirstlane(tid >> 6), lane = tid & 63, wr = wid >> 2, wc = wid & 3, fr = lane & 15, fq = lane >> 4;
    const int K = g.K, nt = K / BK, LD = g.ld ? g.ld : g.K;
    unsigned voffA[2], voffB[2];
#pragma unroll
    for (int i = 0; i < 2; ++i) { int R, C; stage_rc(tid * 16 + i * 8192, R, C); const int Rb = Epi::PERM ? ((R & ~31) + perm32(R & 31)) : R;
        voffA[i] = (unsigned)(R * LD + C) * 2u; voffB[i] = (unsigned)(Rb * LD + C) * 2u; }
    const size_t kstep = (size_t)(BK * 2);
    const size_t hstep = (size_t)HALF * LD * 2;
    const size_t tstep = 2 * hstep;
    const unsigned ldsw = (unsigned)wid * 1024u;
    const int aoff = lds_byte(wr * 64 + fr, fq * 8), boff = lds_byte(wc * 32 + fr, fq * 8);
#define PG8_SA(b, h) (((b) * 2 + (h)) * HTB)
#define PG8_SB(b, h) ((4 + (b) * 2 + (h)) * HTB)
#define PG8_STAGE(bufoff, gbase, voff) do { _Pragma("unroll") for (int _i = 0; _i < 2; ++_i) \
        __builtin_amdgcn_global_load_lds((const unsigned*)((const char*)(gbase) + (voff)[_i]), (PG8_LAS unsigned*)(lds + (bufoff) + ldsw + _i * 8192), 16, 0, 0); } while (0)
#define PG8_LDA(dst, b, h) do { _Pragma("unroll") for (int m = 0; m < 4; ++m) _Pragma("unroll") for (int k = 0; k < 2; ++k) dst[m][k] = *(const PG8_LAS bf16x8*)(lds + PG8_SA(b, h) + aoff + m * 2048 + k * 1024); } while (0)
#define PG8_LDB(dst, b, h) do { _Pragma("unroll") for (int n = 0; n < 2; ++n) _Pragma("unroll") for (int k = 0; k < 2; ++k) dst[n][k] = *(const PG8_LAS bf16x8*)(lds + PG8_SB(b, h) + boff + n * 2048 + k * 1024); } while (0)
#define PG8_MMA(ai, bj, At, Bt) do { __builtin_amdgcn_s_setprio(1); _Pragma("unroll") for (int m = 0; m < 4; ++m) _Pragma("unroll") for (int n = 0; n < 2; ++n) _Pragma("unroll") for (int k = 0; k < 2; ++k) \
        acc[ai][bj][m][n] = __builtin_amdgcn_mfma_f32_16x16x32_bf16(Bt[n][k], At[m][k], acc[ai][bj][m][n], 0, 0, 0); __builtin_amdgcn_s_setprio(0); } while (0)
#define PG8_WAIT_V(n) asm volatile("s_waitcnt vmcnt(" #n ")" ::: "memory")
#define PG8_WAIT_L(n) asm volatile("s_waitcnt lgkmcnt(" #n ")" ::: "memory")
#define PG8_BAR __builtin_amdgcn_s_barrier()
#define PG8_SCHED __builtin_amdgcn_sched_barrier(0)
    Unit cur, nxt; int ui = 0;
    if (!S.next(0, cur)) return;
    f32x4 acc[2][2][4][2];
#pragma unroll
    for (int a = 0; a < 2; ++a)
#pragma unroll
        for (int b = 0; b < 2; ++b)
#pragma unroll
            for (int m = 0; m < 4; ++m)
#pragma unroll
                for (int n = 0; n < 2; ++n) acc[a][b][m][n] = (f32x4){0.f, 0.f, 0.f, 0.f};
    bf16x8 At[4][2], B0[2][2], B1[2][2];
    const char* cA = (const char*)g.A + (size_t)cur.pm * tstep + (size_t)cur.ko * 2; const char* cB = (const char*)g.Bt + (size_t)cur.pn * tstep + (size_t)cur.ko * 2;
    S.a_ready(cur);
    if constexpr (SP2) {
        PG8_STAGE(PG8_SB(0, 0), cB, voffB); PG8_STAGE(PG8_SB(0, 1), cB + hstep, voffB); PG8_STAGE(PG8_SA(0, 0), cA, voffA); PG8_STAGE(PG8_SA(0, 1), cA + hstep, voffA);
        if (wr == 1) PG8_BAR;
        PG8_WAIT_V(2); PG8_BAR;
        PG8_STAGE(PG8_SB(1, 0), cB + kstep, voffB); PG8_STAGE(PG8_SA(1, 0), cA + kstep, voffA); PG8_STAGE(PG8_SB(1, 1), cB + hstep + kstep, voffB);
        PG8_WAIT_V(6); PG8_BAR;
    } else {
        PG8_STAGE(PG8_SB(0, 0), cB, voffB); PG8_STAGE(PG8_SA(0, 0), cA, voffA); PG8_STAGE(PG8_SB(0, 1), cB + hstep, voffB); PG8_STAGE(PG8_SA(0, 1), cA + hstep, voffA);
        if (wr == 1) PG8_BAR;
        PG8_WAIT_V(4); PG8_BAR;
        PG8_STAGE(PG8_SB(1, 0), cB + kstep, voffB); PG8_STAGE(PG8_SA(1, 0), cA + kstep, voffA); PG8_STAGE(PG8_SB(1, 1), cB + hstep + kstep, voffB);
        PG8_WAIT_V(6); PG8_BAR;
    }
    for (;;) {
        const bool has_next = S.next(ui + 1, nxt);
        const char* nA = has_next ? (const char*)g.A + (size_t)nxt.pm * tstep + (size_t)nxt.ko * 2 : cA; const char* nB = has_next ? (const char*)g.Bt + (size_t)nxt.pn * tstep + (size_t)nxt.ko * 2 : cB;
        for (int t = 0; t < nt; t += 2) {
            const bool last = (t == nt - 2);
            const char* a1 = cA + (size_t)(t + 1) * kstep;
            const char* a2 = last ? nA : cA + (size_t)(t + 2) * kstep; const char* b2 = last ? nB : cB + (size_t)(t + 2) * kstep;
            const char* a3 = a2 + kstep; const char* b3 = b2 + kstep;
            if (last && has_next) S.a_ready(nxt);
            if constexpr (SP2) {
            PG8_LDB(B0, 0, 0); PG8_LDB(B1, 0, 1); PG8_SCHED; PG8_LDA(At, 0, 0); PG8_STAGE(PG8_SA(1, 1), a1 + hstep, voffA);
            PG8_WAIT_V(8); PG8_WAIT_L(0); PG8_BAR; PG8_MMA(0, 0, At, B0); PG8_MMA(0, 1, At, B1); PG8_BAR; PG8_SCHED;
            PG8_LDA(At, 0, 1); PG8_STAGE(PG8_SB(0, 0), b2, voffB); PG8_STAGE(PG8_SB(0, 1), b2 + hstep, voffB); PG8_STAGE(PG8_SA(0, 0), a2, voffA);
            PG8_WAIT_V(8); PG8_WAIT_L(0); PG8_BAR; PG8_MMA(1, 0, At, B0); PG8_MMA(1, 1, At, B1); PG8_BAR; PG8_SCHED;
            PG8_LDB(B0, 1, 0); PG8_LDB(B1, 1, 1); PG8_SCHED; PG8_LDA(At, 1, 0); PG8_STAGE(PG8_SA(0, 1), a2 + hstep, voffA);
            PG8_WAIT_V(8); PG8_WAIT_L(0); PG8_BAR; PG8_MMA(0, 0, At, B0); PG8_MMA(0, 1, At, B1); PG8_BAR; PG8_SCHED;
            PG8_LDA(At, 1, 1); PG8_STAGE(PG8_SB(1, 0), b3, voffB); PG8_STAGE(PG8_SB(1, 1), b3 + hstep, voffB); PG8_STAGE(PG8_SA(1, 0), a3, voffA);
            PG8_WAIT_V(8); PG8_WAIT_L(0); PG8_BAR; PG8_MMA(1, 0, At, B0); PG8_MMA(1, 1, At, B1); PG8_BAR; PG8_SCHED;
            } else {
            PG8_LDB(B0, 0, 0); PG8_SCHED; PG8_LDA(At, 0, 0); PG8_STAGE(PG8_SA(1, 1), a1 + hstep, voffA);
            PG8_WAIT_L(8); PG8_BAR; PG8_WAIT_L(0); PG8_MMA(0, 0, At, B0); PG8_BAR; PG8_SCHED;
            PG8_LDB(B1, 0, 1); PG8_STAGE(PG8_SB(0, 0), b2, voffB);
            PG8_BAR; PG8_WAIT_L(0); PG8_MMA(0, 1, At, B1); PG8_BAR;
            PG8_LDA(At, 0, 1); PG8_STAGE(PG8_SA(0, 0), a2, voffA);
            PG8_BAR; PG8_WAIT_L(0); PG8_MMA(1, 0, At, B0); PG8_BAR; PG8_SCHED;
            PG8_STAGE(PG8_SB(0, 1), b2 + hstep, voffB);
            PG8_WAIT_V(6); PG8_BAR; PG8_MMA(1, 1, At, B1); PG8_BAR;
            PG8_LDB(B0, 1, 0); PG8_SCHED; PG8_LDA(At, 1, 0); PG8_STAGE(PG8_SA(0, 1), a2 + hstep, voffA);
            PG8_WAIT_L(8); PG8_BAR; PG8_WAIT_L(0); PG8_MMA(0, 0, At, B0); PG8_BAR; PG8_SCHED;
            PG8_LDB(B1, 1, 1); PG8_STAGE(PG8_SB(1, 0), b3, voffB);
            PG8_BAR; PG8_WAIT_L(0); PG8_MMA(0, 1, At, B1); PG8_BAR;
            PG8_LDA(At, 1, 1); PG8_STAGE(PG8_SA(1, 0), a3, voffA);
            PG8_BAR; PG8_WAIT_L(0); PG8_MMA(1, 0, At, B0); PG8_BAR; PG8_SCHED;
            PG8_STAGE(PG8_SB(1, 1), b3 + hstep, voffB);
            PG8_WAIT_V(6); PG8_BAR; PG8_MMA(1, 1, At, B1); PG8_BAR;
            }
        }
        if constexpr (ALIGN_EPI) { if (wr == 0) PG8_BAR; }
        if constexpr (!Epi::AFTER_DRAIN) { E(acc, cur, wr, wc, fr, fq); S.done(cur); }
        if (!has_next) break;
#pragma unroll
        for (int a = 0; a < 2; ++a)
#pragma unroll
            for (int b = 0; b < 2; ++b)
#pragma unroll
                for (int m = 0; m < 4; ++m)
#pragma unroll
                    for (int n = 0; n < 2; ++n) acc[a][b][m][n] = (f32x4){0.f, 0.f, 0.f, 0.f};
        cur = nxt; cA = nA; cB = nB; ++ui;
        if constexpr (ALIGN_EPI) { if (wr == 1) PG8_BAR; }
    }
    PG8_WAIT_V(0);
    if constexpr (!ALIGN_EPI) { if (wr == 0) PG8_BAR; }
    PG8_BAR;
    if constexpr (Epi::AFTER_DRAIN) { E.fused(acc, cur, wr, wc, fr, fq, lds, wid, lane); S.done(cur); }
#undef PG8_SA
#undef PG8_SB
#undef PG8_STAGE
#undef PG8_LDA
#undef PG8_LDB
#undef PG8_MMA
#undef PG8_WAIT_V
#undef PG8_WAIT_L
#undef PG8_BAR
#undef PG8_SCHED
}
}
constexpr int DM = 1024, TP = 16384, TS = 1024, TT = TP + TS, SEQ = 2048, DSEQ = 8, DBATCH = 128;
constexpr int IC = 3328, RWC = 1792, PRW = 1536, FFD = 4096;
constexpr size_t MiB = 1u << 20;
constexpr size_t WS_WIN = 0, WS_WOUT = 7 * MiB, WS_WFF1 = 9 * MiB, WS_WFF2 = 17 * MiB, WS_W2T = 25 * MiB, WS_A2T = WS_W2T + 65536, WS_G2T = WS_A2T + 65536;
constexpr size_t WS_SS1 = 26 * MiB, WS_SS2 = 28 * MiB, WS_XN = 30 * MiB, WS_XG = 64 * MiB, WS_PROJ = 98 * MiB, WS_H = 98 * MiB, WS_END = 234 * MiB;
constexpr size_t O_Y = 0, O_CONVP = (size_t)TT * 1024, O_SHIFTP = O_CONVP + 8192, O_WKVP = O_SHIFTP + 14336, O_CONVS = O_WKVP + 262144, O_SHIFTS = O_CONVS + 131072, O_WKVS = O_SHIFTS + 229376;
constexpr size_t OS_YRAW = 0, OS_G = (size_t)TT * 512, OS_V = OS_G + (size_t)TT * 256;
constexpr size_t WS_WD = 30 * MiB, WS_KK = 64 * MiB, WS_BB = 81 * MiB, WS_KM = 209 * MiB, WS_RR = 226 * MiB, WS_RK = 27 * MiB + 262144;
constexpr int LDS_BYTES = 147456;
constexpr size_t WS_BAR = 29 * MiB + 524288, BAR_ZERO_BYTES = 131072;
constexpr size_t WS_PART = 30 * MiB;
constexpr size_t WS_XSTAT = 29 * MiB + 131072;
constexpr int LDS_BARST = 131072 + 64;

#define GAS __attribute__((address_space(1)))
#define LAS __attribute__((address_space(3)))
typedef unsigned short bf16;
typedef unsigned u32x4 __attribute__((ext_vector_type(4)));
typedef unsigned u32x2 __attribute__((ext_vector_type(2)));
typedef float f32x4 __attribute__((ext_vector_type(4)));
typedef short bf16x8 __attribute__((ext_vector_type(8)));
#define LDS_WAIT() asm volatile("s_waitcnt lgkmcnt(0)" ::: "memory")

__device__ __forceinline__ unsigned pk2(float lo, float hi) { return pg8::cvt_pk_bf16(lo, hi); }
__device__ __forceinline__ bf16 f2bf_sw(float f) { const unsigned u = __builtin_bit_cast(unsigned, f); return (bf16)((u + 0x7fffu + ((u >> 16) & 1u)) >> 16); }
__device__ __forceinline__ float bflo(unsigned u) { return __builtin_bit_cast(float, u << 16); }
__device__ __forceinline__ float bfhi(unsigned u) { return __builtin_bit_cast(float, u & 0xffff0000u); }
__device__ __forceinline__ u32x4 gld16(const void* p) { return *(const GAS u32x4*)p; }
__device__ __forceinline__ f32x4 gldf4(const float* p) { return *(const GAS f32x4*)p; }
__device__ __forceinline__ void unpack8(const u32x4 u, float (&o)[8]) { o[0] = bflo(u.x); o[1] = bfhi(u.x); o[2] = bflo(u.y); o[3] = bfhi(u.y); o[4] = bflo(u.z); o[5] = bfhi(u.z); o[6] = bflo(u.w); o[7] = bfhi(u.w); }
__device__ __forceinline__ u32x4 pack8(const float (&v)[8]) { u32x4 w; w.x = pk2(v[0], v[1]); w.y = pk2(v[2], v[3]); w.z = pk2(v[4], v[5]); w.w = pk2(v[6], v[7]); return w; }
__device__ __forceinline__ float wave_sum(float v) {
#pragma unroll
    for (int o = 1; o < 64; o <<= 1) v += __shfl_xor(v, o);
    return v;
}
template <int CTRL> __device__ __forceinline__ float dppf(float x) { return __builtin_bit_cast(float, __builtin_amdgcn_update_dpp(0, __builtin_bit_cast(int, x), CTRL, 0xF, 0xF, true)); }
__device__ __forceinline__ float row16_sum(float x) {
    x += dppf<0xB1>(x); x += dppf<0x4E>(x); x += dppf<0x124>(x); x += dppf<0x128>(x); return x;
}
__device__ __forceinline__ float sigmoidf_(float x) { return __builtin_amdgcn_rcpf(1.0f + __expf(-x)); }
__device__ __forceinline__ float tanhf_(float x) { const float e = __expf(2.0f * x); return 1.0f - 2.0f * __builtin_amdgcn_rcpf(e + 1.0f); }

struct Args { const float* in[24]; float* out; unsigned char* ws; int ph_lo, ph_hi, li, pad; };

__device__ __forceinline__ void p0_transpose_item(const float* W, int K, int N, bf16* WT, LAS float* scr, int item, int lane) {
    const int nblk = N / 32, kb = item / nblk, nb = item % nblk, k0 = 64 * kb, n0 = 32 * nb;
#pragma unroll 8
    for (int i = 0; i < 32; ++i) { const int kk = 2 * i + (lane >> 5); scr[kk * 33 + (lane & 31)] = W[(size_t)(k0 + kk) * N + n0 + (lane & 31)]; }
    LDS_WAIT(); asm volatile("" ::: "memory");
    const int c = lane & 7;
#pragma unroll
    for (int j = 0; j < 4; ++j) { const int n = (lane >> 3) + 8 * j; const LAS float* s = scr + (8 * c) * 33 + n;
        u32x4 o; o.x = pk2(s[0 * 33], s[1 * 33]); o.y = pk2(s[2 * 33], s[3 * 33]); o.z = pk2(s[4 * 33], s[5 * 33]); o.w = pk2(s[6 * 33], s[7 * 33]);
        *(GAS u32x4*)(WT + (size_t)(n0 + n) * K + k0 + 8 * c) = o; }
    LDS_WAIT(); asm volatile("" ::: "memory");
}
__device__ __forceinline__ void rms_row_to_bf16(const float* xrow, const float* g, bf16* orow, int lane) {
    const GAS f32x4* xr = (const GAS f32x4*)xrow + lane; const GAS f32x4* gr = (const GAS f32x4*)g + lane;
    f32x4 v[4]; float s2 = 0.f;
#pragma unroll
    for (int j = 0; j < 4; ++j) { v[j] = xr[64 * j]; s2 += (v[j].x * v[j].x + v[j].y * v[j].y) + (v[j].z * v[j].z + v[j].w * v[j].w); }
    const float rstd = 1.0f / sqrtf(wave_sum(s2) * (1.f / DM) + 1e-6f);
    GAS u32x2* o8 = (GAS u32x2*)orow + lane;
#pragma unroll
    for (int j = 0; j < 4; ++j) { const f32x4 gg = gr[64 * j]; u32x2 w; w.x = pk2(v[j].x * rstd * gg.x, v[j].y * rstd * gg.y); w.y = pk2(v[j].z * rstd * gg.z, v[j].w * rstd * gg.w); o8[64 * j] = w; }
}

constexpr int SB_W = 0, SB_B = 2048, SB_K = 4096, SB_KK = 6144, SB_R = 8192, SB_V = 10240, SB_BETA = 12288, SB_BYTES = 49280, STG_OFF = 2 * SB_BYTES, STG_BYTES = 4608;

__device__ __forceinline__ void load_xm8(const bf16* prow, int c, bool first, const float* shift0, const float* mu, float (&o)[8]) {
    float cur[8], prv[8];
    unpack8(gld16(prow + c), cur);
    if (!first) { unpack8(gld16(prow - IC + c), prv); }
    else if (shift0) { const f32x4 a = gldf4(shift0 + c), b = gldf4(shift0 + c + 4); prv[0] = a.x; prv[1] = a.y; prv[2] = a.z; prv[3] = a.w; prv[4] = b.x; prv[5] = b.y; prv[6] = b.z; prv[7] = b.w; }
    else {
#pragma unroll
        for (int i = 0; i < 8; ++i) prv[i] = 0.f;
    }
    const f32x4 m0 = gldf4(mu + c), m1 = gldf4(mu + c + 4);
    const float mm[8] = {m0.x, m0.y, m0.z, m0.w, m1.x, m1.y, m1.z, m1.w};
#pragma unroll
    for (int i = 0; i < 8; ++i) o[i] = cur[i] + (prv[i] - cur[i]) * mm[i];
}

constexpr int PREP_MU = 10752, PREP_SCR = 12544;
__device__ __forceinline__ void prep_cols(int h, int cgp, int (&col)[7]) {
    col[0] = h * 64 + 8 * cgp; col[1] = 512 + h * 64 + 8 * cgp; col[2] = 1024 + h * 64 + 8 * cgp; col[3] = 1536 + 8 * cgp; col[4] = 1600 + 8 * cgp; col[5] = 1664 + 16 * cgp; col[6] = 1664 + 16 * cgp + 8;
}
struct PrepRaw { u32x4 c[7]; u32x4 p[7]; };
__device__ __forceinline__ void prep_load(const Args& a, PrepRaw& R, int lane, int row0, int h) {
    const bool smp = row0 >= TP;
    const int tok = lane >> 3, cgp = lane & 7, row = row0 + tok;
    const int t = smp ? tok : (row & 2047);
    const bf16* prow = (const bf16*)(a.ws + WS_PROJ) + (size_t)row * IC + PRW;
    int col[7]; prep_cols(h, cgp, col);
#pragma unroll
    for (int i = 0; i < 7; ++i) { R.c[i] = gld16(prow + col[i]); R.p[i] = (u32x4){0u, 0u, 0u, 0u}; }
    if (t != 0) {
#pragma unroll
        for (int i = 0; i < 7; ++i) R.p[i] = gld16(prow - IC + col[i]);
    }
}
__device__ __forceinline__ void xm8_raw(const u32x4 cu, const u32x4 pu, int c, bool fs, const float* shift0, const float* mu, float (&o)[8]) {
    float cur[8], prv[8];
    unpack8(cu, cur); unpack8(pu, prv);
    if (fs) { const f32x4 a = gldf4(shift0 + c), b = gldf4(shift0 + c + 4); prv[0] = a.x; prv[1] = a.y; prv[2] = a.z; prv[3] = a.w; prv[4] = b.x; prv[5] = b.y; prv[6] = b.z; prv[7] = b.w; }
    const f32x4 m0 = gldf4(mu + c), m1 = gldf4(mu + c + 4);
    const float mm[8] = {m0.x, m0.y, m0.z, m0.w, m1.x, m1.y, m1.z, m1.w};
#pragma unroll
    for (int i = 0; i < 8; ++i) o[i] = cur[i] + (prv[i] - cur[i]) * mm[i];
}
__device__ __forceinline__ void xm8_pre(const u32x4 cu, const u32x4 pu, int c, bool fs, const float* shift0, const f32x4 m0, const f32x4 m1, float (&o)[8]) {
    float cur[8], prv[8];
    unpack8(cu, cur); unpack8(pu, prv);
    if (fs) { const f32x4 a = gldf4(shift0 + c), b = gldf4(shift0 + c + 4); prv[0] = a.x; prv[1] = a.y; prv[2] = a.z; prv[3] = a.w; prv[4] = b.x; prv[5] = b.y; prv[6] = b.z; prv[7] = b.w; }
    const float mm[8] = {m0.x, m0.y, m0.z, m0.w, m1.x, m1.y, m1.z, m1.w};
#pragma unroll
    for (int i = 0; i < 8; ++i) o[i] = cur[i] + (prv[i] - cur[i]) * mm[i];
}
struct PrepConst { int unused; };
__device__ __forceinline__ void prep_item(const Args& a, const PrepConst& C, const PrepRaw& R, LAS unsigned char* scr, int lane, int row0, int h) {
    const bool smp = row0 >= TP;
    const int b = smp ? ((row0 - TP) >> 3) : (row0 >> 11);
    const int tok = lane >> 3, cgp = lane & 7;
    const int row = row0 + tok;
    const int t = smp ? tok : (row & 2047);
    const bool fs = (t == 0) && smp;
    const float* shift0 = a.in[3] + (size_t)b * RWC;
    int col[7]; prep_cols(h, cgp, col);
    const LAS float* MUs = (const LAS float*)(scr + PREP_MU);
    LAS float* KKs = (LAS float*)scr; LAS float* KRs = KKs + 512; LAS float* Rs = KRs + 512;
    LAS bf16* Lw = (LAS bf16*)(scr + 6144); LAS bf16* La = Lw + 8 * 72; LAS bf16* Lg = La + 8 * 72;
    const size_t go = (size_t)row * 512 + h * 64 + 8 * cgp;
    u32x4 pk_r, pk_v, pk_kk;
    {
        float xr[8], xk[8], xv[8];
        xm8_pre(R.c[0], R.p[0], col[0], fs, shift0, *(const LAS f32x4*)(MUs + (0 * 8 + cgp) * 8), *(const LAS f32x4*)(MUs + (0 * 8 + cgp) * 8 + 4), xr);
        xm8_pre(R.c[1], R.p[1], col[1], fs, shift0, *(const LAS f32x4*)(MUs + (1 * 8 + cgp) * 8), *(const LAS f32x4*)(MUs + (1 * 8 + cgp) * 8 + 4), xk);
        xm8_pre(R.c[2], R.p[2], col[2], fs, shift0, *(const LAS f32x4*)(MUs + (2 * 8 + cgp) * 8), *(const LAS f32x4*)(MUs + (2 * 8 + cgp) * 8 + 4), xv);
        pk_r = pack8(xr); pk_v = pack8(xv);
        *(LAS f32x4*)(Rs + tok * 64 + 8 * cgp) = (f32x4){xr[0], xr[1], xr[2], xr[3]}; *(LAS f32x4*)(Rs + tok * 64 + 8 * cgp + 4) = (f32x4){xr[4], xr[5], xr[6], xr[7]};
        *(LAS f32x4*)(KRs + tok * 64 + 8 * cgp) = (f32x4){xk[0], xk[1], xk[2], xk[3]}; *(LAS f32x4*)(KRs + tok * 64 + 8 * cgp + 4) = (f32x4){xk[4], xk[5], xk[6], xk[7]};
        const f32x4 c0 = gldf4(a.in[14] + h * 64 + 8 * cgp), c1 = gldf4(a.in[14] + h * 64 + 8 * cgp + 4);
        float kkv[8] = {xk[0] * c0.x, xk[1] * c0.y, xk[2] * c0.z, xk[3] * c0.w, xk[4] * c1.x, xk[5] * c1.y, xk[6] * c1.z, xk[7] * c1.w};
        float n2 = 0.f;
#pragma unroll
        for (int i = 0; i < 8; ++i) n2 += kkv[i] * kkv[i];
        n2 += __shfl_xor(n2, 1); n2 += __shfl_xor(n2, 2); n2 += __shfl_xor(n2, 4);
        const float inv = __builtin_amdgcn_rsqf(fmaxf(n2, 1e-24f));
#pragma unroll
        for (int i = 0; i < 8; ++i) kkv[i] *= inv;
        pk_kk = pack8(kkv);
        *(LAS f32x4*)(KKs + tok * 64 + 8 * cgp) = (f32x4){kkv[0], kkv[1], kkv[2], kkv[3]}; *(LAS f32x4*)(KKs + tok * 64 + 8 * cgp + 4) = (f32x4){kkv[4], kkv[5], kkv[6], kkv[7]};
    }
    {
        float xw[8], xa[8], xg[8];
        xm8_pre(R.c[3], R.p[3], col[3], fs, shift0, *(const LAS f32x4*)(MUs + (3 * 8 + cgp) * 8), *(const LAS f32x4*)(MUs + (3 * 8 + cgp) * 8 + 4), xw);
#pragma unroll
        for (int i = 0; i < 8; ++i) xw[i] = tanhf_(xw[i]);
        *(LAS u32x4*)(Lw + tok * 72 + 8 * cgp) = pack8(xw);
        xm8_pre(R.c[4], R.p[4], col[4], fs, shift0, *(const LAS f32x4*)(MUs + (4 * 8 + cgp) * 8), *(const LAS f32x4*)(MUs + (4 * 8 + cgp) * 8 + 4), xa);
        *(LAS u32x4*)(La + tok * 72 + 8 * cgp) = pack8(xa);
        xm8_pre(R.c[5], R.p[5], col[5], fs, shift0, *(const LAS f32x4*)(MUs + (5 * 8 + cgp) * 8), *(const LAS f32x4*)(MUs + (5 * 8 + cgp) * 8 + 4), xg);
#pragma unroll
        for (int i = 0; i < 8; ++i) xg[i] = sigmoidf_(xg[i]);
        *(LAS u32x4*)(Lg + tok * 136 + 16 * cgp) = pack8(xg);
        xm8_pre(R.c[6], R.p[6], col[6], fs, shift0, *(const LAS f32x4*)(MUs + (6 * 8 + cgp) * 8), *(const LAS f32x4*)(MUs + (6 * 8 + cgp) * 8 + 4), xg);
#pragma unroll
        for (int i = 0; i < 8; ++i) xg[i] = sigmoidf_(xg[i]);
        *(LAS u32x4*)(Lg + tok * 136 + 16 * cgp + 8) = pack8(xg);
    }
    LDS_WAIT();
    const int fr = lane & 15, fq = lane >> 4, arow = fr & 7;
    const bf16* W2T = (const bf16*)(a.ws + WS_W2T); const bf16* A2T = (const bf16*)(a.ws + WS_A2T); const bf16* G2T = (const bf16*)(a.ws + WS_G2T);
    const bf16x8 Aw0 = *(const LAS bf16x8*)(Lw + arow * 72 + 8 * fq), Aw1 = *(const LAS bf16x8*)(Lw + arow * 72 + 32 + 8 * fq);
    const bf16x8 Aa0 = *(const LAS bf16x8*)(La + arow * 72 + 8 * fq), Aa1 = *(const LAS bf16x8*)(La + arow * 72 + 32 + 8 * fq);
    f32x4 accw[4], acca[4];
#pragma unroll
    for (int nt = 0; nt < 4; ++nt) {
        const size_t bo = (size_t)(h * 64 + 16 * nt + fr) * 64 + 8 * fq;
        const bf16x8 bw0 = __builtin_bit_cast(bf16x8, gld16(W2T + bo)), bw1 = __builtin_bit_cast(bf16x8, gld16(W2T + bo + 32));
        const bf16x8 ba0 = __builtin_bit_cast(bf16x8, gld16(A2T + bo)), ba1 = __builtin_bit_cast(bf16x8, gld16(A2T + bo + 32));
        f32x4 z = {0.f, 0.f, 0.f, 0.f};
        accw[nt] = __builtin_amdgcn_mfma_f32_16x16x32_bf16(Aw0, bw0, z, 0, 0, 0); accw[nt] = __builtin_amdgcn_mfma_f32_16x16x32_bf16(Aw1, bw1, accw[nt], 0, 0, 0);
        acca[nt] = __builtin_amdgcn_mfma_f32_16x16x32_bf16(Aa0, ba0, z, 0, 0, 0); acca[nt] = __builtin_amdgcn_mfma_f32_16x16x32_bf16(Aa1, ba1, acca[nt], 0, 0, 0);
    }
    const bool lowh = fq < 2;
    const int ntb = lowh ? 0 : 2, tokb = 4 * (fq & 1);
    f32x4 Wsel[2], Asel[2];
    Wsel[0] = lowh ? accw[0] : accw[2]; Wsel[1] = lowh ? accw[1] : accw[3];
    Asel[0] = lowh ? acca[0] : acca[2]; Asel[1] = lowh ? acca[1] : acca[3];
    float rkp[4] = {0.f, 0.f, 0.f, 0.f};
    float* WD = (float*)(a.ws + WS_WD); bf16* BBp = (bf16*)(a.ws + WS_BB); bf16* KMp = (bf16*)(a.ws + WS_KM);
#pragma unroll
    for (int u = 0; u < 2; ++u) {
        const int c = 16 * (ntb + u) + fr, hc = h * 64 + c;
        const float w0c = a.in[9][hc], a0c = a.in[11][hc], kac = a.in[15][hc], rkc = a.in[16][hc];
#pragma unroll
        for (int e = 0; e < 4; ++e) {
            const int o = (tokb + e) * 64 + c;
            const float sg = sigmoidf_(Wsel[u][e] + w0c);
            const float decay = __expf(-0.6065306597126334f * sg);
            const float av = sigmoidf_(Asel[u][e] + a0c);
            const float kkv = KKs[o], kr = KRs[o], rv = Rs[o];
            const float kmod = kr * (1.0f + (av - 1.0f) * kac);
            Rs[o] = decay; KKs[o] = kkv * av; KRs[o] = kmod;
            rkp[e] += rv * kmod * rkc;
        }
    }
    float* RK = (float*)(a.ws + WS_RK);
#pragma unroll
    for (int e = 0; e < 4; ++e) { rkp[e] = row16_sum(rkp[e]); rkp[e] += __shfl_xor(rkp[e], 32); }
    bf16x8 Ag[4];
#pragma unroll
    for (int ks = 0; ks < 4; ++ks) Ag[ks] = *(const LAS bf16x8*)(Lg + arow * 136 + 32 * ks + 8 * fq);
    bf16* Gb = (bf16*)(a.out + OS_G);
    LDS_WAIT();
    LAS float* Gs = (LAS float*)Lw;
    for (int nt = 0; nt < 4; ++nt) {
        const size_t bo = (size_t)(h * 64 + 16 * nt + fr) * 128 + 8 * fq;
        f32x4 acc = {0.f, 0.f, 0.f, 0.f};
#pragma unroll
        for (int ks = 0; ks < 4; ++ks) acc = __builtin_amdgcn_mfma_f32_16x16x32_bf16(Ag[ks], __builtin_bit_cast(bf16x8, gld16(G2T + bo + 32 * ks)), acc, 0, 0, 0);
        if (lowh) {
#pragma unroll
            for (int e = 0; e < 4; ++e) Gs[(4 * fq + e) * 64 + 16 * nt + fr] = acc[e];
        }
    }
    LDS_WAIT();
    {
        const LAS float* pg = Gs + tok * 64 + 8 * cgp; const f32x4 g0 = *(const LAS f32x4*)pg, g1 = *(const LAS f32x4*)(pg + 4);
        const float gv[8] = {g0.x, g0.y, g0.z, g0.w, g1.x, g1.y, g1.z, g1.w};
        const LAS float* ps = Rs + tok * 64 + 8 * cgp; const f32x4 d0 = *(const LAS f32x4*)ps, d1 = *(const LAS f32x4*)(ps + 4);
        const LAS float* pb = KKs + tok * 64 + 8 * cgp; const f32x4 b0 = *(const LAS f32x4*)pb, b1 = *(const LAS f32x4*)(pb + 4);
        const float bv[8] = {b0.x, b0.y, b0.z, b0.w, b1.x, b1.y, b1.z, b1.w};
        const LAS float* pk = KRs + tok * 64 + 8 * cgp; const f32x4 k0 = *(const LAS f32x4*)pk, k1 = *(const LAS f32x4*)(pk + 4);
        const float kv[8] = {k0.x, k0.y, k0.z, k0.w, k1.x, k1.y, k1.z, k1.w};
        *(GAS u32x4*)((bf16*)(a.ws + WS_RR) + go) = pk_r;
        *(GAS u32x4*)((bf16*)(a.out + OS_V) + go) = pk_v;
        *(GAS u32x4*)((bf16*)(a.ws + WS_KK) + go) = pk_kk;
        *(GAS f32x4*)(WD + go) = d0; *(GAS f32x4*)(WD + go + 4) = d1;
        *(GAS u32x4*)(BBp + go) = pack8(bv);
        *(GAS u32x4*)(KMp + go) = pack8(kv);
        *(GAS u32x4*)(Gb + go) = pack8(gv);
        if (fr == 0 && lowh) {
#pragma unroll
            for (int e = 0; e < 4; ++e) RK[(size_t)(row0 + tokb + e) * 8 + h] = rkp[e];
        }
    }
    LDS_WAIT();
}

struct LdRaw { f32x4 w0, w1; u32x4 kk, b, k, r, v, kkn; };
__device__ __forceinline__ void loader_load(const Args& a, LdRaw& R, int pw, int lane, bool is_sample, int chain, int t0) {
    const int b = chain >> 3, h = chain & 7, tok = lane >> 3, cgp = lane & 7;
    const int row = (is_sample ? TP + b * DSEQ : b * SEQ + t0 + 8 * pw) + tok;
    const size_t go = (size_t)row * 512 + h * 64 + 8 * cgp;
    R.w0 = gldf4((const float*)(a.ws + WS_WD) + go); R.w1 = gldf4((const float*)(a.ws + WS_WD) + go + 4);
    R.kk = gld16((const bf16*)(a.ws + WS_KK) + go); R.b = gld16((const bf16*)(a.ws + WS_BB) + go); R.k = gld16((const bf16*)(a.ws + WS_KM) + go);
    R.r = gld16((const bf16*)(a.ws + WS_RR) + go); R.v = gld16((const bf16*)(a.out + OS_V) + go);
    R.kkn = gld16((const bf16*)(a.ws + WS_KK) + go + 512);
}
__device__ __forceinline__ void st8(LAS float* p, const u32x4 u) {
    float f[8]; unpack8(u, f);
    *(LAS f32x4*)p = (f32x4){f[0], f[1], f[2], f[3]}; *(LAS f32x4*)(p + 4) = (f32x4){f[4], f[5], f[6], f[7]};
}
__device__ __forceinline__ void loader_store(const LdRaw& R, LAS unsigned char* lds, int buf, int pw, int lane) {
    LAS float* B = (LAS float*)(lds + buf * SB_BYTES);
    const int o = (8 * pw + (lane >> 3)) * 64 + 8 * (lane & 7);
    *(LAS f32x4*)(B + SB_W + o) = R.w0; *(LAS f32x4*)(B + SB_W + o + 4) = R.w1;
    st8(B + SB_KK + o, R.kk); st8(B + SB_B + o, R.b); st8(B + SB_K + o, R.k); st8(B + SB_R + o, R.r); st8(B + SB_V + o, R.v);
    float bb[8], kn[8]; unpack8(R.b, bb); unpack8(R.kkn, kn);
    float part = 0.f;
#pragma unroll
    for (int i = 0; i < 8; ++i) part += bb[i] * kn[i];
    part += __shfl_xor(part, 1); part += __shfl_xor(part, 2); part += __shfl_xor(part, 4);
    if ((lane & 7) == 0) B[SB_BETA + 8 * pw + (lane >> 3)] = part;
}

typedef float f32x2 __attribute__((ext_vector_type(2)));
struct StepOps { f32x4 kk, w, b, k, r; float v; };
__device__ __forceinline__ void ld_step(StepOps& o, const LAS float* B, int off, int voff) {
    o.kk = *(const LAS f32x4*)(B + SB_KK + off); o.w = *(const LAS f32x4*)(B + SB_W + off); o.b = *(const LAS f32x4*)(B + SB_B + off);
    o.k = *(const LAS f32x4*)(B + SB_K + off); o.r = *(const LAS f32x4*)(B + SB_R + off); o.v = B[SB_V + voff];
}
__device__ __forceinline__ float wkv_step2(f32x2& Sa, f32x2& Sb, const f32x4 kk, const f32x4 w, const f32x4 b, const f32x4 k, const f32x4 r, const float vv) {
    f32x2 t = Sa * (f32x2){kk.x, kk.y}; t = Sb * (f32x2){kk.z, kk.w} + t;
    const float p = row16_sum(t.x + t.y);
    const float nu = -p;
    Sa = Sa * (f32x2){w.x, w.y} + (f32x2){b.x, b.y} * nu + (f32x2){k.x, k.y} * vv;
    Sb = Sb * (f32x2){w.z, w.w} + (f32x2){b.z, b.w} * nu + (f32x2){k.z, k.w} * vv;
    f32x2 u = Sa * (f32x2){r.x, r.y}; u = Sb * (f32x2){r.z, r.w} + u;
    return row16_sum(u.x + u.y);
}
__device__ __forceinline__ float wkv_step(f32x4& S, const f32x4 kk, const f32x4 w, const f32x4 b, const f32x4 k, const f32x4 r, const float vv) {
    f32x2 Sa = {S.x, S.y}, Sb = {S.z, S.w};
    const float y = wkv_step2(Sa, Sb, kk, w, b, k, r, vv);
    S = (f32x4){Sa.x, Sa.y, Sb.x, Sb.y};
    return y;
}

__device__ __forceinline__ void p2_scan(const Args& a, LAS unsigned char* lds, int G, int vcu, int wave, int lane) {
    const int nPI = (vcu < 256) ? (256 - vcu + G - 1) / G : 0;
    const int nSG = nPI;
    const int NT = nPI * 64 + nSG;
    const bool scanw = wave < 4;
    const int sw = wave & 3;
    const int jj = lane & 15, lr = 4 * sw + (lane >> 4);
    float* Yraw = a.out + OS_YRAW;
    f32x4 S = {0.f, 0.f, 0.f, 0.f};
#define TASK_DECODE(j, is_sample, item, chunk) const bool is_sample = (j) >= nPI * 64; const int item = is_sample ? vcu + ((j) - nPI * 64) * G : vcu + ((j) >> 6) * G; const int chunk = (j) & 63;
    LdRaw R;
    R.w0 = R.w1 = (f32x4){0.f, 0.f, 0.f, 0.f}; R.kk = R.b = R.k = R.r = R.v = R.kkn = (u32x4){0u, 0u, 0u, 0u};
    if (!scanw && NT > 0) {
        { TASK_DECODE(0, smp, item, chunk); loader_load(a, R, sw, lane, smp, smp ? 4 * item + sw : (item >> 2), chunk * 32); loader_store(R, lds, 0, sw, lane); }
        if (NT > 1) { TASK_DECODE(1, smp, item, chunk); loader_load(a, R, sw, lane, smp, smp ? 4 * item + sw : (item >> 2), chunk * 32); }
    }
    LDS_WAIT(); __builtin_amdgcn_s_barrier(); asm volatile("" ::: "memory");
    for (int j = 0; j < NT; ++j) {
        const bool smp_task = j >= nPI * 64;
        if (scanw || smp_task) {
            TASK_DECODE(j, smp, item, chunk);
            const LAS float* B = (const LAS float*)(lds + (j & 1) * SB_BYTES);
            if (!smp) {
                const int chain = item >> 2, q = item & 3, b = chain >> 3, h = chain & 7;
                if (chunk == 0) S = (f32x4){0.f, 0.f, 0.f, 0.f};
                const int rowb = b * SEQ + chunk * 32;
                const int vrow = 16 * q + lr;
                f32x2 Sa = {S.x, S.y}, Sb = {S.z, S.w};
                StepOps c0, c1, c2;
                ld_step(c0, B, 4 * jj, vrow); ld_step(c1, B, 64 + 4 * jj, 64 + vrow);
                float p;
                { f32x2 t = Sa * (f32x2){c0.kk.x, c0.kk.y}; t = Sb * (f32x2){c0.kk.z, c0.kk.w} + t; p = row16_sum(t.x + t.y); }
                for (int blk = 0; blk < 2; ++blk) {
                    float ykeep = 0.f;
#pragma unroll
                    for (int s2 = 0; s2 < 16; ++s2) {
                        const int sc_ = blk * 16 + s2;
                        const int sn = (sc_ + 2) & 31;
                        ld_step(c2, B, sn * 64 + 4 * jj, sn * 64 + vrow);
                        const float beta = B[SB_BETA + sc_];
                        const f32x2 Aa = Sa * (f32x2){c0.w.x, c0.w.y} + (f32x2){c0.k.x, c0.k.y} * c0.v;
                        const f32x2 Ab = Sb * (f32x2){c0.w.z, c0.w.w} + (f32x2){c0.k.z, c0.k.w} * c0.v;
                        f32x2 tq = Aa * (f32x2){c1.kk.x, c1.kk.y}; tq = Ab * (f32x2){c1.kk.z, c1.kk.w} + tq;
                        const float q = row16_sum(tq.x + tq.y);
                        const float np = -p;
                        Sa = Aa + (f32x2){c0.b.x, c0.b.y} * np; Sb = Ab + (f32x2){c0.b.z, c0.b.w} * np;
                        f32x2 u = Sa * (f32x2){c0.r.x, c0.r.y}; u = Sb * (f32x2){c0.r.z, c0.r.w} + u;
                        const float y = row16_sum(u.x + u.y);
                        ykeep = (s2 == jj) ? y : ykeep;
                        p = q + np * beta;
                        c0 = c1; c1 = c2;
                    }
                    Yraw[(size_t)(rowb + blk * 16 + jj) * 512 + h * 64 + vrow] = ykeep;
                }
                S = (f32x4){Sa.x, Sa.y, Sb.x, Sb.y};
                if (chunk == 63) *(GAS f32x4*)(a.out + O_WKVP + ((size_t)(chain * 64 + vrow)) * 64 + 4 * jj) = S;
            } else {
                for (int cs = scanw ? 0 : 2; cs < (scanw ? 2 : 4); ++cs) {
                    const int chain = 4 * item + cs, b = chain >> 3, h = chain & 7;
                    const float* st = a.in[4] + (size_t)chain * 4096;
                    f32x4 Sq[4]; float yk[4] = {0.f, 0.f, 0.f, 0.f};
#pragma unroll
                    for (int qq = 0; qq < 4; ++qq) Sq[qq] = gldf4(st + (16 * qq + lr) * 64 + 4 * jj);
#pragma unroll
                    for (int t = 0; t < 8; ++t) {
                        const int s = 8 * cs + t;
                        const f32x4 kk = *(const LAS f32x4*)(B + SB_KK + s * 64 + 4 * jj), w = *(const LAS f32x4*)(B + SB_W + s * 64 + 4 * jj), bb = *(const LAS f32x4*)(B + SB_B + s * 64 + 4 * jj);
                        const f32x4 k = *(const LAS f32x4*)(B + SB_K + s * 64 + 4 * jj), r = *(const LAS f32x4*)(B + SB_R + s * 64 + 4 * jj);
#pragma unroll
                        for (int qq = 0; qq < 4; ++qq) {
                            const float vv = B[SB_V + s * 64 + 16 * qq + lr];
                            const float y = wkv_step(Sq[qq], kk, w, bb, k, r, vv);
                            yk[qq] = (t == jj) ? y : yk[qq];
                        }
                    }
#pragma unroll
                    for (int qq = 0; qq < 4; ++qq) {
                        if (jj < 8) Yraw[(size_t)(TP + b * DSEQ + jj) * 512 + h * 64 + 16 * qq + lr] = yk[qq];
                        *(GAS f32x4*)(a.out + O_WKVS + ((size_t)(chain * 64 + 16 * qq + lr)) * 64 + 4 * jj) = Sq[qq];
                    }
                }
            }
        }
        if (!scanw && j + 1 < NT) {
            loader_store(R, lds, (j + 1) & 1, sw, lane);
            if (j + 2 < NT) { TASK_DECODE(j + 2, smp, item, chunk); loader_load(a, R, sw, lane, smp, smp ? 4 * item + sw : (item >> 2), chunk * 32); }
        }
        LDS_WAIT(); __builtin_amdgcn_s_barrier(); asm volatile("" ::: "memory");
    }
#undef TASK_DECODE
}

struct MixConst { f32x4 w[6]; f32x4 l[4]; };
struct MixRaw { u32x4 cb, cc0, cx0, cc1, cx1, cc2, cx2, g, v; f32x4 y0, y1; float rk; };
__device__ __forceinline__ void p3_load(const Args& a, MixRaw& R, int row, int lane) {
    const bool smp = row >= TP;
    const int t = smp ? ((row - TP) & 7) : (row & 2047);
    const bf16* pr = (const bf16*)(a.ws + WS_PROJ) + (size_t)row * IC;
    const int c8 = 8 * lane;
    const u32x4 z = {0u, 0u, 0u, 0u};
    R.cb = gld16(pr + c8); R.cc0 = gld16(pr + 512 + c8); R.cx0 = gld16(pr + 1024 + c8);
    R.cc1 = z; R.cx1 = z; R.cc2 = z; R.cx2 = z;
    if (t >= 1) { R.cc1 = gld16(pr - IC + 512 + c8); R.cx1 = gld16(pr - IC + 1024 + c8); }
    if (t >= 2) { R.cc2 = gld16(pr - 2 * IC + 512 + c8); R.cx2 = gld16(pr - 2 * IC + 1024 + c8); }
    const float* yr = a.out + OS_YRAW + (size_t)row * 512 + c8;
    R.y0 = gldf4(yr); R.y1 = gldf4(yr + 4);
    R.v = gld16((const bf16*)(a.out + OS_V) + (size_t)row * 512 + c8);
    R.g = gld16((const bf16*)(a.out + OS_G) + (size_t)row * 512 + c8);
    R.rk = ((const float*)(a.ws + WS_RK))[(size_t)row * 8 + (lane >> 3)];
}
__device__ __forceinline__ void p3_token(const Args& a, const MixConst& K, const MixRaw& R, int row, int lane) {
    const bool smp = row >= TP;
    const int rr = row - TP;
    const int b = smp ? (rr >> 3) : (row >> 11), t = smp ? (rr & 7) : (row & 2047), L = smp ? DSEQ : SEQ;
    const bf16* pr = (const bf16*)(a.ws + WS_PROJ) + (size_t)row * IC;
    const int c8 = 8 * lane;
    float yconv[8], yrw[8];
    {
        float cb[8], cc[8], cx[8], u0[8], f1[8], f2[8];
        unpack8(R.cb, cb); unpack8(R.cc0, cc); unpack8(R.cx0, cx);
#pragma unroll
        for (int i = 0; i < 8; ++i) u0[i] = cc[i] * cx[i];
        unpack8(R.cc1, cc); unpack8(R.cx1, cx);
#pragma unroll
        for (int i = 0; i < 8; ++i) f1[i] = cc[i] * cx[i];
        unpack8(R.cc2, cc); unpack8(R.cx2, cx);
#pragma unroll
        for (int i = 0; i < 8; ++i) f2[i] = cc[i] * cx[i];
        if (smp && t < 2) {
            const float* sc = a.in[2] + (size_t)b * 1024;
            if (t == 0) { const f32x4 s0 = gldf4(sc + 512 + c8), s1 = gldf4(sc + 512 + c8 + 4); f1[0] = s0.x; f1[1] = s0.y; f1[2] = s0.z; f1[3] = s0.w; f1[4] = s1.x; f1[5] = s1.y; f1[6] = s1.z; f1[7] = s1.w; }
            const float* sp = sc + (t == 1 ? 512 : 0) + c8; const f32x4 s0 = gldf4(sp), s1 = gldf4(sp + 4);
            f2[0] = s0.x; f2[1] = s0.y; f2[2] = s0.z; f2[3] = s0.w; f2[4] = s1.x; f2[5] = s1.y; f2[6] = s1.z; f2[7] = s1.w;
        }
        const f32x4 w00 = K.w[0], w01 = K.w[1], w10 = K.w[2], w11 = K.w[3], w20 = K.w[4], w21 = K.w[5];
        const float W0[8] = {w00.x, w00.y, w00.z, w00.w, w01.x, w01.y, w01.z, w01.w}, W1[8] = {w10.x, w10.y, w10.z, w10.w, w11.x, w11.y, w11.z, w11.w}, W2[8] = {w20.x, w20.y, w20.z, w20.w, w21.x, w21.y, w21.z, w21.w};
#pragma unroll
        for (int i = 0; i < 8; ++i) yconv[i] = cb[i] * (f2[i] * W0[i] + f1[i] * W1[i] + u0[i] * W2[i]);
        if (t >= L - 2) {
            float* oc = a.out + (smp ? O_CONVS : O_CONVP) + (size_t)b * 1024 + (t == L - 1 ? 512 : 0) + c8;
            *(GAS f32x4*)oc = (f32x4){u0[0], u0[1], u0[2], u0[3]}; *(GAS f32x4*)(oc + 4) = (f32x4){u0[4], u0[5], u0[6], u0[7]};
        }
    }
    {
        const f32x4 y0 = R.y0, y1 = R.y1;
        float y[8] = {y0.x, y0.y, y0.z, y0.w, y1.x, y1.y, y1.z, y1.w};
        float s = 0.f;
#pragma unroll
        for (int i = 0; i < 8; ++i) s += y[i];
        s += __shfl_xor(s, 1); s += __shfl_xor(s, 2); s += __shfl_xor(s, 4);
        const float mean = s * (1.f / 64.f);
        float qv = 0.f;
#pragma unroll
        for (int i = 0; i < 8; ++i) { y[i] -= mean; qv += y[i] * y[i]; }
        qv += __shfl_xor(qv, 1); qv += __shfl_xor(qv, 2); qv += __shfl_xor(qv, 4);
        const float rs = 1.0f / sqrtf(qv * (1.f / 64.f) + 64e-5f);
        float xv[8], g[8];
        unpack8(R.v, xv); unpack8(R.g, g);
        const float rk = R.rk;
        const f32x4 l0 = K.l[0], l1 = K.l[1], b0 = K.l[2], b1 = K.l[3];
        const float lg[8] = {l0.x, l0.y, l0.z, l0.w, l1.x, l1.y, l1.z, l1.w}, lb[8] = {b0.x, b0.y, b0.z, b0.w, b1.x, b1.y, b1.z, b1.w};
#pragma unroll
        for (int i = 0; i < 8; ++i) yrw[i] = (y[i] * rs * lg[i] + lb[i] + rk * xv[i]) * g[i];
    }
    bf16* ym = (bf16*)(a.ws + WS_XN) + (size_t)row * 1024;
    *(GAS u32x4*)(ym + c8) = pack8(yconv);
    *(GAS u32x4*)(ym + 512 + c8) = pack8(yrw);
    if (t == L - 1) {
        float* os = a.out + (smp ? O_SHIFTS : O_SHIFTP) + (size_t)b * RWC;
#pragma unroll
        for (int i = 0; i < 7; ++i) { const int c = i * 256 + 4 * lane; const u32x2 u = *(const GAS u32x2*)(pr + PRW + c);
            *(GAS f32x4*)(os + c) = (f32x4){bflo(u.x), bfhi(u.x), bflo(u.y), bfhi(u.y)}; }
    }
}

#define XB_TMO      128
#define XB_XCNT(j)  (256  + 64 * (j))
#define XB_XSUB(j)  (1280 + 64 * (j))
#define XB_XGEN(j)  (2304 + 64 * (j))
#define XB_TOP      3328
#define XB_TOPGEN   3392
#define XCD_BAR_WORDS 3456
#define XB_SPIN_CAP (1u << 18)

__device__ __forceinline__ unsigned xb_ld(unsigned* p)              { return __hip_atomic_load(p, __ATOMIC_RELAXED, __HIP_MEMORY_SCOPE_AGENT); }
__device__ __forceinline__ unsigned xb_add(unsigned* p, unsigned v) { return __hip_atomic_fetch_add(p, v, __ATOMIC_RELAXED, __HIP_MEMORY_SCOPE_AGENT); }
__device__ __forceinline__ unsigned xb_xcc_id() { return (unsigned)__builtin_amdgcn_s_getreg((3 << 11) | 20) & 0xFu; }
#define XB_SPIN(cond, bar) do { unsigned _sp = 0; while (cond) { __builtin_amdgcn_s_sleep(1); \
    if ((++_sp & 255u) == 0u) { if (xb_ld(&(bar)[XB_TMO])) break; if (_sp > XB_SPIN_CAP) { atomicAdd(&(bar)[XB_TMO], 1u); break; } } } } while (0)

struct XcdBarrier {
    unsigned* bar; unsigned x;
    volatile LAS unsigned* st;
};

__device__ __forceinline__ XcdBarrier xcd_barrier_post(unsigned* bar, volatile LAS unsigned* st) {
    XcdBarrier b; b.bar = bar; b.x = xb_xcc_id(); b.st = st;
    if (threadIdx.x == 0) (void)xb_add(&bar[XB_XCNT(b.x)], 1u);
    return b;
}
__device__ __forceinline__ void xcd_barrier_complete(unsigned* bar, unsigned x, unsigned& nloc, unsigned& nx) {
    const unsigned G = gridDim.x * gridDim.y * gridDim.z;
    unsigned sum, cnt, mine, sp = 0u;
    for (;;) {
        sum = 0u; cnt = 0u; mine = 0u;
#pragma unroll
        for (unsigned j = 0; j < 16; ++j) { const unsigned c = xb_ld(&bar[XB_XCNT(j)]); sum += c; cnt += (c > 0u) ? 1u : 0u; mine = (j == x) ? c : mine; }
        if (sum == G) break;
        __builtin_amdgcn_s_sleep(1);
        if ((++sp & 255u) == 0u) { if (xb_ld(&bar[XB_TMO])) break; if (sp > XB_SPIN_CAP) { atomicAdd(&bar[XB_TMO], 1u); break; } }
    }
    nloc = mine > 0u ? mine : 1u; nx = cnt > 0u ? cnt : 1u;
}

__device__ __forceinline__ void xcd_barrier(const XcdBarrier& b) {
    asm volatile("s_waitcnt vmcnt(0)" ::: "memory");
    __syncthreads();
    if (threadIdx.x == 0) {
        unsigned* bar = b.bar;
        __builtin_amdgcn_s_waitcnt(0);
        unsigned nloc = b.st[0], nx = b.st[1];
        if (nloc == 0u) { xcd_barrier_complete(bar, b.x, nloc, nx); b.st[0] = nloc; b.st[1] = nx; }
        const unsigned old = xb_add(&bar[XB_XSUB(b.x)], 1u);
        const unsigned gen = old / nloc;
        if (old + 1u == (gen + 1u) * nloc) {
            __builtin_amdgcn_fence(__ATOMIC_RELEASE, "agent");
            asm volatile("s_waitcnt vmcnt(0)" ::: "memory");
            const unsigned og = xb_add(&bar[XB_TOP], 1u);
            const unsigned tg = og / nx;
            if (og + 1u == (tg + 1u) * nx) xb_add(&bar[XB_TOPGEN], 1u);
            else XB_SPIN(xb_ld(&bar[XB_TOPGEN]) == tg, bar);
            __builtin_amdgcn_fence(__ATOMIC_ACQUIRE, "agent");
            xb_add(&bar[XB_XGEN(b.x)], 1u);
            asm volatile("s_waitcnt vmcnt(0)" ::: "memory");
        } else {
            XB_SPIN(xb_ld(&bar[XB_XGEN(b.x)]) == gen, bar);
            __builtin_amdgcn_fence(__ATOMIC_ACQUIRE, "agent");
            asm volatile("s_waitcnt vmcnt(0)" ::: "memory");
        }
    }
    __syncthreads();
}

__global__ void __launch_bounds__(512, 2) fwd_kernel(Args a) {
    extern __shared__ __attribute__((aligned(16))) unsigned char lds_raw[];
    LAS unsigned char* lds = (LAS unsigned char*)lds_raw;
    cg::grid_group grid = cg::this_grid();
    const int tid = threadIdx.x, lane = tid & 63, wave = __builtin_amdgcn_readfirstlane(tid >> 6);
    const int G = gridDim.x, bx = blockIdx.x;
    const int vcu = (G % 8 == 0) ? (bx % 8) * (G / 8) + bx / 8 : bx;
    const int gw = vcu * 8 + wave, NGW = G * 8;
    const int lo = a.ph_lo, hi = a.ph_hi;
#define IN(k) (lo <= (k) && (k) < hi)
    volatile LAS unsigned* barst = (volatile LAS unsigned*)(lds + LDS_BARST);
    if (tid == 0) { barst[0] = 0u; barst[1] = 0u; }
    __syncthreads();
    const XcdBarrier bar = xcd_barrier_post((unsigned*)(a.ws + WS_BAR) + a.li * XCD_BAR_WORDS, barst);
    if (a.ph_lo < 0) grid.sync();
#define SEAM(k) do { if (IN(k) && IN((k) + 1)) xcd_barrier(bar); } while (0)
    unsigned char* ws = a.ws;
    bf16* WT_IN = (bf16*)(ws + WS_WIN); bf16* WT_OUT = (bf16*)(ws + WS_WOUT); bf16* WT_FF1 = (bf16*)(ws + WS_WFF1); bf16* WT_FF2 = (bf16*)(ws + WS_WFF2);
    bf16* XN = (bf16*)(ws + WS_XN); bf16* XG = (bf16*)(ws + WS_XG); bf16* PROJ = (bf16*)(ws + WS_PROJ); bf16* HB = (bf16*)(ws + WS_H);
    float* SS1 = (float*)(ws + WS_SS1); float* SS2 = (float*)(ws + WS_SS2);

    if (IN(0)) {
        LAS float* scr = (LAS float*)(lds + wave * 16384);
        constexpr int I_IN = 16 * (IC / 32), I_OUT = 16 * 32, I_F1 = 16 * (FFD / 32), I_F2 = 64 * 32, I_W2 = 16, I_A2 = 16, I_G2 = 2 * 16;
        constexpr int NITEMS = I_IN + I_W2 + I_A2 + I_G2;
        for (int it = gw; it < NITEMS; it += NGW) {
            int r = it;
            if (r < I_IN) { p0_transpose_item(a.in[6], DM, IC, WT_IN, scr, r, lane); continue; } r -= I_IN;
            if (r < I_W2) { p0_transpose_item(a.in[10], 64, 512, (bf16*)(ws + WS_W2T), scr, r, lane); continue; } r -= I_W2;
            if (r < I_A2) { p0_transpose_item(a.in[12], 64, 512, (bf16*)(ws + WS_A2T), scr, r, lane); continue; } r -= I_A2;
            p0_transpose_item(a.in[13], 128, 512, (bf16*)(ws + WS_G2T), scr, r, lane);
        }
        {
            const GAS f32x4* gr = (const GAS f32x4*)a.in[5] + lane;
            const f32x4 g0 = gr[0], g1 = gr[64], g2 = gr[128], g3 = gr[192];
            for (int m0 = gw; m0 < TT; m0 += 4 * NGW) {
                f32x4 v[4][4];
#pragma unroll
                for (int k = 0; k < 4; ++k) { const int m = m0 + k * NGW;
                    if (m < TT) { const float* xrow = (m < TP) ? a.in[0] + (size_t)m * DM : a.in[1] + (size_t)(m - TP) * DM; const GAS f32x4* xr = (const GAS f32x4*)xrow + lane;
                        v[k][0] = xr[0]; v[k][1] = xr[64]; v[k][2] = xr[128]; v[k][3] = xr[192]; }
                    else { v[k][0] = v[k][1] = v[k][2] = v[k][3] = (f32x4){0.f, 0.f, 0.f, 0.f}; } }
#pragma unroll
                for (int k = 0; k < 4; ++k) { const int m = m0 + k * NGW;
                    float s2 = 0.f;
#pragma unroll
                    for (int j = 0; j < 4; ++j) s2 += (v[k][j].x * v[k][j].x + v[k][j].y * v[k][j].y) + (v[k][j].z * v[k][j].z + v[k][j].w * v[k][j].w);
                    const float rstd = 1.0f / sqrtf(wave_sum(s2) * (1.f / DM) + 1e-6f);
                    if (m < TT) { GAS u32x2* o8 = (GAS u32x2*)(XN + (size_t)m * DM) + lane;
                        u32x2 w; w.x = pk2(v[k][0].x * rstd * g0.x, v[k][0].y * rstd * g0.y); w.y = pk2(v[k][0].z * rstd * g0.z, v[k][0].w * rstd * g0.w); o8[0] = w;
                        w.x = pk2(v[k][1].x * rstd * g1.x, v[k][1].y * rstd * g1.y); w.y = pk2(v[k][1].z * rstd * g1.z, v[k][1].w * rstd * g1.w); o8[64] = w;
                        w.x = pk2(v[k][2].x * rstd * g2.x, v[k][2].y * rstd * g2.y); w.y = pk2(v[k][2].z * rstd * g2.z, v[k][2].w * rstd * g2.w); o8[128] = w;
                        w.x = pk2(v[k][3].x * rstd * g3.x, v[k][3].y * rstd * g3.y); w.y = pk2(v[k][3].z * rstd * g3.z, v[k][3].w * rstd * g3.w); o8[192] = w; }
                }
            }
        }
    }
    SEAM(0);
    if (IN(1)) {
        pg8::Gemm g{XN, WT_IN, TT, IC, DM}; pg8::StaticOrder S; S.init(TT, IC, G, bx);
        pg8::EpiStore<0> E{PROJ, IC};
        pg8::gemm_phase<pg8::EpiStore<0>, pg8::StaticOrder, true, true>(lds, g, S, E);
        {
            const int ntile = (TT / 256) * (IC / 256), full = ntile / G, nbusy = ntile - full * G;
            if (bx >= nbusy) {
                constexpr int I_OUT = 16 * 32, I_F1 = 16 * (FFD / 32), I_F2 = 64 * 32;
                LAS float* scr = (LAS float*)(lds + wave * 16384);
                for (int it = (bx - nbusy) * 8 + wave; it < I_OUT + I_F1 + I_F2; it += (G - nbusy) * 8) {
                    int r = it;
                    if (r < I_OUT) { p0_transpose_item(a.in[19], DM, DM, WT_OUT, scr, r, lane); continue; } r -= I_OUT;
                    if (r < I_F1) { p0_transpose_item(a.in[21], DM, FFD, WT_FF1, scr, r, lane); continue; } r -= I_F1;
                    p0_transpose_item(a.in[22], FFD, DM, WT_FF2, scr, r, lane);
                }
            }
        }
    }
    SEAM(1);
    if (IN(2)) {
        LAS unsigned char* scr = lds + wave * PREP_SCR;
        PrepConst C; C.unused = 0;
        {
            const int h = gw & 7, cgp = lane & 7;
            int col[7]; prep_cols(h, cgp, col);
            LAS float* MUw = (LAS float*)(scr + PREP_MU);
#pragma unroll
            for (int i = 0; i < 7; ++i) { *(LAS f32x4*)(MUw + (i * 8 + cgp) * 8) = gldf4(a.in[8] + col[i]); *(LAS f32x4*)(MUw + (i * 8 + cgp) * 8 + 4) = gldf4(a.in[8] + col[i] + 4); }
            LDS_WAIT();
        }
        PrepRaw R, Rn;
        int it = gw;
        if (it < TT) prep_load(a, R, lane, (it >> 3) * 8, it & 7);
        while (it < TT) {
            const int nit = it + NGW;
            if (nit < TT) prep_load(a, Rn, lane, (nit >> 3) * 8, nit & 7);
            prep_item(a, C, R, scr, lane, (it >> 3) * 8, it & 7);
            R = Rn; it = nit;
        }
    }
    SEAM(2);
    if (IN(3)) p2_scan(a, lds, G, vcu, wave, lane);
    SEAM(3);
    if (IN(4)) {
        MixConst K; { const int c8 = 8 * lane; const float* cw = a.in[7];
            K.w[0] = gldf4(cw + c8); K.w[1] = gldf4(cw + c8 + 4); K.w[2] = gldf4(cw + 512 + c8); K.w[3] = gldf4(cw + 512 + c8 + 4); K.w[4] = gldf4(cw + 1024 + c8); K.w[5] = gldf4(cw + 1024 + c8 + 4);
            K.l[0] = gldf4(a.in[17] + c8); K.l[1] = gldf4(a.in[17] + c8 + 4); K.l[2] = gldf4(a.in[18] + c8); K.l[3] = gldf4(a.in[18] + c8 + 4); }
        MixRaw R, Rn;
        int m = gw;
        if (m < TT) p3_load(a, R, m, lane);
        while (m < TT) {
            const int mn = m + NGW;
            if (mn < TT) p3_load(a, Rn, mn, lane);
            p3_token(a, K, R, m, lane);
            R = Rn; m = mn;
        }
    }
    SEAM(4);
    if (IN(5)) {
        unsigned* ocnt = (unsigned*)(ws + WS_BAR) + 30000;
        if (G == 256) {
            { pg8::Gemm g{XN, WT_OUT, TT, DM, DM}; pg8::OutOrder S{G, bx, ocnt};
              pg8::EpiRes<0> E{a.in[0], a.in[1], a.out, XG, a.in[20], nullptr, SS1};
              pg8::gemm_phase<pg8::EpiRes<0>, pg8::OutOrder, true, true>(lds, g, S, E); }
            {
              pg8::Gemm g{XG, WT_FF1, TT, FFD, DM}; pg8::SampleFF1Order S{G, bx, ocnt, 16u * 8u};
              pg8::EpiStore<1> E{HB, FFD};
              pg8::gemm_phase<pg8::EpiStore<1>, pg8::SampleFF1Order, true, true>(lds, g, S, E); }
        } else {
            pg8::Gemm g{XN, WT_OUT, TT, DM, DM}; pg8::StaticOrder S; S.init(TT, DM, G, bx);
            pg8::EpiRes<0> E{a.in[0], a.in[1], a.out, XG, a.in[20], nullptr, SS1};
            pg8::gemm_phase<pg8::EpiRes<0>, pg8::StaticOrder, true, true>(lds, g, S, E);
        }
    }
    SEAM(5);
    if (IN(6)) {
        const int mrows = (G == 256) ? TP : TT;
        pg8::Gemm g{XG, WT_FF1, mrows, FFD, DM}; pg8::StaticOrder S; S.init(mrows, FFD, G, bx);
        pg8::EpiStore<1> E{HB, FFD};
        pg8::gemm_phase<pg8::EpiStore<1>, pg8::StaticOrder, true, true>(lds, g, S, E);
    }
    SEAM(6);
    if (IN(7)) {
        {
            pg8::Gemm g{HB, WT_FF2, TP, DM, FFD, 0}; pg8::StaticOrder S; S.init(TP, DM, G, bx);
            if (G == 256) {
                pg8::EpiResNorm E{a.out, SS1, a.in[23], (float*)(ws + WS_XSTAT), (unsigned*)(ws + WS_BAR) + 20000};
                pg8::gemm_phase<pg8::EpiResNorm, pg8::StaticOrder, false, true>(lds, g, S, E);
            } else {
                pg8::EpiRes<1> E{nullptr, nullptr, a.out, nullptr, nullptr, SS1, SS2};
                pg8::gemm_phase<pg8::EpiRes<1>, pg8::StaticOrder, true, true>(lds, g, S, E);
            }
        }
        {
            pg8::Gemm g{HB, WT_FF2, TT, DM, 512, FFD}; pg8::SplitOrder S{G, bx};
            pg8::EpiPart E{(float*)(ws + WS_PART)};
            pg8::gemm_phase<pg8::EpiPart, pg8::SplitOrder, true, true>(lds, g, S, E);
        }
    }
    SEAM(7);
    if (IN(8)) {
        for (int m = gw; m < TT; m += NGW) {
            GAS f32x4* xr = (GAS f32x4*)(a.out + (size_t)m * DM) + lane; const GAS f32x4* gr = (const GAS f32x4*)a.in[23] + lane;
            if (m < TP) {
                if (G == 256) continue;
                float s = (lane < 16) ? SS2[(size_t)m * 16 + lane] : 0.f;
                const float rstd = 1.0f / sqrtf(wave_sum(s) * (1.f / DM) + 1e-6f);
#pragma unroll
                for (int j = 0; j < 4; ++j) { const f32x4 v = xr[64 * j], gg = gr[64 * j]; xr[64 * j] = v * rstd * gg; }
            } else {
                float s1 = (lane < 16) ? SS1[(size_t)m * 16 + lane] : 0.f;
                const float sc = 1.0f / (wave_sum(s1) * (1.f / DM) + 1e-6f);
                const GAS f32x4* pr = (const GAS f32x4*)((const float*)(ws + WS_PART) + (size_t)(m - TP) * 1024) + lane;
                f32x4 x2[4]; float s2 = 0.f;
#pragma unroll
                for (int j = 0; j < 4; ++j) {
                    f32x4 acc = pr[64 * j];
#pragma unroll
                    for (int kc = 1; kc < 8; ++kc) acc = acc + pr[(size_t)kc * (1024 * 1024 / 4) + 64 * j];
                    x2[j] = xr[64 * j] + acc * sc;
                    s2 += (x2[j].x * x2[j].x + x2[j].y * x2[j].y) + (x2[j].z * x2[j].z + x2[j].w * x2[j].w);
                }
                const float rstd = 1.0f / sqrtf(wave_sum(s2) * (1.f / DM) + 1e-6f);
#pragma unroll
                for (int j = 0; j < 4; ++j) xr[64 * j] = x2[j] * rstd * gr[64 * j];
            }
        }
    }
#undef IN
#undef SEAM
}

extern "C" void kernel_launch(void* const* d_in, const int* in_sizes, int n_in, void* d_out, int out_size, void* d_ws, size_t ws_size, hipStream_t stream) {
    static int grid = 0;
    if (grid == 0) {
        int dev = 0, cus = 0, per_cu = 0;
        (void)hipGetDevice(&dev);
        (void)hipDeviceGetAttribute(&cus, hipDeviceAttributeMultiprocessorCount, dev);
        if (hipFuncSetAttribute((const void*)fwd_kernel, hipFuncAttributeMaxDynamicSharedMemorySize, LDS_BYTES) != hipSuccess) fprintf(stderr, "hipFuncSetAttribute failed\n");
        if (hipOccupancyMaxActiveBlocksPerMultiprocessor(&per_cu, (const void*)fwd_kernel, 512, LDS_BYTES) != hipSuccess || per_cu < 1) { fprintf(stderr, "occupancy query: %d\n", per_cu); per_cu = 1; }
        (void)hipGetLastError();
        grid = cus * 1;
        if (n_in != 24 || ws_size < WS_END) fprintf(stderr, "unexpected n_in %d ws %zu\n", n_in, ws_size);
    }
    Args a{};
    for (int i = 0; i < 24; ++i) a.in[i] = (const float*)d_in[i];
    a.out = (float*)d_out; a.ws = (unsigned char*)d_ws;
#ifndef PROBE_SEQ
#define PROBE_SEQ {0, 9}
#endif
    static const int seq[] = PROBE_SEQ;
    (void)hipMemsetAsync((unsigned char*)d_ws + WS_BAR, 0, BAR_ZERO_BYTES, stream);
    for (unsigned i = 0; i + 1 < sizeof(seq) / sizeof(seq[0]); i += 2) {
        a.ph_lo = seq[i]; a.ph_hi = seq[i + 1]; a.li = (int)(i / 2);
        void* args[] = {&a};
        hipError_t e = hipLaunchCooperativeKernel((const void*)fwd_kernel, dim3(grid), dim3(512), args, LDS_BYTES, stream);
        if (e != hipSuccess) fprintf(stderr, "cooperative launch failed: %s (grid %d)\n", hipGetErrorString(e), grid);
    }
}
```
